# Optimizing an MI355X kernel written in HIP

```python
import math
import jax, jax.numpy as jnp
from jax import lax
import numpy as np

D_MODEL = 1024
BATCH = 4
SEQ = 4096
DEPTH = 1
DEC_BATCH = 8
DEC_SEQ = 16
PAST_LEN = 4096

CHUNK = 64
Q_BLOCK = 128
ROPE_THETA = 10000.0
EPS = 1e-6
NEG = -1e30
MACARON = 0.5
D_FF = 2816
ATT_HEADS = 4
ATT_DH = 64
ATT_QK_W = ATT_HEADS * 2 * ATT_DH
ATT_V_W = ATT_HEADS * 2 * ATT_DH
RW_HEAD = 64
RW_W = D_MODEL // 2
RW_HEADS = RW_W // RW_HEAD
W_LORA = 64
A_LORA = 64
G_LORA = 128
SHIFT_W = 3 * RW_W + W_LORA + A_LORA + G_LORA
LNX_EPS = 64e-5
GATE_W = 2 * D_MODEL
IN_W = 2 * ATT_QK_W + ATT_V_W + SHIFT_W + GATE_W

kernel_name = 'hybrid_diffattn_rwkv7_macaron_step'


def rms_norm(x, g, eps=EPS):
    xf = x.astype(jnp.float32)
    y = xf * lax.rsqrt(jnp.mean(xf * xf, axis=-1, keepdims=True) + eps)
    return (y * g.astype(jnp.float32)).astype(x.dtype)


def swiglu(x, w_in, w_out):
    gate, up = jnp.split(x @ w_in, 2, axis=-1)
    return (jax.nn.silu(gate) * up) @ w_out


def sandwich_ffn(x, pre_g, w_in, w_out, post_g):
    return x + MACARON * rms_norm(swiglu(rms_norm(x, pre_g), w_in, w_out), post_g)


def rope(x, pos):
    half = ATT_DH // 2
    inv = ROPE_THETA ** (-jnp.arange(half, dtype=jnp.float32) / half)
    ang = pos.astype(jnp.float32)[:, None] * inv[None, :]
    cos = jnp.cos(ang)[None, :, None, None, :]
    sin = jnp.sin(ang)[None, :, None, None, :]
    xf = x.astype(jnp.float32)
    x1, x2 = xf[..., :half], xf[..., half:]
    return jnp.concatenate([x1 * cos - x2 * sin, x1 * sin + x2 * cos], axis=-1).astype(x.dtype)


def diff_core(q, k, v, lam, mask):
    s = jnp.einsum('bqhmd,bkhmd->bhmqk', q, k).astype(jnp.float32) * (ATT_DH ** -0.5)
    if mask is not None:
        s = jnp.where(mask, s, NEG)
    pr = jax.nn.softmax(s, axis=-1)
    a = pr[:, :, 0] - lam * pr[:, :, 1]
    return jnp.einsum('bhqk,bkhe->bqhe', a, v.astype(jnp.float32))


def diff_attention(z_q, z_k, z_v, pos, lam, lam_init, subln_g, cache_k, cache_v):
    B, T, _ = z_q.shape
    q = rope(z_q.reshape(B, T, ATT_HEADS, 2, ATT_DH), pos)
    k = rope(z_k.reshape(B, T, ATT_HEADS, 2, ATT_DH), pos)
    v = z_v.reshape(B, T, ATT_HEADS, 2 * ATT_DH)
    if cache_k is None:
        nb = T // Q_BLOCK
        qb = jnp.moveaxis(q.reshape(B, nb, Q_BLOCK, ATT_HEADS, 2, ATT_DH), 1, 0)
        key_chunk = jnp.arange(T) // CHUNK

        def block(args):
            qi, bi = args
            q_chunk = (bi * Q_BLOCK + jnp.arange(Q_BLOCK)) // CHUNK
            mask = key_chunk[None, :] <= q_chunk[:, None]
            return diff_core(qi, k, v, lam, mask)

        o = lax.map(block, (qb, jnp.arange(nb)))
        o = jnp.moveaxis(o, 0, 1).reshape(B, T, ATT_HEADS, 2 * ATT_DH)
    else:
        keys = jnp.concatenate([cache_k.astype(k.dtype), k], axis=1)
        vals = jnp.concatenate([cache_v.astype(v.dtype), v], axis=1)
        o = diff_core(q, keys, vals, lam, None)
    o = o * lax.rsqrt(jnp.mean(o * o, axis=-1, keepdims=True) + EPS) * subln_g.astype(jnp.float32) * (1.0 - lam_init)
    return o.reshape(B, T, ATT_V_W).astype(z_v.dtype), k, v


def wkv7_scan(r, decay, k, v, kk, a, S0):
    def step(S, inp):
        r_t, w_t, k_t, v_t, kk_t, a_t = inp
        sa = jnp.einsum('bhij,bhj->bhi', S, -kk_t)
        S = S * w_t[:, :, None, :] + sa[..., None] * (kk_t * a_t)[:, :, None, :] + v_t[..., None] * k_t[:, :, None, :]
        y = jnp.einsum('bhij,bhj->bhi', S, r_t)
        return S, y

    xs = tuple(jnp.moveaxis(t, 1, 0) for t in (r, decay, k, v, kk, a))
    S, ys = lax.scan(step, S0, xs)
    return jnp.moveaxis(ys, 0, 1), S


def rwkv7_branch(z_rw, S0, shift0, p):
    B, T, _ = z_rw.shape
    prev = jnp.concatenate([shift0.astype(z_rw.dtype), z_rw[:, :-1]], axis=1)
    zs = (z_rw + (prev - z_rw) * p['rwkv_mu']).astype(jnp.float32)
    r, k, v, zw, za, zg = jnp.split(zs, [RW_W, 2 * RW_W, 3 * RW_W, 3 * RW_W + W_LORA, 3 * RW_W + W_LORA + A_LORA], axis=-1)
    w = -jax.nn.softplus(-(p['rwkv_w0'].astype(jnp.float32) + jnp.tanh(zw) @ p['rwkv_w2'].astype(jnp.float32))) - 0.5
    decay = jnp.exp(-jnp.exp(w))
    a = jax.nn.sigmoid(p['rwkv_a0'].astype(jnp.float32) + za @ p['rwkv_a2'].astype(jnp.float32))
    g = jax.nn.sigmoid(zg) @ p['rwkv_g2'].astype(jnp.float32)
    heads = lambda t: t.reshape(B, T, RW_HEADS, RW_HEAD)
    kk = heads(k * p['rwkv_k_k'].astype(jnp.float32))
    kk = kk / jnp.maximum(jnp.sqrt(jnp.sum(kk * kk, axis=-1, keepdims=True)), 1e-12)
    k = k * (1.0 + (a - 1.0) * p['rwkv_k_a'].astype(jnp.float32))
    rh, kh, vh, ah, dh = heads(r), heads(k), heads(v), heads(a), heads(decay)
    y, S = wkv7_scan(rh, dh, kh, vh, kk, ah, S0.astype(jnp.float32))
    mu = jnp.mean(y, axis=-1, keepdims=True)
    var = jnp.mean(jnp.square(y - mu), axis=-1, keepdims=True)
    y = ((y - mu) * lax.rsqrt(var + LNX_EPS)).reshape(B, T, RW_W)
    y = y * p['rwkv_lnx_g'].astype(jnp.float32) + p['rwkv_lnx_b'].astype(jnp.float32)
    bonus = jnp.sum(rh * kh * p['rwkv_r_k'].astype(jnp.float32), axis=-1, keepdims=True) * vh
    out = (y + bonus.reshape(B, T, RW_W)) * g
    return out.astype(z_rw.dtype), S, z_rw[:, -1:]


def layer(x, pos, l, p, cache_k, cache_v, S0, shift0):
    h = sandwich_ffn(x, p['ffn1_pre_g'], p['ffn1_w_in'], p['ffn1_w_out'], p['ffn1_post_g'])
    u = rms_norm(h, p['mix_pre_g'])
    z = u @ p['w_in']
    o1 = ATT_QK_W
    o2 = 2 * ATT_QK_W
    o3 = o2 + ATT_V_W
    o4 = o3 + SHIFT_W
    z_q, z_k, z_v, z_rw, z_g = jnp.split(z, [o1, o2, o3, o4], axis=-1)
    lam_init = 0.8 - 0.6 * math.exp(-0.3 * l)
    f32 = lambda t: t.astype(jnp.float32)
    lam = (jnp.exp(jnp.sum(f32(p['att_lambda_q1']) * f32(p['att_lambda_k1'])))
           - jnp.exp(jnp.sum(f32(p['att_lambda_q2']) * f32(p['att_lambda_k2']))) + lam_init)
    o_att, k_rows, v_rows = diff_attention(z_q, z_k, z_v, pos, lam, lam_init, p['att_subln_g'], cache_k, cache_v)
    o_rw, S, shift = rwkv7_branch(z_rw, S0, shift0, p)
    gate_att, gate_rw = jnp.split(jax.nn.sigmoid(z_g), 2, axis=-1)
    merged = gate_att * (o_att @ p['w_o_att']) + gate_rw * (o_rw @ p['w_o_rwkv'])
    h = h + rms_norm(merged @ p['w_out'], p['mix_post_g'])
    y = sandwich_ffn(h, p['ffn2_pre_g'], p['ffn2_w_in'], p['ffn2_w_out'], p['ffn2_post_g'])
    return y, k_rows, v_rows, S, shift


def setup_inputs(seed: int = 0) -> dict:
    key = jax.random.key(seed)
    ks = iter(jax.random.split(key, 48))
    L = DEPTH

    def nrm(shape, scale):
        return scale * jax.random.normal(next(ks), shape, jnp.float32)

    def gain(n):
        return 1.0 + nrm((L, n), 0.05)

    return {
        'x_prompt': nrm((BATCH, SEQ, D_MODEL), 1.0),
        'x_sample': nrm((DEC_BATCH, DEC_SEQ, D_MODEL), 1.0),
        'cache_att_k': nrm((L, DEC_BATCH, PAST_LEN, ATT_HEADS, 2, ATT_DH), 1.0),
        'cache_att_v': nrm((L, DEC_BATCH, PAST_LEN, ATT_HEADS, 2 * ATT_DH), 1.0),
        'state_rwkv': nrm((L, DEC_BATCH, RW_HEADS, RW_HEAD, RW_HEAD), 0.3),
        'state_shift': nrm((L, DEC_BATCH, 1, SHIFT_W), 1.0),
        'ffn1_pre_g': gain(D_MODEL),
        'ffn1_w_in': nrm((L, D_MODEL, 2 * D_FF), D_MODEL ** -0.5),
        'ffn1_w_out': nrm((L, D_FF, D_MODEL), D_FF ** -0.5),
        'ffn1_post_g': gain(D_MODEL),
        'mix_pre_g': gain(D_MODEL),
        'w_in': nrm((L, D_MODEL, IN_W), D_MODEL ** -0.5),
        'att_lambda_q1': nrm((L, ATT_DH), 0.1),
        'att_lambda_k1': nrm((L, ATT_DH), 0.1),
        'att_lambda_q2': nrm((L, ATT_DH), 0.1),
        'att_lambda_k2': nrm((L, ATT_DH), 0.1),
        'att_subln_g': gain(2 * ATT_DH),
        'rwkv_mu': jax.random.uniform(next(ks), (L, SHIFT_W), jnp.float32),
        'rwkv_w0': jax.random.uniform(next(ks), (L, RW_W), jnp.float32, minval=-6.0, maxval=0.0),
        'rwkv_w2': nrm((L, W_LORA, RW_W), 0.5 * W_LORA ** -0.5),
        'rwkv_a0': nrm((L, RW_W), 0.1),
        'rwkv_a2': nrm((L, A_LORA, RW_W), 0.5 * A_LORA ** -0.5),
        'rwkv_g2': nrm((L, G_LORA, RW_W), G_LORA ** -0.5),
        'rwkv_k_k': 0.85 + nrm((L, RW_W), 0.05),
        'rwkv_k_a': 1.0 + nrm((L, RW_W), 0.05),
        'rwkv_r_k': nrm((L, RW_HEADS, RW_HEAD), 0.1),
        'rwkv_lnx_g': gain(RW_W),
        'rwkv_lnx_b': nrm((L, RW_W), 0.02),
        'w_o_att': nrm((L, ATT_V_W, D_MODEL), ATT_V_W ** -0.5),
        'w_o_rwkv': nrm((L, RW_W, D_MODEL), RW_W ** -0.5),
        'w_out': nrm((L, D_MODEL, D_MODEL), D_MODEL ** -0.5),
        'mix_post_g': gain(D_MODEL),
        'ffn2_pre_g': gain(D_MODEL),
        'ffn2_w_in': nrm((L, D_MODEL, 2 * D_FF), D_MODEL ** -0.5),
        'ffn2_w_out': nrm((L, D_FF, D_MODEL), D_FF ** -0.5),
        'ffn2_post_g': gain(D_MODEL),
    }


def reference(x_prompt, x_sample, cache_att_k, cache_att_v, state_rwkv, state_shift,
              ffn1_pre_g, ffn1_w_in, ffn1_w_out, ffn1_post_g, mix_pre_g, w_in,
              att_lambda_q1, att_lambda_k1, att_lambda_q2, att_lambda_k2, att_subln_g,
              rwkv_mu, rwkv_w0, rwkv_w2, rwkv_a0, rwkv_a2, rwkv_g2, rwkv_k_k, rwkv_k_a,
              rwkv_r_k, rwkv_lnx_g, rwkv_lnx_b, w_o_att, w_o_rwkv, w_out, mix_post_g,
              ffn2_pre_g, ffn2_w_in, ffn2_w_out, ffn2_post_g):
    Bp, Tp, _ = x_prompt.shape
    Bs, Ts, _ = x_sample.shape
    past = cache_att_k.shape[2]
    pos_p = jnp.arange(Tp)
    pos_s = past + jnp.arange(Ts)
    xp, xs = x_prompt, x_sample
    kp_l, vp_l, sp_l, shp_l = [], [], [], []
    ks_l, vs_l, ss_l, shs_l = [], [], [], []
    for l in range(DEPTH):
        p = dict(
            ffn1_pre_g=ffn1_pre_g[l], ffn1_w_in=ffn1_w_in[l], ffn1_w_out=ffn1_w_out[l], ffn1_post_g=ffn1_post_g[l],
            mix_pre_g=mix_pre_g[l], w_in=w_in[l],
            att_lambda_q1=att_lambda_q1[l], att_lambda_k1=att_lambda_k1[l],
            att_lambda_q2=att_lambda_q2[l], att_lambda_k2=att_lambda_k2[l], att_subln_g=att_subln_g[l],
            rwkv_mu=rwkv_mu[l], rwkv_w0=rwkv_w0[l], rwkv_w2=rwkv_w2[l], rwkv_a0=rwkv_a0[l], rwkv_a2=rwkv_a2[l],
            rwkv_g2=rwkv_g2[l], rwkv_k_k=rwkv_k_k[l], rwkv_k_a=rwkv_k_a[l], rwkv_r_k=rwkv_r_k[l],
            rwkv_lnx_g=rwkv_lnx_g[l], rwkv_lnx_b=rwkv_lnx_b[l],
            w_o_att=w_o_att[l], w_o_rwkv=w_o_rwkv[l], w_out=w_out[l], mix_post_g=mix_post_g[l],
            ffn2_pre_g=ffn2_pre_g[l], ffn2_w_in=ffn2_w_in[l], ffn2_w_out=ffn2_w_out[l], ffn2_post_g=ffn2_post_g[l],
        )
        S0p = jnp.zeros((Bp, RW_HEADS, RW_HEAD, RW_HEAD), jnp.float32)
        sh0p = jnp.zeros((Bp, 1, SHIFT_W), xp.dtype)
        xp, kp, vp, Sp, shp = layer(xp, pos_p, l, p, None, None, S0p, sh0p)
        xs, kn, vn, Sn, shn = layer(xs, pos_s, l, p, cache_att_k[l], cache_att_v[l], state_rwkv[l], state_shift[l])
        kp_l.append(kp); vp_l.append(vp); sp_l.append(Sp); shp_l.append(shp)
        ks_l.append(kn); vs_l.append(vn); ss_l.append(Sn); shs_l.append(shn)
    new_k_prompt = jnp.stack(kp_l, 0)
    new_v_prompt = jnp.stack(vp_l, 0)
    new_rwkv_prompt = jnp.stack(sp_l, 0)
    new_shift_prompt = jnp.stack(shp_l, 0)
    new_k_sample = jnp.stack(ks_l, 0)
    new_v_sample = jnp.stack(vs_l, 0)
    new_rwkv_sample = jnp.stack(ss_l, 0)
    new_shift_sample = jnp.stack(shs_l, 0)
    return (xp, xs, new_k_prompt, new_v_prompt, new_rwkv_prompt, new_shift_prompt,
            new_k_sample, new_v_sample, new_rwkv_sample, new_shift_sample)
```

```cpp
#include <hip/hip_runtime.h>
#include <hip/hip_cooperative_groups.h>
#include <cstdio>
#include <cstdint>
namespace cg = cooperative_groups;
namespace pg8 {
#define PG8_LAS __attribute__((address_space(3)))
typedef unsigned short bf16_t;
typedef short bf16x8 __attribute__((ext_vector_type(8)));
typedef float f32x4 __attribute__((ext_vector_type(4)));
typedef unsigned u32x4 __attribute__((ext_vector_type(4)));
constexpr int BM = 256, BK = 64, HALF = 128, HTB = HALF * BK * 2  , STAGE_BYTES = 8 * HTB, NXCD = 8, WGM = 8;

__host__ __device__ __forceinline__ int lds_byte(int r, int c) { const int st = (r >> 4) * 2 + (c >> 5), rr = r & 15, cc = c & 31, ob = rr * 64 + cc * 2; return st * 1024 + (ob ^ (((ob >> 9) & 1) << 5)); }
__host__ __device__ __forceinline__ void stage_rc(int b, int& R, int& C) { const int st = b / 1024, sb = b % 1024, swz = sb ^ (((sb >> 9) & 1) << 5); R = (st >> 1) * 16 + swz / 64; C = (st & 1) * 32 + (swz % 64) / 2; }
__host__ __device__ __forceinline__ int perm32(int rho) { const int n = rho >> 4, i = rho & 15; return 8 * (i >> 2) + 4 * n + (i & 3); }

struct Unit { int pm, pn; };
struct Gemm { const bf16_t* A; const bf16_t* Bt; int M, N, K, ld; };

struct StaticOrder {
    int nM, nN, nwg, G, c;
    __host__ __device__ void init(int M, int N, int G_, int c_) { nM = M / BM; nN = N / BM; nwg = nM * nN; G = G_; c = c_; }
    __host__ __device__ bool next(int i, Unit& u) const {
        const long L = (long)i * G + c; if (L >= nwg) return false;
        int wgid = (int)L; { const int q = nwg / NXCD, r = nwg % NXCD, xcd = wgid % NXCD, off = wgid / NXCD; wgid = (xcd < r ? xcd * (q + 1) : r * (q + 1) + (xcd - r) * q) + off; }
        const int nig = WGM * nN, gid = wgid / nig, fm = gid * WGM, gsz = (nM - fm) < WGM ? (nM - fm) : WGM;
        u.pm = fm + ((wgid % nig) % gsz); u.pn = (wgid % nig) / gsz; return true;
    }
    __device__ __forceinline__ void a_ready(const Unit&) const {}
    __device__ __forceinline__ void done(const Unit&) const {}
};

__device__ __forceinline__ unsigned cvt_pk_bf16(float lo, float hi) { unsigned r; asm volatile("v_cvt_pk_bf16_f32 %0, %1, %2" : "=v"(r) : "v"(lo), "v"(hi)); return r; }
typedef float f32x2 __attribute__((ext_vector_type(2)));
template <class Epi, class Sched, bool ALIGN_EPI = false, bool SP2 = false>
__device__ __forceinline__ void gemm_phase(PG8_LAS unsigned char* lds, const Gemm g, const Sched& S, const Epi& E) {
    const int tid = threadIdx.x, wid = __builtin_amdgcn_readfirstlane(tid >> 6), lane = tid & 63, wr = wid >> 2, wc = wid & 3, fr = lane & 15, fq = lane >> 4;
    const int K = g.K, nt = K / BK;
    unsigned voffA[2], voffB[2];
#pragma unroll
    for (int i = 0; i < 2; ++i) { int R, C; stage_rc(tid * 16 + i * 8192, R, C); const int Rb = Epi::PERM ? ((R & ~31) + perm32(R & 31)) : R;
        voffA[i] = (unsigned)(R * g.ld + C) * 2u; voffB[i] = (unsigned)(Rb * g.ld + C) * 2u; }
    const size_t kstep = (size_t)(BK * 2);
    const size_t hstep = (size_t)HALF * g.ld * 2;
    const size_t tstep = 2 * hstep;
    const unsigned ldsw = (unsigned)wid * 1024u;
    const int aoff = lds_byte(wr * 64 + fr, fq * 8), boff = lds_byte(wc * 32 + fr, fq * 8);
#define PG8_SA(b, h) (((b) * 2 + (h)) * HTB)
#define PG8_SB(b, h) ((4 + (b) * 2 + (h)) * HTB)
#define PG8_STAGE(bufoff, gbase, voff) do { _Pragma("unroll") for (int _i = 0; _i < 2; ++_i) \
        __builtin_amdgcn_global_load_lds((const unsigned*)((const char*)(gbase) + (voff)[_i]), (PG8_LAS unsigned*)(lds + (bufoff) + ldsw + _i * 8192), 16, 0, 0); } while (0)
#define PG8_LDA(dst, b, h) do { _Pragma("unroll") for (int m = 0; m < 4; ++m) _Pragma("unroll") for (int k = 0; k < 2; ++k) dst[m][k] = *(const PG8_LAS bf16x8*)(lds + PG8_SA(b, h) + aoff + m * 2048 + k * 1024); } while (0)
#define PG8_LDB(dst, b, h) do { _Pragma("unroll") for (int n = 0; n < 2; ++n) _Pragma("unroll") for (int k = 0; k < 2; ++k) dst[n][k] = *(const PG8_LAS bf16x8*)(lds + PG8_SB(b, h) + boff + n * 2048 + k * 1024); } while (0)
#define PG8_MMA(ai, bj, At, Bt) do { __builtin_amdgcn_s_setprio(1); _Pragma("unroll") for (int m = 0; m < 4; ++m) _Pragma("unroll") for (int n = 0; n < 2; ++n) _Pragma("unroll") for (int k = 0; k < 2; ++k) \
        acc[ai][bj][m][n] = __builtin_amdgcn_mfma_f32_16x16x32_bf16(Bt[n][k], At[m][k], acc[ai][bj][m][n], 0, 0, 0); __builtin_amdgcn_s_setprio(0); } while (0)
#define PG8_WAIT_V(n) asm volatile("s_waitcnt vmcnt(" #n ")" ::: "memory")
#define PG8_WAIT_L(n) asm volatile("s_waitcnt lgkmcnt(" #n ")" ::: "memory")
#define PG8_BAR __builtin_amdgcn_s_barrier()
#define PG8_SCHED __builtin_amdgcn_sched_barrier(0)
    Unit cur, nxt; int ui = 0;
    if (!S.next(0, cur)) return;
    f32x4 acc[2][2][4][2];
#pragma unroll
    for (int a = 0; a < 2; ++a)
#pragma unroll
        for (int b = 0; b < 2; ++b)
#pragma unroll
            for (int m = 0; m < 4; ++m)
#pragma unroll
                for (int n = 0; n < 2; ++n) acc[a][b][m][n] = (f32x4){0.f, 0.f, 0.f, 0.f};
    bf16x8 At[4][2], B0[2][2], B1[2][2];
    const char* cA = (const char*)g.A + (size_t)cur.pm * tstep; const char* cB = (const char*)g.Bt + (size_t)cur.pn * tstep;
    S.a_ready(cur);
    if constexpr (SP2) {
        PG8_STAGE(PG8_SB(0, 0), cB, voffB); PG8_STAGE(PG8_SB(0, 1), cB + hstep, voffB); PG8_STAGE(PG8_SA(0, 0), cA, voffA); PG8_STAGE(PG8_SA(0, 1), cA + hstep, voffA);
        if (wr == 1) PG8_BAR;
        PG8_WAIT_V(2); PG8_BAR;
        PG8_STAGE(PG8_SB(1, 0), cB + kstep, voffB); PG8_STAGE(PG8_SA(1, 0), cA + kstep, voffA); PG8_STAGE(PG8_SB(1, 1), cB + hstep + kstep, voffB);
        PG8_WAIT_V(6); PG8_BAR;
    } else {
        PG8_STAGE(PG8_SB(0, 0), cB, voffB); PG8_STAGE(PG8_SA(0, 0), cA, voffA); PG8_STAGE(PG8_SB(0, 1), cB + hstep, voffB); PG8_STAGE(PG8_SA(0, 1), cA + hstep, voffA);
        if (wr == 1) PG8_BAR;
        PG8_WAIT_V(4); PG8_BAR;
        PG8_STAGE(PG8_SB(1, 0), cB + kstep, voffB); PG8_STAGE(PG8_SA(1, 0), cA + kstep, voffA); PG8_STAGE(PG8_SB(1, 1), cB + hstep + kstep, voffB);
        PG8_WAIT_V(6); PG8_BAR;
    }
    for (;;) {
        const bool has_next = S.next(ui + 1, nxt);
        const char* nA = has_next ? (const char*)g.A + (size_t)nxt.pm * tstep : cA; const char* nB = has_next ? (const char*)g.Bt + (size_t)nxt.pn * tstep : cB;
        for (int t = 0; t < nt; t += 2) {
            const bool last = (t == nt - 2);
            const char* a1 = cA + (size_t)(t + 1) * kstep;
            const char* a2 = last ? nA : cA + (size_t)(t + 2) * kstep; const char* b2 = last ? nB : cB + (size_t)(t + 2) * kstep;
            const char* a3 = a2 + kstep; const char* b3 = b2 + kstep;
            if (last && has_next) S.a_ready(nxt);
            if constexpr (SP2) {
            PG8_LDB(B0, 0, 0); PG8_LDB(B1, 0, 1); PG8_SCHED; PG8_LDA(At, 0, 0); PG8_STAGE(PG8_SA(1, 1), a1 + hstep, voffA);
            PG8_WAIT_V(8); PG8_WAIT_L(0); PG8_BAR; PG8_MMA(0, 0, At, B0); PG8_MMA(0, 1, At, B1); PG8_BAR; PG8_SCHED;
            PG8_LDA(At, 0, 1); PG8_STAGE(PG8_SB(0, 0), b2, voffB); PG8_STAGE(PG8_SB(0, 1), b2 + hstep, voffB); PG8_STAGE(PG8_SA(0, 0), a2, voffA);
            PG8_WAIT_V(8); PG8_WAIT_L(0); PG8_BAR; PG8_MMA(1, 0, At, B0); PG8_MMA(1, 1, At, B1); PG8_BAR; PG8_SCHED;
            PG8_LDB(B0, 1, 0); PG8_LDB(B1, 1, 1); PG8_SCHED; PG8_LDA(At, 1, 0); PG8_STAGE(PG8_SA(0, 1), a2 + hstep, voffA);
            PG8_WAIT_V(8); PG8_WAIT_L(0); PG8_BAR; PG8_MMA(0, 0, At, B0); PG8_MMA(0, 1, At, B1); PG8_BAR; PG8_SCHED;
            PG8_LDA(At, 1, 1); PG8_STAGE(PG8_SB(1, 0), b3, voffB); PG8_STAGE(PG8_SB(1, 1), b3 + hstep, voffB); PG8_STAGE(PG8_SA(1, 0), a3, voffA);
            PG8_WAIT_V(8); PG8_WAIT_L(0); PG8_BAR; PG8_MMA(1, 0, At, B0); PG8_MMA(1, 1, At, B1); PG8_BAR; PG8_SCHED;
            } else {
            PG8_LDB(B0, 0, 0); PG8_SCHED; PG8_LDA(At, 0, 0); PG8_STAGE(PG8_SA(1, 1), a1 + hstep, voffA);
            PG8_WAIT_L(8); PG8_BAR; PG8_WAIT_L(0); PG8_MMA(0, 0, At, B0); PG8_BAR; PG8_SCHED;
            PG8_LDB(B1, 0, 1); PG8_STAGE(PG8_SB(0, 0), b2, voffB);
            PG8_BAR; PG8_WAIT_L(0); PG8_MMA(0, 1, At, B1); PG8_BAR;
            PG8_LDA(At, 0, 1); PG8_STAGE(PG8_SA(0, 0), a2, voffA);
            PG8_BAR; PG8_WAIT_L(0); PG8_MMA(1, 0, At, B0); PG8_BAR; PG8_SCHED;
            PG8_STAGE(PG8_SB(0, 1), b2 + hstep, voffB);
            PG8_WAIT_V(6); PG8_BAR; PG8_MMA(1, 1, At, B1); PG8_BAR;
            PG8_LDB(B0, 1, 0); PG8_SCHED; PG8_LDA(At, 1, 0); PG8_STAGE(PG8_SA(0, 1), a2 + hstep, voffA);
            PG8_WAIT_L(8); PG8_BAR; PG8_WAIT_L(0); PG8_MMA(0, 0, At, B0); PG8_BAR; PG8_SCHED;
            PG8_LDB(B1, 1, 1); PG8_STAGE(PG8_SB(1, 0), b3, voffB);
            PG8_BAR; PG8_WAIT_L(0); PG8_MMA(0, 1, At, B1); PG8_BAR;
            PG8_LDA(At, 1, 1); PG8_STAGE(PG8_SA(1, 0), a3, voffA);
            PG8_BAR; PG8_WAIT_L(0); PG8_MMA(1, 0, At, B0); PG8_BAR; PG8_SCHED;
            PG8_STAGE(PG8_SB(1, 1), b3 + hstep, voffB);
            PG8_WAIT_V(6); PG8_BAR; PG8_MMA(1, 1, At, B1); PG8_BAR;
            }
        }
        if constexpr (ALIGN_EPI) { if (wr == 0) PG8_BAR; }
        if constexpr (!Epi::AFTER_DRAIN) { E(acc, cur, wr, wc, fr, fq); S.done(cur); }
        if (!has_next) break;
#pragma unroll
        for (int a = 0; a < 2; ++a)
#pragma unroll
            for (int b = 0; b < 2; ++b)
#pragma unroll
                for (int m = 0; m < 4; ++m)
#pragma unroll
                    for (int n = 0; n < 2; ++n) acc[a][b][m][n] = (f32x4){0.f, 0.f, 0.f, 0.f};
        cur = nxt; cA = nA; cB = nB; ++ui;
        if constexpr (ALIGN_EPI) { if (wr == 1) PG8_BAR; }
    }
    PG8_WAIT_V(0);
    if constexpr (!ALIGN_EPI) { if (wr == 0) PG8_BAR; }
    PG8_BAR;
    if constexpr (Epi::AFTER_DRAIN) { E.fused(acc, cur, wr, wc, fr, fq, lds, wid, lane); S.done(cur); }
#undef PG8_SA
#undef PG8_SB
#undef PG8_STAGE
#undef PG8_LDA
#undef PG8_LDB
#undef PG8_MMA
#undef PG8_WAIT_V
#undef PG8_WAIT_L
#undef PG8_BAR
#undef PG8_SCHED
}
}

constexpr int DM = 1024, TP = 4096, BP = 4, MPR = BP * TP, BS = 8, TS = 16, MR = MPR + BS * TS, MP = 16640;
constexpr int DFF = 2816, NFF = 2 * DFF, INW = 5376, SHW = 1792, PAST = 4096, NPOS = PAST + TS;
constexpr float EPS = 1e-6f, LNX_EPS = 64e-5f;
constexpr float QSCALE = 0.125f * 1.4426950408889634f;
constexpr size_t O_Y = 0, O_KP = (size_t)MR * DM, O_VP = O_KP + (size_t)MPR * 512, O_SP = O_VP + (size_t)MPR * 512, O_SHP = O_SP + 131072,
                 O_KS = O_SHP + 7168, O_VS = O_KS + 65536, O_SS = O_VS + 65536, O_SHS = O_SS + 262144, O_END = O_SHS + 14336;
constexpr size_t KiB = 1024, MiB = 1u << 20;
constexpr size_t WS_W1T = 0, WS_W2T = 11 * MiB, WS_WINT = 16 * MiB + 512 * KiB, WS_WAT = 27 * MiB, WS_WRT = 28 * MiB, WS_WOT = 29 * MiB, WS_W3T = 31 * MiB, WS_W4T = 42 * MiB,
                 WS_TAB = 48 * MiB, WS_CTR = 49 * MiB + 512 * KiB, WS_ORW = 0,
                 WS_XN = 50 * MiB, WS_ABUF = 50 * MiB, WS_GG = 66 * MiB + 256 * KiB, WS_MG = 50 * MiB,
                 WS_G = 82 * MiB + 512 * KiB, WS_QB = WS_G, WS_KB = 98 * MiB + 768 * KiB, WS_VT = 115 * MiB, WS_ZRW = 131 * MiB + 256 * KiB,
                 WS_GATE = 188 * MiB + 128 * KiB, WS_DEC = 253 * MiB + 128 * KiB, WS_T = WS_KB, WS_F = 171 * MiB + 896 * KiB, WS_NEED = 286 * MiB;
constexpr size_t WS_LW = 49 * MiB + 64 * KiB;
static_assert(WS_ZRW + (size_t)MP * SHW * 2 <= WS_GATE && WS_GATE + (size_t)MP * 2048 * 2 <= WS_DEC && WS_DEC + (size_t)MP * 512 * 4 <= WS_NEED, "ws map");
static_assert(WS_G + (size_t)MP * DFF * 2 <= WS_F && WS_F + (size_t)MP * DM * 4 <= WS_NEED && WS_T + (size_t)MP * DM * 4 <= WS_F, "ws map 2");
static_assert(WS_XN + (size_t)MP * DM * 2 <= WS_G && WS_ORW + (size_t)MP * 512 * 2 <= WS_WINT && WS_VT + (size_t)MP * 512 * 2 <= WS_ZRW, "ws map 3");

#define LAS __attribute__((address_space(3)))
typedef unsigned short bf16_t;
typedef short bf16x8 __attribute__((ext_vector_type(8)));
typedef float f32x4 __attribute__((ext_vector_type(4)));
typedef float f32x2 __attribute__((ext_vector_type(2)));
typedef unsigned u32x4 __attribute__((ext_vector_type(4)));
typedef unsigned u32x2 __attribute__((ext_vector_type(2)));
typedef __bf16 bf16x2_t __attribute__((ext_vector_type(2)));
using pg8::Unit;

__device__ __forceinline__ unsigned pk2(float lo, float hi) { f32x2 v = {lo, hi}; bf16x2_t b = __builtin_convertvector(v, bf16x2_t); return __builtin_bit_cast(unsigned, b); }
__device__ __forceinline__ bf16_t f2bf(float f) { return (bf16_t)(pk2(f, 0.f) & 0xffffu); }
__device__ __forceinline__ float bf2f(bf16_t h) { return __uint_as_float((unsigned)h << 16); }
__device__ __forceinline__ float bflo(unsigned w) { return __uint_as_float(w << 16); }
__device__ __forceinline__ float bfhi(unsigned w) { return __uint_as_float(w & 0xffff0000u); }
__device__ __forceinline__ float fexp2(float x) { return __builtin_amdgcn_exp2f(x); }
__device__ __forceinline__ float frcp(float x) { return __builtin_amdgcn_rcpf(x); }
__device__ __forceinline__ float sigmoidf_(float x) { return frcp(1.f + fexp2(-1.4426950408889634f * x)); }
template <int CTRL> __device__ __forceinline__ float dpp_add_(float x) {
    return x + __builtin_bit_cast(float, __builtin_amdgcn_update_dpp(0, __builtin_bit_cast(int, x), CTRL, 0xf, 0xf, true));
}
__device__ __forceinline__ float wave_sum_fast(float x) {
    x = dpp_add_<0xB1>(x); x = dpp_add_<0x4E>(x); x = dpp_add_<0x141>(x); x = dpp_add_<0x140>(x);
    { auto rr = __builtin_amdgcn_permlane16_swap(__float_as_uint(x), __float_as_uint(x), false, false); x = __uint_as_float(rr[0]) + __uint_as_float(rr[1]); }
    { auto rr = __builtin_amdgcn_permlane32_swap(__float_as_uint(x), __float_as_uint(x), false, false); x = __uint_as_float(rr[0]) + __uint_as_float(rr[1]); }
    return x;
}
__device__ __forceinline__ float wave_sum(float v) { return wave_sum_fast(v); }
__device__ __forceinline__ float half_sum(float v) {
#pragma unroll
    for (int o = 1; o < 32; o <<= 1) v += __shfl_xor(v, o);
    return v;
}

struct Params {
    const float* in[36];
    float* out;
    unsigned char* ws;
    int ph_lo, ph_hi;
};
struct Ctx {
    const LAS unsigned* tab;
    __device__ __forceinline__ const void* ptr(int i) const {
        const unsigned lo = __builtin_amdgcn_readfirstlane(tab[2 * i]), hi = __builtin_amdgcn_readfirstlane(tab[2 * i + 1]);
        return (const void*)(const __attribute__((address_space(1))) void*)(((unsigned long long)hi << 32) | lo);
    }
    __device__ __forceinline__ const float* in(int i) const { return (const float*)ptr(i); }
    __device__ __forceinline__ float* out() const { return (float*)ptr(36); }
    __device__ __forceinline__ unsigned char* ws() const { return (unsigned char*)ptr(37); }
};

struct EpiSwiglu {
    static constexpr bool PERM = true, AFTER_DRAIN = false;
    bf16_t* O;
    __device__ __forceinline__ void operator()(const f32x4 (&acc)[2][2][4][2], const Unit& u, int wr, int wc, int fr, int fq) const {
        const int col0 = u.pn * 128 + wc * 32 + 8 * fq;
#pragma unroll
        for (int ai = 0; ai < 2; ++ai)
#pragma unroll
            for (int m = 0; m < 4; ++m) {
                const int row = u.pm * 256 + ai * 128 + wr * 64 + m * 16 + fr;
                float v[8];
#pragma unroll
                for (int n = 0; n < 2; ++n)
#pragma unroll
                    for (int i = 0; i < 4; ++i) { const float g = acc[ai][0][m][n][i], up = acc[ai][1][m][n][i]; v[n * 4 + i] = g * sigmoidf_(g) * up; }
                u32x4 w; w.x = pk2(v[0], v[1]); w.y = pk2(v[2], v[3]); w.z = pk2(v[4], v[5]); w.w = pk2(v[6], v[7]);
                if (row < MR) *(u32x4*)(O + (size_t)row * DFF + col0) = w;
                asm volatile("" ::: "memory");
            }
    }
};
struct EpiF32 {
    static constexpr bool PERM = false, AFTER_DRAIN = false;
    float* O;
    __device__ __forceinline__ void operator()(const f32x4 (&acc)[2][2][4][2], const Unit& u, int wr, int wc, int fr, int fq) const {
        const int col0 = u.pn * 256 + wc * 32 + 4 * fq;
#pragma unroll
        for (int ai = 0; ai < 2; ++ai)
#pragma unroll
            for (int m = 0; m < 4; ++m) {
                const int row = u.pm * 256 + ai * 128 + wr * 64 + m * 16 + fr;
                if (row < MR) {
#pragma unroll
                    for (int bj = 0; bj < 2; ++bj)
#pragma unroll
                        for (int n = 0; n < 2; ++n) *(f32x4*)(O + (size_t)row * DM + col0 + bj * 128 + n * 16) = acc[ai][bj][m][n];
                }
                asm volatile("" ::: "memory");
            }
    }
};
struct EpiGate1 {
    static constexpr bool PERM = true, AFTER_DRAIN = false;
    bf16_t* T; const bf16_t* GATE;
    __device__ __forceinline__ void operator()(const f32x4 (&acc)[2][2][4][2], const Unit& u, int wr, int wc, int fr, int fq) const {
        const int col0 = u.pn * 256 + wc * 32 + 8 * fq;
#pragma unroll
        for (int ai = 0; ai < 2; ++ai)
#pragma unroll
            for (int m = 0; m < 4; ++m) {
                const int row = u.pm * 256 + ai * 128 + wr * 64 + m * 16 + fr;
                if (row < MR) {
#pragma unroll
                    for (int bj = 0; bj < 2; ++bj) {
                        const u32x4 gv = *(const u32x4*)(GATE + (size_t)row * 2048 + col0 + bj * 128);
                        f32x4 a = acc[ai][bj][m][0], b = acc[ai][bj][m][1];
                        a[0] *= bflo(gv.x); a[1] *= bfhi(gv.x); a[2] *= bflo(gv.y); a[3] *= bfhi(gv.y);
                        b[0] *= bflo(gv.z); b[1] *= bfhi(gv.z); b[2] *= bflo(gv.w); b[3] *= bfhi(gv.w);
                        u32x4 w; w.x = pk2(a[0], a[1]); w.y = pk2(a[2], a[3]); w.z = pk2(b[0], b[1]); w.w = pk2(b[2], b[3]);
                        *(u32x4*)(T + (size_t)row * DM + col0 + bj * 128) = w;
                    }
                }
                asm volatile("" ::: "memory");
            }
    }
};
struct EpiGate2 {
    static constexpr bool PERM = true, AFTER_DRAIN = false;
    const bf16_t* T; const bf16_t* GATE; bf16_t* MG;
    __device__ __forceinline__ void operator()(const f32x4 (&acc)[2][2][4][2], const Unit& u, int wr, int wc, int fr, int fq) const {
        const int col0 = u.pn * 256 + wc * 32 + 8 * fq;
#pragma unroll
        for (int ai = 0; ai < 2; ++ai)
#pragma unroll
            for (int m = 0; m < 4; ++m) {
                const int row = u.pm * 256 + ai * 128 + wr * 64 + m * 16 + fr;
                if (row < MR) {
#pragma unroll
                    for (int bj = 0; bj < 2; ++bj) {
                        const u32x4 gv = *(const u32x4*)(GATE + (size_t)row * 2048 + 1024 + col0 + bj * 128);
                        const u32x4 tv = *(const u32x4*)(T + (size_t)row * DM + col0 + bj * 128);
                        f32x4 a = (f32x4){bflo(tv.x), bfhi(tv.x), bflo(tv.y), bfhi(tv.y)}, b = (f32x4){bflo(tv.z), bfhi(tv.z), bflo(tv.w), bfhi(tv.w)};
                        const f32x4 x = acc[ai][bj][m][0], y = acc[ai][bj][m][1];
                        a[0] += x[0] * bflo(gv.x); a[1] += x[1] * bfhi(gv.x); a[2] += x[2] * bflo(gv.y); a[3] += x[3] * bfhi(gv.y);
                        b[0] += y[0] * bflo(gv.z); b[1] += y[1] * bfhi(gv.z); b[2] += y[2] * bflo(gv.w); b[3] += y[3] * bfhi(gv.w);
                        u32x4 w; w.x = pk2(a[0], a[1]); w.y = pk2(a[2], a[3]); w.z = pk2(b[0], b[1]); w.w = pk2(b[2], b[3]);
                        *(u32x4*)(MG + (size_t)row * DM + col0 + bj * 128) = w;
                    }
                }
                asm volatile("" ::: "memory");
            }
    }
};
struct EpiZ {
    static constexpr bool PERM = true, AFTER_DRAIN = false;
    float* out; bf16_t *QB, *KB, *VT, *ZRW, *GATE; const f32x2* TAB;
    __device__ __forceinline__ void operator()(const f32x4 (&acc)[2][2][4][2], const Unit& u, int wr, int wc, int fr, int fq) const {
        const int pn = u.pn;
#pragma unroll
        for (int ai = 0; ai < 2; ++ai)
#pragma unroll
            for (int m = 0; m < 4; ++m) {
                const int row = u.pm * 256 + ai * 128 + wr * 64 + m * 16 + fr;
                asm volatile("" ::: "memory");
                if (row >= MR) continue;
                const bool smp = row >= MPR;
                if (pn < 4) {
                    const int pos = smp ? PAST + ((row - MPR) & 15) : (row & (TP - 1));
                    const int d0 = 8 * fq;
                    float o1[8], o2[8];
#pragma unroll
                    for (int n = 0; n < 2; ++n)
#pragma unroll
                        for (int i = 0; i < 4; ++i) {
                            const f32x2 cs = TAB[pos * 32 + d0 + n * 4 + i];
                            const float x1 = acc[ai][0][m][n][i], x2 = acc[ai][1][m][n][i];
                            o1[n * 4 + i] = x1 * cs.x - x2 * cs.y; o2[n * 4 + i] = x1 * cs.y + x2 * cs.x;
                        }
                    const int cb = (pn & 1) * 256 + 64 * wc + d0;
                    if (pn < 2) {
                        u32x4 w1, w2;
                        w1.x = pk2(o1[0] * QSCALE, o1[1] * QSCALE); w1.y = pk2(o1[2] * QSCALE, o1[3] * QSCALE); w1.z = pk2(o1[4] * QSCALE, o1[5] * QSCALE); w1.w = pk2(o1[6] * QSCALE, o1[7] * QSCALE);
                        w2.x = pk2(o2[0] * QSCALE, o2[1] * QSCALE); w2.y = pk2(o2[2] * QSCALE, o2[3] * QSCALE); w2.z = pk2(o2[4] * QSCALE, o2[5] * QSCALE); w2.w = pk2(o2[6] * QSCALE, o2[7] * QSCALE);
                        *(u32x4*)(QB + (size_t)row * 512 + cb) = w1; *(u32x4*)(QB + (size_t)row * 512 + cb + 32) = w2;
                    } else {
                        float* ko = smp ? out + O_KS + (size_t)(row - MPR) * 512 + cb : out + O_KP + (size_t)row * 512 + cb;
                        *(f32x4*)ko = (f32x4){o1[0], o1[1], o1[2], o1[3]}; *(f32x4*)(ko + 4) = (f32x4){o1[4], o1[5], o1[6], o1[7]};
                        *(f32x4*)(ko + 32) = (f32x4){o2[0], o2[1], o2[2], o2[3]}; *(f32x4*)(ko + 36) = (f32x4){o2[4], o2[5], o2[6], o2[7]};
                        u32x4 w1, w2;
                        w1.x = pk2(o1[0], o1[1]); w1.y = pk2(o1[2], o1[3]); w1.z = pk2(o1[4], o1[5]); w1.w = pk2(o1[6], o1[7]);
                        w2.x = pk2(o2[0], o2[1]); w2.y = pk2(o2[2], o2[3]); w2.z = pk2(o2[4], o2[5]); w2.w = pk2(o2[6], o2[7]);
                        *(u32x4*)(KB + (size_t)row * 512 + cb) = w1; *(u32x4*)(KB + (size_t)row * 512 + cb + 32) = w2;
                    }
                } else {
#pragma unroll
                    for (int bj = 0; bj < 2; ++bj) {
                        const int c = pn * 256 + bj * 128 + wc * 32 + 8 * fq;
                        const f32x4 a = acc[ai][bj][m][0], b = acc[ai][bj][m][1];
                        if (pn < 6) {
                            const int vc = c - 1024;
                            float* vo = smp ? out + O_VS + (size_t)(row - MPR) * 512 + vc : out + O_VP + (size_t)row * 512 + vc;
                            *(f32x4*)vo = a; *(f32x4*)(vo + 4) = b;
                            if (!smp) {
                                const int bb = row >> 12, t = row & (TP - 1), hh = vc >> 7, dd = vc & 127;
                                bf16_t* vt = VT + ((size_t)(bb * 4 + hh) * 128 + dd) * TP + t;
                                vt[0] = f2bf(a[0]); vt[TP] = f2bf(a[1]); vt[2 * TP] = f2bf(a[2]); vt[3 * TP] = f2bf(a[3]);
                                vt[4 * TP] = f2bf(b[0]); vt[5 * TP] = f2bf(b[1]); vt[6 * TP] = f2bf(b[2]); vt[7 * TP] = f2bf(b[3]);
                            }
                        } else if (pn < 13) {
                            const int zc = c - 1536;
                            u32x4 w; w.x = pk2(a[0], a[1]); w.y = pk2(a[2], a[3]); w.z = pk2(b[0], b[1]); w.w = pk2(b[2], b[3]);
                            *(u32x4*)(ZRW + (size_t)row * SHW + zc) = w;
                            const bool last = smp ? (((row - MPR) & 15) == 15) : ((row & (TP - 1)) == TP - 1);
                            if (last) { float* so = smp ? out + O_SHS + (size_t)((row - MPR) >> 4) * SHW + zc : out + O_SHP + (size_t)(row >> 12) * SHW + zc;
                                *(f32x4*)so = a; *(f32x4*)(so + 4) = b; }
                        } else {
                            const int gc = c - 3328;
                            u32x4 w; w.x = pk2(sigmoidf_(a[0]), sigmoidf_(a[1])); w.y = pk2(sigmoidf_(a[2]), sigmoidf_(a[3])); w.z = pk2(sigmoidf_(b[0]), sigmoidf_(b[1])); w.w = pk2(sigmoidf_(b[2]), sigmoidf_(b[3]));
                            *(u32x4*)(GATE + (size_t)row * 2048 + gc) = w;
                        }
                    }
                }
            }
    }
};

__device__ __forceinline__ void transpose_item(const float* W, int K, int N, bf16_t* WT, int k0, int n0, int drow0, LAS float* scr, int lane) {
#pragma unroll 8
    for (int i = 0; i < 32; ++i) { const int kk = 2 * i + (lane >> 5); scr[kk * 33 + (lane & 31)] = W[(size_t)(k0 + kk) * N + n0 + (lane & 31)]; }
    asm volatile("s_waitcnt lgkmcnt(0)" ::: "memory");
    const int c = lane & 7;
#pragma unroll
    for (int j = 0; j < 4; ++j) { const int n = (lane >> 3) + 8 * j; const LAS float* s = scr + (8 * c) * 33 + n;
        u32x4 o; o.x = pk2(s[0 * 33], s[1 * 33]); o.y = pk2(s[2 * 33], s[3 * 33]); o.z = pk2(s[4 * 33], s[5 * 33]); o.w = pk2(s[6 * 33], s[7 * 33]);
        *(u32x4*)(WT + (size_t)(drow0 + n) * K + k0 + 8 * c) = o; }
    asm volatile("s_waitcnt lgkmcnt(0)" ::: "memory");
}
__device__ __forceinline__ int map_w1(int n) { return n < DFF ? 256 * (n >> 7) + (n & 127) : 256 * ((n - DFF) >> 7) + 128 + ((n - DFF) & 127); }
__device__ __forceinline__ int map_win(int n) { return n < 1024 ? (n & ~255) + 128 * ((n >> 5) & 1) + 32 * ((n >> 6) & 3) + (n & 31) : n; }

__device__ __forceinline__ void sincos_d(double ang, float& c, float& s) {
    const double TWO_PI = 6.283185307179586476925286766559, HALF_PI = 1.5707963267948966192313216916398;
    double r = ang - TWO_PI * __builtin_rint(ang / TWO_PI);
    const double qd = __builtin_rint(r / HALF_PI); const int q = (int)qd; r -= qd * HALF_PI;
    const double r2 = r * r;
    double sp = r * (1.0 + r2 * (-1.0 / 6 + r2 * (1.0 / 120 + r2 * (-1.0 / 5040 + r2 * (1.0 / 362880 + r2 * (-1.0 / 39916800 + r2 * (1.0 / 6227020800.0)))))));
    double cp = 1.0 + r2 * (-0.5 + r2 * (1.0 / 24 + r2 * (-1.0 / 720 + r2 * (1.0 / 40320 + r2 * (-1.0 / 3628800 + r2 * (1.0 / 479001600.0 + r2 * (-1.0 / 87178291200.0)))))));
    double cc, ss;
    switch (q & 3) { case 0: cc = cp; ss = sp; break; case 1: cc = -sp; ss = cp; break; case 2: cc = -cp; ss = -sp; break; default: cc = sp; ss = -cp; break; }
    c = (float)cc; s = (float)ss;
}
__device__ __forceinline__ void rms_row_to_bf16(const float* xrow, const float* g, bf16_t* orow, int lane) {
    const f32x4* xr = (const f32x4*)xrow + lane; const f32x4* gr = (const f32x4*)g + lane;
    f32x4 v[4]; float s = 0.f;
#pragma unroll
    for (int j = 0; j < 4; ++j) { v[j] = xr[64 * j]; s += (v[j].x * v[j].x + v[j].y * v[j].y) + (v[j].z * v[j].z + v[j].w * v[j].w); }
    const float rs = 1.f / sqrtf(wave_sum(s) * (1.f / DM) + EPS);
    u32x2* o8 = (u32x2*)orow + lane;
#pragma unroll
    for (int j = 0; j < 4; ++j) { const f32x4 gg = gr[64 * j]; u32x2 w; w.x = pk2(v[j].x * rs * gg.x, v[j].y * rs * gg.y); w.y = pk2(v[j].z * rs * gg.z, v[j].w * rs * gg.w); o8[64 * j] = w; }
}
__device__ __forceinline__ const float* xrow_ptr(const Ctx& p, int row) { return row < MPR ? p.in(0) + (size_t)row * DM : p.in(1) + (size_t)(row - MPR) * DM; }

__device__ __forceinline__ void prologue_part2(const Ctx& p, LAS unsigned char* lds, int bidx, int nblk) {
    const int tid = threadIdx.x, lane = tid & 63, wave = __builtin_amdgcn_readfirstlane(tid >> 6);
    const int gw = bidx * 8 + wave, NGW = nblk * 8;
    unsigned char* ws = p.ws();
    LAS float* scr = (LAS float*)(lds + wave * 16384);
    constexpr int I2 = 44 * 32, I3 = 16 * 168, I4 = 8 * 32, I5 = 8 * 32, I6 = 16 * 32;
    __syncthreads();
    for (int it = gw; it < I2 + I3 + I4 + I5 + I6; it += NGW) {
        int r = it;
        if (r < I2) { const int kb = r / 32, nb = r % 32; transpose_item(p.in(8), DFF, DM, (bf16_t*)(ws + WS_W2T), 64 * kb, 32 * nb, 32 * nb, scr, lane); continue; } r -= I2;
        if (r < I3) { const int kb = r / 168, nb = r % 168; transpose_item(p.in(11), DM, INW, (bf16_t*)(ws + WS_WINT), 64 * kb, 32 * nb, map_win(32 * nb), scr, lane); continue; } r -= I3;
        if (r < I4) { const int kb = r / 32, nb = r % 32; transpose_item(p.in(28), 512, DM, (bf16_t*)(ws + WS_WAT), 64 * kb, 32 * nb, 32 * nb, scr, lane); continue; } r -= I4;
        if (r < I5) { const int kb = r / 32, nb = r % 32; transpose_item(p.in(29), 512, DM, (bf16_t*)(ws + WS_WRT), 64 * kb, 32 * nb, 32 * nb, scr, lane); continue; } r -= I5;
        { const int kb = r / 32, nb = r % 32; transpose_item(p.in(30), DM, DM, (bf16_t*)(ws + WS_WOT), 64 * kb, 32 * nb, 32 * nb, scr, lane); }
    }
    {   bf16_t* LW = (bf16_t*)(ws + WS_LW);
        for (int e = bidx * 512 + tid; e < 512 * 256; e += nblk * 512) {
            const int n = e & 511, k = e >> 9;
            if (k < 64) LW[n * 64 + k] = f2bf(p.in(19)[k * 512 + n]);
            else if (k < 128) LW[512 * 64 + n * 64 + (k - 64)] = f2bf(p.in(21)[(k - 64) * 512 + n]);
            else LW[2 * 512 * 64 + n * 128 + (k - 128)] = f2bf(p.in(22)[(k - 128) * 512 + n]);
        } }
    for (int e = bidx * 512 + tid; e < NPOS * 32; e += nblk * 512) {
        const int pos = e >> 5, d = e & 31;
        const double inv = exp(-(double)d * (9.210340371976182736071965818737 / 32.0));
        float c, s; sincos_d((double)pos * inv, c, s);
        ((f32x2*)(ws + WS_TAB))[e] = (f32x2){c, s};
    }
}
__device__ __forceinline__ void phase_prologue(const Ctx& p, LAS unsigned char* lds) {
    const int tid = threadIdx.x, lane = tid & 63, wave = __builtin_amdgcn_readfirstlane(tid >> 6);
    const int gw = blockIdx.x * 8 + wave, NGW = gridDim.x * 8;
    unsigned char* ws = p.ws();
    LAS float* scr = (LAS float*)(lds + wave * 16384);
    constexpr int I1 = 16 * 176;
    for (int it = gw; it < I1; it += NGW) { const int kb = it / 176, nb = it % 176; transpose_item(p.in(7), DM, NFF, (bf16_t*)(ws + WS_W1T), 64 * kb, 32 * nb, map_w1(32 * nb), scr, lane); }
    bf16_t* XN = (bf16_t*)(ws + WS_XN);
    {   f32x4 g4[4], v[4], v2[4];
#pragma unroll
        for (int j = 0; j < 4; ++j) g4[j] = ((const f32x4*)p.in(6))[lane + 64 * j];
        if (gw < MR) {
#pragma unroll
            for (int j = 0; j < 4; ++j) v[j] = ((const f32x4*)xrow_ptr(p, gw))[lane + 64 * j]; }
        for (int m = gw; m < MP; m += NGW) {
            const int mn = m + NGW;
            if (mn < MR) {
#pragma unroll
                for (int j = 0; j < 4; ++j) v2[j] = ((const f32x4*)xrow_ptr(p, mn))[lane + 64 * j]; }
            u32x2* o8 = (u32x2*)(XN + (size_t)m * DM) + lane;
            if (m < MR) {
                float sq = 0.f;
#pragma unroll
                for (int j = 0; j < 4; ++j) sq += (v[j].x * v[j].x + v[j].y * v[j].y) + (v[j].z * v[j].z + v[j].w * v[j].w);
                const float rs = 1.f / sqrtf(wave_sum(sq) * (1.f / DM) + EPS);
#pragma unroll
                for (int j = 0; j < 4; ++j) { u32x2 w; w.x = pk2(v[j].x * rs * g4[j].x, v[j].y * rs * g4[j].y); w.y = pk2(v[j].z * rs * g4[j].z, v[j].w * rs * g4[j].w); o8[64 * j] = w; }
            } else {
#pragma unroll
                for (int j = 0; j < 4; ++j) o8[64 * j] = (u32x2){0u, 0u}; }
#pragma unroll
            for (int j = 0; j < 4; ++j) v[j] = v2[j];
        }
    }
}

__device__ __forceinline__ void phase_rowpass(const Ctx& p, const float* F, int base_is_x, float alpha, const float* gpost, const float* gnext, bf16_t* XN, const float* PART, int nsplit) {
    const int tid = threadIdx.x, lane = tid & 63, wave = __builtin_amdgcn_readfirstlane(tid >> 6);
    const int gw = blockIdx.x * 8 + wave, NGW = gridDim.x * 8;
    float* H = p.out() + O_Y;
    auto loadrow = [&](int m, f32x4 (&f)[4], f32x4 (&b)[4]) {
        const f32x4* fr = (const f32x4*)(F + (size_t)m * DM) + lane;
        const f32x4* br = (const f32x4*)(base_is_x ? xrow_ptr(p, m) : H + (size_t)m * DM) + lane;
#pragma unroll
        for (int j = 0; j < 4; ++j) { b[j] = br[64 * j];
            if (m < MPR) f[j] = fr[64 * j];
            else { f[j] = (f32x4){0.f, 0.f, 0.f, 0.f};
                for (int ks = 0; ks < nsplit; ++ks) f[j] = f[j] + ((const f32x4*)(PART + ((size_t)ks * 128 + (m - MPR)) * DM))[lane + 64 * j]; } }
    };
    f32x4 gp[4], gn[4];
#pragma unroll
    for (int j = 0; j < 4; ++j) { gp[j] = ((const f32x4*)gpost)[lane + 64 * j]; gn[j] = gnext ? ((const f32x4*)gnext)[lane + 64 * j] : (f32x4){0.f, 0.f, 0.f, 0.f}; }
    f32x4 f[4], b[4], f2[4], b2[4];
    if (gw < MR) loadrow(gw, f, b);
    for (int m = gw; m < MR; m += NGW) {
        const bool more = m + NGW < MR;
        if (more) loadrow(m + NGW, f2, b2);
        float s = 0.f;
#pragma unroll
        for (int j = 0; j < 4; ++j) s += (f[j].x * f[j].x + f[j].y * f[j].y) + (f[j].z * f[j].z + f[j].w * f[j].w);
        const float rs = alpha / sqrtf(wave_sum_fast(s) * (1.f / DM) + EPS);
        float s2 = 0.f;
#pragma unroll
        for (int j = 0; j < 4; ++j) { b[j] = b[j] + f[j] * rs * gp[j]; s2 += (b[j].x * b[j].x + b[j].y * b[j].y) + (b[j].z * b[j].z + b[j].w * b[j].w);
            ((f32x4*)(H + (size_t)m * DM))[lane + 64 * j] = b[j]; }
        if (gnext) {
            const float r2 = 1.f / sqrtf(wave_sum_fast(s2) * (1.f / DM) + EPS);
            u32x2* o8 = (u32x2*)(XN + (size_t)m * DM) + lane;
#pragma unroll
            for (int j = 0; j < 4; ++j) { u32x2 w; w.x = pk2(b[j].x * r2 * gn[j].x, b[j].y * r2 * gn[j].y); w.y = pk2(b[j].z * r2 * gn[j].z, b[j].w * r2 * gn[j].w); o8[64 * j] = w; }
        }
        if (more) {
#pragma unroll
            for (int j = 0; j < 4; ++j) { f[j] = f2[j]; b[j] = b2[j]; } }
    }
}

__device__ __forceinline__ float zshift(const Ctx& p, const bf16_t* ZRW, int row, int c) {
    const float z = bf2f(ZRW[(size_t)row * SHW + c]);
    float prev;
    if (row < MPR) prev = (row & (TP - 1)) ? bf2f(ZRW[(size_t)(row - 1) * SHW + c]) : 0.f;
    else { const int r = row - MPR; prev = (r & 15) ? bf2f(ZRW[(size_t)(row - 1) * SHW + c]) : p.in(5)[(size_t)(r >> 4) * SHW + c]; }
    return z + (prev - z) * p.in(17)[c];
}
__device__ __forceinline__ void unpack8(const u32x4 w, float (&f)[8]) { f[0] = bflo(w.x); f[1] = bfhi(w.x); f[2] = bflo(w.y); f[3] = bfhi(w.y); f[4] = bflo(w.z); f[5] = bfhi(w.z); f[6] = bflo(w.w); f[7] = bfhi(w.w); }
__device__ __forceinline__ void zshift8(const Ctx& p, const bf16_t* ZRW, int row, int c, const float (&mu)[8], float (&o)[8]) {
    float z[8], pv[8];
    unpack8(*(const u32x4*)(ZRW + (size_t)row * SHW + c), z);
    bool first; int bsmp = 0;
    if (row < MPR) first = (row & (TP - 1)) == 0; else { first = ((row - MPR) & 15) == 0; bsmp = (row - MPR) >> 4; }
    if (!first) unpack8(*(const u32x4*)(ZRW + (size_t)(row - 1) * SHW + c), pv);
    else if (row < MPR) {
#pragma unroll
        for (int e = 0; e < 8; ++e) pv[e] = 0.f;
    } else { const float* s0 = p.in(5) + (size_t)bsmp * SHW + c;
#pragma unroll
        for (int e = 0; e < 8; ++e) pv[e] = s0[e]; }
#pragma unroll
    for (int e = 0; e < 8; ++e) o[e] = z[e] + (pv[e] - z[e]) * mu[e];
}
__device__ __forceinline__ void phase_lora(const Ctx& p, LAS unsigned char* lds) {
    const int tid = threadIdx.x, lane = tid & 63, wave = __builtin_amdgcn_readfirstlane(tid >> 6), q = lane & 15, g = lane >> 4;
    const bf16_t* ZRW = (const bf16_t*)(p.ws() + WS_ZRW);
    float* DEC = (float*)(p.ws() + WS_DEC); bf16_t* AB = (bf16_t*)(p.ws() + WS_ABUF); bf16_t* GG = (bf16_t*)(p.ws() + WS_GG);
    const bf16_t* w2T = (const bf16_t*)(p.ws() + WS_LW); const bf16_t* a2T = w2T + 512 * 64; const bf16_t* g2T = a2T + 512 * 64;
    LAS bf16_t* X = (LAS bf16_t*)(lds + wave * 16 * 264 * 2);
    const float* mu = p.in(17) + 1536;
    for (int it = blockIdx.x + gridDim.x * wave; it < MR / 16; it += gridDim.x * 8) {
        const int r0 = it * 16;
        {
            const int tt = lane >> 2, cq = lane & 3, row = r0 + tt;
#pragma unroll
            for (int j = 0; j < 8; ++j) {
                const int c = cq * 64 + j * 8;
                float m8[8], z[8];
#pragma unroll
                for (int e = 0; e < 8; ++e) m8[e] = mu[c + e];
                zshift8(p, ZRW, row, 1536 + c, m8, z);
#pragma unroll
                for (int e = 0; e < 8; ++e) z[e] = cq == 0 ? tanhf(z[e]) : (cq == 1 ? z[e] : sigmoidf_(z[e]));
                u32x4 w; w.x = pk2(z[0], z[1]); w.y = pk2(z[2], z[3]); w.z = pk2(z[4], z[5]); w.w = pk2(z[6], z[7]);
                *(LAS u32x4*)(X + tt * 264 + c) = w;
            }
        }
        asm volatile("s_waitcnt lgkmcnt(0)" ::: "memory");
        bf16x8 bx[8];
#pragma unroll
        for (int ks = 0; ks < 8; ++ks) bx[ks] = *(const LAS bf16x8*)(X + q * 264 + ks * 32 + 8 * g);
        const int row = r0 + q;
#pragma unroll 2
        for (int nt = 0; nt < 32; ++nt) {
            const int n = nt * 16 + q;
            f32x4 aw = (f32x4){0.f, 0.f, 0.f, 0.f}, aa = aw, ag = aw;
#pragma unroll
            for (int ks = 0; ks < 2; ++ks) {
                aw = __builtin_amdgcn_mfma_f32_16x16x32_bf16(*(const bf16x8*)(w2T + n * 64 + ks * 32 + 8 * g), bx[ks], aw, 0, 0, 0);
                aa = __builtin_amdgcn_mfma_f32_16x16x32_bf16(*(const bf16x8*)(a2T + n * 64 + ks * 32 + 8 * g), bx[2 + ks], aa, 0, 0, 0);
            }
#pragma unroll
            for (int ks = 0; ks < 4; ++ks) ag = __builtin_amdgcn_mfma_f32_16x16x32_bf16(*(const bf16x8*)(g2T + n * 128 + ks * 32 + 8 * g), bx[4 + ks], ag, 0, 0, 0);
            const int c = nt * 16 + 4 * g;
            const f32x4 w0 = *(const f32x4*)(p.in(18) + c), a0 = *(const f32x4*)(p.in(20) + c);
            f32x4 dec; float av[4];
#pragma unroll
            for (int e = 0; e < 4; ++e) {
                const float x = w0[e] + aw[e];
                const float sp = fmaxf(-x, 0.f) + log1pf(expf(-fabsf(x)));
                dec[e] = expf(-expf(-sp - 0.5f));
                av[e] = sigmoidf_(a0[e] + aa[e]);
            }
            *(f32x4*)(DEC + (size_t)row * 512 + c) = dec;
            *(u32x2*)(AB + (size_t)row * 512 + c) = (u32x2){pk2(av[0], av[1]), pk2(av[2], av[3])};
            *(u32x2*)(GG + (size_t)row * 512 + c) = (u32x2){pk2(ag[0], ag[1]), pk2(ag[2], ag[3])};
        }
        asm volatile("s_waitcnt lgkmcnt(0)" ::: "memory");
    }
}

#define MFMA16(a, b, c) __builtin_amdgcn_mfma_f32_16x16x32_bf16((a), (b), (c), 0, 0, 0)
struct AttAcc { f32x4 O[2][8]; float m[2], l[2]; };
__device__ __forceinline__ void att_init(AttAcc& A) {
#pragma unroll
    for (int mm = 0; mm < 2; ++mm) { A.m[mm] = -1e30f; A.l[mm] = 0.f;
#pragma unroll
        for (int d = 0; d < 8; ++d) A.O[mm][d] = (f32x4){0.f, 0.f, 0.f, 0.f}; }
}
template <class LK> __device__ __forceinline__ void att_qk(AttAcc& A, const LK& lk, const bf16x8 (&bq)[2][2], int nvalid, int g, bf16x8 (&bP)[2][2]) {
#pragma unroll
    for (int mm = 0; mm < 2; ++mm) {
        f32x4 s[4];
#pragma unroll
        for (int t = 0; t < 4; ++t) { s[t] = (f32x4){0.f, 0.f, 0.f, 0.f};
#pragma unroll
            for (int ks = 0; ks < 2; ++ks) s[t] = MFMA16(lk(mm, ks, t), bq[mm][ks], s[t]); }
        if (nvalid < 64) {
#pragma unroll
            for (int t = 0; t < 4; ++t)
#pragma unroll
                for (int r = 0; r < 4; ++r) if (16 * t + 4 * g + r >= nvalid) s[t][r] = -1e30f;
        }
        float mx = s[0][0];
#pragma unroll
        for (int t = 0; t < 4; ++t)
#pragma unroll
            for (int r = 0; r < 4; ++r) mx = fmaxf(mx, s[t][r]);
        { auto rr = __builtin_amdgcn_permlane16_swap(__float_as_uint(mx), __float_as_uint(mx), false, false); mx = fmaxf(__uint_as_float(rr[0]), __uint_as_float(rr[1])); }
        { auto rr = __builtin_amdgcn_permlane32_swap(__float_as_uint(mx), __float_as_uint(mx), false, false); mx = fmaxf(__uint_as_float(rr[0]), __uint_as_float(rr[1])); }
        const float mnew = fmaxf(A.m[mm], mx), alpha = fexp2(A.m[mm] - mnew);
        const bool grew = __builtin_amdgcn_ballot_w64(mnew > A.m[mm]) != 0ull;
        A.m[mm] = mnew;
        float ls = 0.f;
#pragma unroll
        for (int t = 0; t < 4; ++t)
#pragma unroll
            for (int r = 0; r < 4; ++r) { s[t][r] = fexp2(s[t][r] - mnew); ls += s[t][r]; }
        A.l[mm] = A.l[mm] * alpha + ls;
        if (grew) {
#pragma unroll
            for (int d = 0; d < 8; ++d) A.O[mm][d] = A.O[mm][d] * alpha;
        }
#pragma unroll
        for (int k2 = 0; k2 < 2; ++k2) {
            u32x4 w; w.x = pk2(s[2 * k2][0], s[2 * k2][1]); w.y = pk2(s[2 * k2][2], s[2 * k2][3]); w.z = pk2(s[2 * k2 + 1][0], s[2 * k2 + 1][1]); w.w = pk2(s[2 * k2 + 1][2], s[2 * k2 + 1][3]);
            bP[mm][k2] = __builtin_bit_cast(bf16x8, w);
        }
        asm volatile("" ::: "memory");
    }
}
__device__ __forceinline__ void att_final(const AttAcc& A, float l0, float l1, float lam, const float* subg, bf16_t* orow, int g) {
    const float i0 = 1.f / l0, i1 = lam / l1;
    f32x4 o[8]; float ss = 0.f;
#pragma unroll
    for (int d = 0; d < 8; ++d) { o[d] = A.O[0][d] * i0 - A.O[1][d] * i1; ss += (o[d][0] * o[d][0] + o[d][1] * o[d][1]) + (o[d][2] * o[d][2] + o[d][3] * o[d][3]); }
    ss += __shfl_xor(ss, 16); ss += __shfl_xor(ss, 32);
    const float rs = 0.8f / sqrtf(ss * (1.f / 128.f) + EPS);
#pragma unroll
    for (int d = 0; d < 8; ++d) { const f32x4 gg = *(const f32x4*)(subg + 16 * d + 4 * g);
        u32x2 w; w.x = pk2(o[d][0] * rs * gg[0], o[d][1] * rs * gg[1]); w.y = pk2(o[d][2] * rs * gg[2], o[d][3] * rs * gg[3]);
        *(u32x2*)(orow + 16 * d + 4 * g) = w; }
}
__device__ __forceinline__ float att_lambda(const Ctx& p, int lane) {
    const float a = wave_sum(p.in(12)[lane] * p.in(13)[lane]), b = wave_sum(p.in(14)[lane] * p.in(15)[lane]);
    return expf(a) - expf(b) + 0.2f;
}
constexpr int KS_STRIDE = 136, VS_STRIDE = 72, ATT_BUF = 64 * KS_STRIDE + 128 * VS_STRIDE;
__device__ __forceinline__ void att_prompt_unit(const Ctx& p, int bh, int qb, LAS unsigned char* lds) {
    const int tid = threadIdx.x, lane = tid & 63, wave = __builtin_amdgcn_readfirstlane(tid >> 6), q = lane & 15, g = lane >> 4;
    const int b = bh >> 2, h = bh & 3;
    bf16_t* QB = (bf16_t*)(p.ws() + WS_QB); const bf16_t* KB = (const bf16_t*)(p.ws() + WS_KB); const bf16_t* VT = (const bf16_t*)(p.ws() + WS_VT);
    const int row = b * TP + qb * 128 + wave * 16 + q;
    bf16_t* qrow = QB + (size_t)row * 512 + h * 128;
    bf16x8 bq[2][2];
#pragma unroll
    for (int mm = 0; mm < 2; ++mm)
#pragma unroll
        for (int ks = 0; ks < 2; ++ks) bq[mm][ks] = *(const bf16x8*)(qrow + mm * 64 + ks * 32 + 8 * g);
    AttAcc A; att_init(A);
    const int nkb = 2 * qb + 2, nkt = 2 * qb + 1 + (wave >> 2);
    const bf16_t* kg = KB + (size_t)(b * TP + (tid >> 4)) * 512 + h * 128 + (tid & 15) * 8;
    const bf16_t* vg = VT + ((size_t)bh * 128 + (tid >> 3)) * TP + (tid & 7) * 8;
    LAS bf16_t* L = (LAS bf16_t*)lds;
    const int kso = (tid >> 4) * KS_STRIDE + (tid & 15) * 8, vsb = 64 * KS_STRIDE + (tid >> 3) * VS_STRIDE + ((tid & 7) >> 2) * 32;
    const int kb_ = (tid & 3) * 8, vso = vsb + 8 * ((kb_ & 15) >> 2) + 4 * (kb_ >> 4), vso2 = vsb + 8 * (((kb_ + 4) & 15) >> 2) + 4 * ((kb_ + 4) >> 4);
    u32x4 k0 = *(const u32x4*)kg, k1 = *(const u32x4*)(kg + 32 * 512), v0 = *(const u32x4*)vg, v1 = *(const u32x4*)(vg + (size_t)64 * TP);
    __syncthreads();
    *(LAS u32x4*)(L + kso) = k0; *(LAS u32x4*)(L + kso + 32 * KS_STRIDE) = k1; *(LAS u32x2*)(L + vso) = (u32x2){v0.x, v0.y}; *(LAS u32x2*)(L + vso2) = (u32x2){v0.z, v0.w}; *(LAS u32x2*)(L + vso + 64 * VS_STRIDE) = (u32x2){v1.x, v1.y}; *(LAS u32x2*)(L + vso2 + 64 * VS_STRIDE) = (u32x2){v1.z, v1.w};
    __syncthreads();
    for (int kt = 0; kt < nkb; ++kt) {
        const LAS bf16_t* Lc = L + (kt & 1) * ATT_BUF;
        LAS bf16_t* Ln = L + ((kt + 1) & 1) * ATT_BUF;
        const bool more = kt + 1 < nkb;
        if (more) { const bf16_t* kn = kg + (size_t)(kt + 1) * 64 * 512; const bf16_t* vn = vg + (kt + 1) * 64;
            k0 = *(const u32x4*)kn; k1 = *(const u32x4*)(kn + 32 * 512); v0 = *(const u32x4*)vn; v1 = *(const u32x4*)(vn + (size_t)64 * TP); }
        if (kt < nkt) {
            bf16x8 bP[2][2];
            const LAS bf16_t* kl = Lc + q * KS_STRIDE + 8 * g;
            att_qk(A, [&](int mm, int ks, int t) { return *(const LAS bf16x8*)(kl + t * 16 * KS_STRIDE + mm * 64 + ks * 32); }, bq, 64, g, bP);
            const LAS bf16_t* vl = Lc + 64 * KS_STRIDE + q * VS_STRIDE + 8 * g;
#pragma unroll
            for (int d = 0; d < 8; ++d)
#pragma unroll
                for (int k2 = 0; k2 < 2; ++k2) {
                    const bf16x8 vf = *(const LAS bf16x8*)(vl + d * 16 * VS_STRIDE + 32 * k2);
                    A.O[0][d] = MFMA16(vf, bP[0][k2], A.O[0][d]); A.O[1][d] = MFMA16(vf, bP[1][k2], A.O[1][d]);
                }
        }
        if (more) { *(LAS u32x4*)(Ln + kso) = k0; *(LAS u32x4*)(Ln + kso + 32 * KS_STRIDE) = k1; *(LAS u32x2*)(Ln + vso) = (u32x2){v0.x, v0.y}; *(LAS u32x2*)(Ln + vso2) = (u32x2){v0.z, v0.w}; *(LAS u32x2*)(Ln + vso + 64 * VS_STRIDE) = (u32x2){v1.x, v1.y}; *(LAS u32x2*)(Ln + vso2 + 64 * VS_STRIDE) = (u32x2){v1.z, v1.w}; }
        __syncthreads();
    }
    float l0 = A.l[0], l1 = A.l[1];
    l0 += __shfl_xor(l0, 16); l0 += __shfl_xor(l0, 32); l1 += __shfl_xor(l1, 16); l1 += __shfl_xor(l1, 32);
    const float lam = att_lambda(p, lane);
    att_final(A, l0, l1, lam, p.in(16), qrow, g);
}
__device__ __forceinline__ bf16x8 cvt8(const float* s) {
    const f32x4 a = *(const f32x4*)s, b = *(const f32x4*)(s + 4);
    u32x4 w; w.x = pk2(a[0], a[1]); w.y = pk2(a[2], a[3]); w.z = pk2(b[0], b[1]); w.w = pk2(b[2], b[3]);
    return __builtin_bit_cast(bf16x8, w);
}
__device__ __forceinline__ void att_sample_unit(const Ctx& p, int bs, int h, LAS unsigned char* lds) {
    const int tid = threadIdx.x, lane = tid & 63, wave = __builtin_amdgcn_readfirstlane(tid >> 6), q = lane & 15, g = lane >> 4;
    bf16_t* QB = (bf16_t*)(p.ws() + WS_QB);
    const int row = MPR + bs * 16 + q;
    bf16_t* qrow = QB + (size_t)row * 512 + h * 128;
    bf16x8 bq[2][2];
#pragma unroll
    for (int mm = 0; mm < 2; ++mm)
#pragma unroll
        for (int ks = 0; ks < 2; ++ks) bq[mm][ks] = *(const bf16x8*)(qrow + mm * 64 + ks * 32 + 8 * g);
    AttAcc A; att_init(A);
    for (int kt = wave; kt < 65; kt += 8) {
        const bool isnew = kt == 64;
        const float* kb = isnew ? p.out() + O_KS + (size_t)bs * 16 * 512 : p.in(2) + ((size_t)bs * PAST + kt * 64) * 512;
        const float* vb = isnew ? p.out() + O_VS + (size_t)bs * 16 * 512 : p.in(3) + ((size_t)bs * PAST + kt * 64) * 512;
        const int nvalid = isnew ? 16 : 64;
        bf16x8 bP[2][2];
        att_qk(A, [&](int mm, int ks, int t) { const int key = min(16 * t + q, nvalid - 1); return cvt8(kb + (key * 512 + h * 128 + mm * 64 + ks * 32 + 8 * g)); }, bq, nvalid, g, bP);
#pragma unroll
        for (int k2 = 0; k2 < 2; ++k2)
#pragma unroll
            for (int dp = 0; dp < 4; ++dp) {
                float v[2][8];
#pragma unroll
                for (int dd = 0; dd < 2; ++dd)
#pragma unroll
                    for (int e = 0; e < 8; ++e) { const int key = min(32 * k2 + (e >> 2) * 16 + 4 * g + (e & 3), nvalid - 1); v[dd][e] = vb[key * 512 + h * 128 + 16 * (2 * dp + dd) + q]; }
#pragma unroll
                for (int dd = 0; dd < 2; ++dd) { const int d = 2 * dp + dd;
                    u32x4 w; w.x = pk2(v[dd][0], v[dd][1]); w.y = pk2(v[dd][2], v[dd][3]); w.z = pk2(v[dd][4], v[dd][5]); w.w = pk2(v[dd][6], v[dd][7]);
                    const bf16x8 vf = __builtin_bit_cast(bf16x8, w);
                    A.O[0][d] = MFMA16(vf, bP[0][k2], A.O[0][d]); A.O[1][d] = MFMA16(vf, bP[1][k2], A.O[1][d]); }
                asm volatile("" ::: "memory");
            }
    }
    float l0 = A.l[0], l1 = A.l[1];
    l0 += __shfl_xor(l0, 16); l0 += __shfl_xor(l0, 32); l1 += __shfl_xor(l1, 16); l1 += __shfl_xor(l1, 32);
    LAS float* Ob = (LAS float*)lds; LAS float* ML = Ob + 8 * 2 * 8 * 4 * 64;
#pragma unroll
    for (int mm = 0; mm < 2; ++mm)
#pragma unroll
        for (int d = 0; d < 8; ++d)
#pragma unroll
            for (int r = 0; r < 4; ++r) Ob[((((wave * 2 + mm) * 8 + d) * 4 + r) << 6) + lane] = A.O[mm][d][r];
    ML[(wave * 4 + 0) * 64 + lane] = A.m[0]; ML[(wave * 4 + 1) * 64 + lane] = A.m[1]; ML[(wave * 4 + 2) * 64 + lane] = l0; ML[(wave * 4 + 3) * 64 + lane] = l1;
    __syncthreads();
    {
        float ms0 = -1e30f, ms1 = -1e30f;
#pragma unroll
        for (int w = 0; w < 8; ++w) { ms0 = fmaxf(ms0, ML[(w * 4 + 0) * 64 + lane]); ms1 = fmaxf(ms1, ML[(w * 4 + 1) * 64 + lane]); }
        float L0 = 0.f, L1 = 0.f; f32x4 o0 = (f32x4){0.f, 0.f, 0.f, 0.f}, o1 = o0;
#pragma unroll
        for (int w = 0; w < 8; ++w) {
            const float f0 = fexp2(ML[(w * 4 + 0) * 64 + lane] - ms0), f1 = fexp2(ML[(w * 4 + 1) * 64 + lane] - ms1);
            L0 += ML[(w * 4 + 2) * 64 + lane] * f0; L1 += ML[(w * 4 + 3) * 64 + lane] * f1;
#pragma unroll
            for (int r = 0; r < 4; ++r) { o0[r] += Ob[((((w * 2 + 0) * 8 + wave) * 4 + r) << 6) + lane] * f0; o1[r] += Ob[((((w * 2 + 1) * 8 + wave) * 4 + r) << 6) + lane] * f1; }
        }
        const float lam = att_lambda(p, lane);
        const f32x4 o = o0 * (1.f / L0) - o1 * (lam / L1);
        float ss = (o[0] * o[0] + o[1] * o[1]) + (o[2] * o[2] + o[3] * o[3]);
        ss += __shfl_xor(ss, 16); ss += __shfl_xor(ss, 32);
        LAS float* SS = ML + 8 * 4 * 64;
        SS[wave * 64 + lane] = ss;
        __syncthreads();
        float tot = 0.f;
#pragma unroll
        for (int w = 0; w < 8; ++w) tot += SS[w * 64 + lane];
        const float rs = 0.8f / sqrtf(tot * (1.f / 128.f) + EPS);
        const f32x4 gg = *(const f32x4*)(p.in(16) + 16 * wave + 4 * g);
        u32x2 wv; wv.x = pk2(o[0] * rs * gg[0], o[1] * rs * gg[1]); wv.y = pk2(o[2] * rs * gg[2], o[3] * rs * gg[3]);
        *(u32x2*)(qrow + 16 * wave + 4 * g) = wv;
    }
    __syncthreads();
}

template <int CTRL> __device__ __forceinline__ float dpp_add(float x) {
    return x + __builtin_bit_cast(float, __builtin_amdgcn_update_dpp(0, __builtin_bit_cast(int, x), CTRL, 0xf, 0xf, true));
}
__device__ __forceinline__ float sum16(float x) { x = dpp_add<0xB1>(x); x = dpp_add<0x4E>(x); x = dpp_add<0x141>(x); x = dpp_add<0x140>(x); return x; }
__device__ __forceinline__ float sum8(float x) { x = dpp_add<0xB1>(x); x = dpp_add<0x4E>(x); x = dpp_add<0x141>(x); return x; }
__device__ __forceinline__ void unpack4(const u32x2 w, float (&f)[4]) { f[0] = bflo(w.x); f[1] = bfhi(w.x); f[2] = bflo(w.y); f[3] = bfhi(w.y); }
__device__ __forceinline__ void zshift4(const Ctx& p, const bf16_t* ZRW, int row, int c, const float (&mu)[4], float (&o)[4]) {
    float z[4], pv[4];
    unpack4(*(const u32x2*)(ZRW + (size_t)row * SHW + c), z);
    bool first; int bsmp = 0;
    if (row < MPR) first = (row & (TP - 1)) == 0; else { first = ((row - MPR) & 15) == 0; bsmp = (row - MPR) >> 4; }
    if (!first) unpack4(*(const u32x2*)(ZRW + (size_t)(row - 1) * SHW + c), pv);
    else if (row < MPR) { pv[0] = 0.f; pv[1] = 0.f; pv[2] = 0.f; pv[3] = 0.f; }
    else { const f32x4 s0 = *(const f32x4*)(p.in(5) + (size_t)bsmp * SHW + c); pv[0] = s0[0]; pv[1] = s0[1]; pv[2] = s0[2]; pv[3] = s0[3]; }
#pragma unroll
    for (int e = 0; e < 4; ++e) o[e] = z[e] + (pv[e] - z[e]) * mu[e];
}
constexpr int SCH = 32, SBUF_F = SCH * 320 + 16 * SCH, YP_F = SCH * 16 * 8;
struct ScanOps { f32x4 w, kk, ka, kp, rr; float v; };
__device__ __forceinline__ void scan_load(ScanOps& o, const LAS float* OP, int t) {
    o.w = *(const LAS f32x4*)(OP + t * 320); o.kk = *(const LAS f32x4*)(OP + t * 320 + 64); o.ka = *(const LAS f32x4*)(OP + t * 320 + 128);
    o.kp = *(const LAS f32x4*)(OP + t * 320 + 192); o.rr = *(const LAS f32x4*)(OP + t * 320 + 256);
}
__device__ __forceinline__ void scan_step(f32x4& S, const ScanOps& o, LAS float* yp) {
    f32x2 S0 = {S[0], S[1]}, S1 = {S[2], S[3]};
    const f32x2 k0 = {o.kk[0], o.kk[1]}, k1 = {o.kk[2], o.kk[3]};
    f32x2 t = S0 * k0; t = S1 * k1 + t;
    const float sa = -sum16(t[0] + t[1]);
    const f32x2 sav = {sa, sa}, vv = {o.v, o.v};
    const f32x2 a0 = {o.ka[0], o.ka[1]}, a1 = {o.ka[2], o.ka[3]}, p0 = {o.kp[0], o.kp[1]}, p1 = {o.kp[2], o.kp[3]}, w0 = {o.w[0], o.w[1]}, w1 = {o.w[2], o.w[3]};
    f32x2 u0 = a0 * sav; u0 = p0 * vv + u0; S0 = S0 * w0 + u0;
    f32x2 u1 = a1 * sav; u1 = p1 * vv + u1; S1 = S1 * w1 + u1;
    const f32x2 r0 = {o.rr[0], o.rr[1]}, r1 = {o.rr[2], o.rr[3]};
    f32x2 y = S0 * r0; y = S1 * r1 + y;
    *yp = dpp_add<0xB1>(y[0] + y[1]);
    S = (f32x4){S0[0], S0[1], S1[0], S1[1]};
}
__device__ __forceinline__ void scan_unit(const Ctx& p, int chain, int rq, LAS unsigned char* lds) {
    const int tid = threadIdx.x, lane = tid & 63, wave = __builtin_amdgcn_readfirstlane(tid >> 6);
    const bool smp = chain >= 32;
    const int cb = smp ? (chain - 32) >> 3 : chain >> 3, h = chain & 7, T = smp ? TS : TP, row0 = smp ? MPR + cb * TS : cb * TP;
    const int nch = (T + SCH - 1) / SCH;
    const bf16_t* ZRW = (const bf16_t*)(p.ws() + WS_ZRW);
    const float* DEC = (const float*)(p.ws() + WS_DEC); const bf16_t* AB = (const bf16_t*)(p.ws() + WS_ABUF);
    bf16_t* ORW = (bf16_t*)(p.ws() + WS_ORW);
    LAS float* B0 = (LAS float*)lds; LAS float* YB = B0 + 2 * SBUF_F;
    __syncthreads();
    if (wave >= 4) {
        const int ht = tid - 256, tt = ht >> 3, cg8 = ht & 7, c0 = h * 64 + 8 * cg8;
        const bool hasv = cg8 < 2;
        const int vx = hasv ? 1024 + h * 64 + 16 * rq + 8 * cg8 : c0;
        float mur[8], muk[8], muv[8], kkc[8], kac[8];
#pragma unroll
        for (int e = 0; e < 8; ++e) { mur[e] = p.in(17)[c0 + e]; muk[e] = p.in(17)[512 + c0 + e]; kkc[e] = p.in(23)[c0 + e]; kac[e] = p.in(24)[c0 + e]; muv[e] = p.in(17)[vx + e]; }
        struct HReg { u32x4 zr, zrp, zk, zkp, ab, zv, zvp; f32x4 d0, d1; };
        auto issue = [&](HReg& R, int c) {
            const int row = row0 + c * SCH + tt, rp = row > 0 ? row - 1 : 0;
            R.zr = *(const u32x4*)(ZRW + (size_t)row * SHW + c0); R.zrp = *(const u32x4*)(ZRW + (size_t)rp * SHW + c0);
            R.zk = *(const u32x4*)(ZRW + (size_t)row * SHW + 512 + c0); R.zkp = *(const u32x4*)(ZRW + (size_t)rp * SHW + 512 + c0);
            R.ab = *(const u32x4*)(AB + (size_t)row * 512 + c0); R.d0 = *(const f32x4*)(DEC + (size_t)row * 512 + c0); R.d1 = *(const f32x4*)(DEC + (size_t)row * 512 + c0 + 4);
            R.zv = *(const u32x4*)(ZRW + (size_t)row * SHW + vx); R.zvp = *(const u32x4*)(ZRW + (size_t)rp * SHW + vx);
        };
        auto commit = [&](const HReg& R, int c) {
            float zr[8], pr[8], zk[8], pk[8], a[8], zv[8], pv[8];
            unpack8(R.zr, zr); unpack8(R.zrp, pr); unpack8(R.zk, zk); unpack8(R.zkp, pk); unpack8(R.ab, a); unpack8(R.zv, zv); unpack8(R.zvp, pv);
            if (c == 0 && tt == 0) {
#pragma unroll
                for (int e = 0; e < 8; ++e) { pr[e] = 0.f; pk[e] = 0.f; pv[e] = 0.f; }
                if (smp) { const float* s0 = p.in(5) + (size_t)cb * SHW;
#pragma unroll
                    for (int e = 0; e < 8; ++e) { pr[e] = s0[c0 + e]; pk[e] = s0[512 + c0 + e]; pv[e] = s0[vx + e]; } }
            }
            float r[8], k[8], kk[8], n2 = 0.f;
#pragma unroll
            for (int e = 0; e < 8; ++e) { r[e] = zr[e] + (pr[e] - zr[e]) * mur[e]; k[e] = zk[e] + (pk[e] - zk[e]) * muk[e]; kk[e] = k[e] * kkc[e]; n2 += kk[e] * kk[e]; }
            n2 = sum8(n2);
            const float inv = __builtin_amdgcn_rsqf(fmaxf(n2, 1e-24f));
            float ka[8], kp[8];
#pragma unroll
            for (int e = 0; e < 8; ++e) { kk[e] *= inv; ka[e] = kk[e] * a[e]; kp[e] = k[e] * (1.f + (a[e] - 1.f) * kac[e]); }
            LAS float* OP = B0 + (c & 1) * SBUF_F + tt * 320 + 8 * cg8;
            *(LAS f32x4*)(OP) = R.d0; *(LAS f32x4*)(OP + 4) = R.d1;
            *(LAS f32x4*)(OP + 64) = (f32x4){kk[0], kk[1], kk[2], kk[3]}; *(LAS f32x4*)(OP + 68) = (f32x4){kk[4], kk[5], kk[6], kk[7]};
            *(LAS f32x4*)(OP + 128) = (f32x4){ka[0], ka[1], ka[2], ka[3]}; *(LAS f32x4*)(OP + 132) = (f32x4){ka[4], ka[5], ka[6], ka[7]};
            *(LAS f32x4*)(OP + 192) = (f32x4){kp[0], kp[1], kp[2], kp[3]}; *(LAS f32x4*)(OP + 196) = (f32x4){kp[4], kp[5], kp[6], kp[7]};
            *(LAS f32x4*)(OP + 256) = (f32x4){r[0], r[1], r[2], r[3]}; *(LAS f32x4*)(OP + 260) = (f32x4){r[4], r[5], r[6], r[7]};
            if (hasv) { LAS float* VW = B0 + (c & 1) * SBUF_F + SCH * 320 + (8 * cg8) * SCH + tt;
#pragma unroll
                for (int e = 0; e < 8; ++e) VW[e * SCH] = zv[e] + (pv[e] - zv[e]) * muv[e]; }
        };
        auto yout = [&](int c) {
            const LAS float* Y = YB + (c & 1) * YP_F + (tt * 16 + 2 * cg8) * 8;
            const f32x4 y0 = *(const LAS f32x4*)Y, y1 = *(const LAS f32x4*)(Y + 4), y2 = *(const LAS f32x4*)(Y + 8), y3 = *(const LAS f32x4*)(Y + 12);
            const f32x4 ya = y0 + y1, yb = y2 + y3;
            if (c * SCH + tt < T) *(unsigned*)(ORW + (size_t)(row0 + c * SCH + tt) * 512 + h * 64 + 16 * rq + 2 * cg8) = pk2((ya[0] + ya[1]) + (ya[2] + ya[3]), (yb[0] + yb[1]) + (yb[2] + yb[3]));
        };
        HReg R0, R1;
        issue(R0, 0); if (nch > 1) issue(R1, 1);
        for (int ci = 0; ci <= nch; ci += 2) {
            if (ci < nch) { commit(R0, ci); if (ci + 2 < nch) issue(R0, ci + 2); }
            __syncthreads();
            if (ci > 0) yout(ci - 1);
            if (ci + 1 <= nch) {
                if (ci + 1 < nch) { commit(R1, ci + 1); if (ci + 3 < nch) issue(R1, ci + 3); }
                __syncthreads();
                yout(ci);
            }
        }
    } else {
        const int rl = lane >> 4, cl = lane & 15, il = 4 * wave + rl;
        f32x4 S;
        float* sg = (smp ? p.out() + O_SS : p.out() + O_SP) + ((size_t)(cb * 8 + h) * 64 + 16 * rq + il) * 64 + 4 * cl;
        if (smp) S = *(const f32x4*)(p.in(4) + ((size_t)(cb * 8 + h) * 64 + 16 * rq + il) * 64 + 4 * cl); else S = (f32x4){0.f, 0.f, 0.f, 0.f};
        for (int ci = 0; ci < nch; ++ci) {
            __syncthreads();
            const LAS float* OP = B0 + (ci & 1) * SBUF_F + 4 * cl;
            const LAS float* VP = B0 + (ci & 1) * SBUF_F + SCH * 320 + il * SCH;
            LAS float* Y = YB + (ci & 1) * YP_F + il * 8 + (cl >> 1);
            const int nt = min(SCH, T - ci * SCH);
            ScanOps oa, ob;
            scan_load(oa, OP, 0);
            f32x2 vv = *(const LAS f32x2*)VP;
#pragma unroll 1
            for (int t = 0; t < nt; t += 4) {
                const LAS float* OPt = OP + t * 320; LAS float* Yt = Y + t * 128;
                scan_load(ob, OPt, 1);
                oa.v = vv[0]; ob.v = vv[1];
                scan_step(S, oa, Yt);
                scan_load(oa, OPt, 2);
                vv = *(const LAS f32x2*)(VP + t + 2);
                scan_step(S, ob, Yt + 128);
                scan_load(ob, OPt, 3);
                oa.v = vv[0]; ob.v = vv[1];
                scan_step(S, oa, Yt + 256);
                scan_load(oa, OP, (t + 4) & (SCH - 1));
                vv = *(const LAS f32x2*)(VP + ((t + 4) & (SCH - 1)));
                scan_step(S, ob, Yt + 384);
            }
        }
        __syncthreads();
        *(f32x4*)sg = S;
    }
}
__device__ __forceinline__ void phase_lnpass(const Ctx& p) {
    const int tid = threadIdx.x, c8 = tid & 7, h = (tid >> 3) & 7, rr = tid >> 6, c = h * 64 + 8 * c8;
    const bf16_t* ZRW = (const bf16_t*)(p.ws() + WS_ZRW); const bf16_t* AB = (const bf16_t*)(p.ws() + WS_ABUF); const bf16_t* GG = (const bf16_t*)(p.ws() + WS_GG);
    bf16_t* ORW = (bf16_t*)(p.ws() + WS_ORW);
    float mur[8], muk[8], muv[8], kac[8], rkc[8], lg[8], lb[8];
#pragma unroll
    for (int e = 0; e < 8; ++e) { mur[e] = p.in(17)[c + e]; muk[e] = p.in(17)[512 + c + e]; muv[e] = p.in(17)[1024 + c + e]; kac[e] = p.in(24)[c + e]; rkc[e] = p.in(25)[c + e]; lg[e] = p.in(26)[c + e]; lb[e] = p.in(27)[c + e]; }
    for (int it = blockIdx.x; it < MR / 8; it += gridDim.x) {
        const int row = it * 8 + rr;
        float r[8], k[8], v[8], a[8], g[8], y[8];
        zshift8(p, ZRW, row, c, mur, r); zshift8(p, ZRW, row, 512 + c, muk, k); zshift8(p, ZRW, row, 1024 + c, muv, v);
        unpack8(*(const u32x4*)(AB + (size_t)row * 512 + c), a); unpack8(*(const u32x4*)(GG + (size_t)row * 512 + c), g); unpack8(*(const u32x4*)(ORW + (size_t)row * 512 + c), y);
        float bon = 0.f, sy = 0.f;
#pragma unroll
        for (int e = 0; e < 8; ++e) { const float kp = k[e] * (1.f + (a[e] - 1.f) * kac[e]); bon += r[e] * kp * rkc[e]; sy += y[e]; }
        bon = sum8(bon);
        const float mu = sum8(sy) * (1.f / 64.f);
        float var = 0.f;
#pragma unroll
        for (int e = 0; e < 8; ++e) { y[e] -= mu; var += y[e] * y[e]; }
        var = sum8(var) * (1.f / 64.f);
        const float rs = 1.f / sqrtf(var + LNX_EPS);
        float o[8];
#pragma unroll
        for (int e = 0; e < 8; ++e) o[e] = (y[e] * rs * lg[e] + lb[e] + bon * v[e]) * g[e];
        u32x4 w; w.x = pk2(o[0], o[1]); w.y = pk2(o[2], o[3]); w.z = pk2(o[4], o[5]); w.w = pk2(o[6], o[7]);
        *(u32x4*)(ORW + (size_t)row * 512 + c) = w;
    }
}

__device__ __forceinline__ void ffn2_weights(const Ctx& p, LAS unsigned char* lds) {
    const int tid = threadIdx.x, lane = tid & 63, wave = __builtin_amdgcn_readfirstlane(tid >> 6);
    unsigned char* ws = p.ws();
    LAS float* scr = (LAS float*)(lds + wave * 16384);
    constexpr int I7 = 16 * 176, I8 = 44 * 32;
    __syncthreads();
    for (int it = ((int)blockIdx.x - 128) * 8 + wave; it < I7 + I8; it += 128 * 8) {
        int r = it;
        if (r < I7) { const int kb = r / 176, nb = r % 176; transpose_item(p.in(33), DM, NFF, (bf16_t*)(ws + WS_W3T), 64 * kb, 32 * nb, map_w1(32 * nb), scr, lane); continue; } r -= I7;
        { const int kb = r / 32, nb = r % 32; transpose_item(p.in(34), DFF, DM, (bf16_t*)(ws + WS_W4T), 64 * kb, 32 * nb, 32 * nb, scr, lane); }
    }
}
__device__ __forceinline__ void phase_mixer(const Ctx& p, LAS unsigned char* lds) {
    if (blockIdx.x < 128) scan_unit(p, blockIdx.x >> 2, blockIdx.x & 3, lds);
    else { const int u0 = (blockIdx.x - 128) * 2; scan_unit(p, 32 + (u0 >> 2), u0 & 3, lds); scan_unit(p, 32 + ((u0 + 1) >> 2), (u0 + 1) & 3, lds); }
    if (blockIdx.x < 128) return;
    unsigned* ctr = (unsigned*)(p.ws() + WS_CTR);
    LAS unsigned* su = (LAS unsigned*)(lds + 140 * 1024);
    for (;;) {
        __syncthreads();
        if (threadIdx.x == 0) su[0] = atomicAdd(ctr, 1u);
        __syncthreads();
        const int u = __builtin_amdgcn_readfirstlane((int)su[0]);
        if (u >= 32) break;
        att_sample_unit(p, u >> 2, u & 3, lds);
    }
    for (;;) {
        __syncthreads();
        if (threadIdx.x == 0) su[0] = atomicAdd(ctr + 1, 1u);
        __syncthreads();
        const int v = __builtin_amdgcn_readfirstlane((int)su[0]);
        if (v >= 512) break;
        att_prompt_unit(p, v & 15, 31 - (v >> 4), lds);
    }
    ffn2_weights(p, lds);
}

constexpr int LDS_BYTES = 147456;
constexpr int NPHASE = 15;
#ifndef SINGLE_LAUNCH
#define SINGLE_LAUNCH 1
#endif

#define XB_TMO      128
#define XB_XCNT(j)  (256  + 64 * (j))
#define XB_XSUB(j)  (1280 + 64 * (j))
#define XB_XGEN(j)  (2304 + 64 * (j))
#define XB_TOP      3328
#define XB_TOPGEN   3392
#define XCD_BAR_WORDS 3456
#define XB_SPIN_CAP (1u << 18)

__device__ __forceinline__ unsigned xb_ld(unsigned* p)              { return __hip_atomic_load(p, __ATOMIC_RELAXED, __HIP_MEMORY_SCOPE_AGENT); }
__device__ __forceinline__ unsigned xb_add(unsigned* p, unsigned v) { return __hip_atomic_fetch_add(p, v, __ATOMIC_RELAXED, __HIP_MEMORY_SCOPE_AGENT); }
__device__ __forceinline__ unsigned xb_xcc_id() { return (unsigned)__builtin_amdgcn_s_getreg((3 << 11) | 20) & 0xFu; }
#define XB_SPIN(cond, bar) do { unsigned _sp = 0; while (cond) { __builtin_amdgcn_s_sleep(1); \
    if ((++_sp & 255u) == 0u) { if (xb_ld(&(bar)[XB_TMO])) break; if (_sp > XB_SPIN_CAP) { atomicAdd(&(bar)[XB_TMO], 1u); break; } } } } while (0)

struct XcdBarrier {
    unsigned* bar; unsigned x;
    volatile LAS unsigned* st;
};

__device__ __forceinline__ XcdBarrier xcd_barrier_post(unsigned* bar, volatile LAS unsigned* st) {
    XcdBarrier b; b.bar = bar; b.x = xb_xcc_id(); b.st = st;
    if (threadIdx.x == 0) (void)xb_add(&bar[XB_XCNT(b.x)], 1u);
    return b;
}
__device__ __forceinline__ void xcd_barrier_complete(unsigned* bar, unsigned x, unsigned& nloc, unsigned& nx) {
    const unsigned G = gridDim.x * gridDim.y * gridDim.z;
    unsigned sum, cnt, mine, sp = 0u;
    for (;;) {
        sum = 0u; cnt = 0u; mine = 0u;
#pragma unroll
        for (unsigned j = 0; j < 16; ++j) { const unsigned c = xb_ld(&bar[XB_XCNT(j)]); sum += c; cnt += (c > 0u) ? 1u : 0u; mine = (j == x) ? c : mine; }
        if (sum == G) break;
        __builtin_amdgcn_s_sleep(1);
        if ((++sp & 255u) == 0u) { if (xb_ld(&bar[XB_TMO])) break; if (sp > XB_SPIN_CAP) { atomicAdd(&bar[XB_TMO], 1u); break; } }
    }
    nloc = mine > 0u ? mine : 1u; nx = cnt > 0u ? cnt : 1u;
}

__device__ __forceinline__ void xcd_barrier(const XcdBarrier& b) {
    asm volatile("s_waitcnt vmcnt(0)" ::: "memory");
    __syncthreads();
    if (threadIdx.x == 0) {
        unsigned* bar = b.bar;
        __builtin_amdgcn_s_waitcnt(0);
        unsigned nloc = b.st[0], nx = b.st[1];
        if (nloc == 0u) { xcd_barrier_complete(bar, b.x, nloc, nx); b.st[0] = nloc; b.st[1] = nx; }
        const unsigned old = xb_add(&bar[XB_XSUB(b.x)], 1u);
        const unsigned gen = old / nloc;
        if (old + 1u == (gen + 1u) * nloc) {
            __builtin_amdgcn_fence(__ATOMIC_RELEASE, "agent");
            asm volatile("s_waitcnt vmcnt(0)" ::: "memory");
            const unsigned og = xb_add(&bar[XB_TOP], 1u);
            const unsigned tg = og / nx;
            if (og + 1u == (tg + 1u) * nx) xb_add(&bar[XB_TOPGEN], 1u);
            else XB_SPIN(xb_ld(&bar[XB_TOPGEN]) == tg, bar);
            __builtin_amdgcn_fence(__ATOMIC_ACQUIRE, "agent");
            xb_add(&bar[XB_XGEN(b.x)], 1u);
            asm volatile("s_waitcnt vmcnt(0)" ::: "memory");
        } else {
            XB_SPIN(xb_ld(&bar[XB_XGEN(b.x)]) == gen, bar);
            __builtin_amdgcn_fence(__ATOMIC_ACQUIRE, "agent");
            asm volatile("s_waitcnt vmcnt(0)" ::: "memory");
        }
    }
    __syncthreads();
}

__device__ __forceinline__ void grid_bar(const Ctx& p, unsigned k) {
    asm volatile("s_waitcnt vmcnt(0)" ::: "memory");
    __syncthreads();
    if (threadIdx.x == 0) {
        unsigned* ctr = (unsigned*)(p.ws() + WS_CTR) + 64;
        __builtin_amdgcn_fence(__ATOMIC_RELEASE, "agent");
        asm volatile("s_waitcnt vmcnt(0)" ::: "memory");
        __hip_atomic_fetch_add(ctr, 1u, __ATOMIC_RELAXED, __HIP_MEMORY_SCOPE_AGENT);
        const unsigned target = k * gridDim.x;
        while (__hip_atomic_load(ctr, __ATOMIC_RELAXED, __HIP_MEMORY_SCOPE_AGENT) < target) __builtin_amdgcn_s_sleep(1);
        __builtin_amdgcn_fence(__ATOMIC_ACQUIRE, "agent");
        asm volatile("s_waitcnt vmcnt(0)" ::: "memory");
    }
    __syncthreads();
}
__device__ __forceinline__ void sub_barrier(const Ctx& p, unsigned n) {
    asm volatile("s_waitcnt vmcnt(0)" ::: "memory");
    __syncthreads();
    if (threadIdx.x == 0) {
        unsigned* c = (unsigned*)(p.ws() + WS_CTR) + 128;
        __builtin_amdgcn_fence(__ATOMIC_RELEASE, "agent");
        asm volatile("s_waitcnt vmcnt(0)" ::: "memory");
        __hip_atomic_fetch_add(c, 1u, __ATOMIC_RELAXED, __HIP_MEMORY_SCOPE_AGENT);
        while (__hip_atomic_load(c, __ATOMIC_RELAXED, __HIP_MEMORY_SCOPE_AGENT) < n) __builtin_amdgcn_s_sleep(2);
        __builtin_amdgcn_fence(__ATOMIC_ACQUIRE, "agent");
        asm volatile("s_waitcnt vmcnt(0)" ::: "memory");
    }
    __syncthreads();
}
template <class Epi> __device__ __forceinline__ void run_gemm(LAS unsigned char* lds, const bf16_t* A, const bf16_t* Bt, int N, int K, const Epi& E, int M = MP) {
    pg8::Gemm g{A, Bt, M, N, K, K}; pg8::StaticOrder S; S.init(M, N, (int)gridDim.x, (int)blockIdx.x);
    pg8::gemm_phase<Epi, pg8::StaticOrder, true, true>(lds, g, S, E);
}
struct OneUnit { int pn; bool on;
    __device__ __forceinline__ bool next(int i, pg8::Unit& u) const { if (i > 0 || !on) return false; u.pm = 0; u.pn = pn; return true; }
    __device__ __forceinline__ void a_ready(const pg8::Unit&) const {}
    __device__ __forceinline__ void done(const pg8::Unit&) const {} };
struct EpiPart {
    static constexpr bool PERM = false, AFTER_DRAIN = false;
    float* O;
    __device__ __forceinline__ void operator()(const f32x4 (&acc)[2][2][4][2], const Unit& u, int wr, int wc, int fr, int fq) const {
        const int col0 = u.pn * 256 + wc * 32 + 4 * fq;
#pragma unroll
        for (int m = 0; m < 4; ++m) {
            const int row = wr * 64 + m * 16 + fr;
#pragma unroll
            for (int bj = 0; bj < 2; ++bj)
#pragma unroll
                for (int n = 0; n < 2; ++n) *(f32x4*)(O + (size_t)row * DM + col0 + bj * 128 + n * 16) = acc[0][bj][m][n];
            asm volatile("" ::: "memory");
        }
    }
};
constexpr size_t WS_PART = 240 * MiB;
constexpr int KSL = 256;
__device__ __forceinline__ void run_gemm_sample(LAS unsigned char* lds, const bf16_t* A, const bf16_t* Bt, int K, float* PART) {
    const int c = (int)blockIdx.x, ns = K / KSL, ks = c >> 2;
    OneUnit S{c & 3, c < 4 * ns};
    pg8::Gemm g{A + (size_t)MPR * K + (size_t)ks * KSL, Bt + (size_t)ks * KSL, 256, DM, KSL, K};
    EpiPart E{PART + (size_t)ks * 128 * DM};
    pg8::gemm_phase<EpiPart, OneUnit, false, true>(lds, g, S, E);
}

__global__ void __launch_bounds__(512) fwd_kernel(Params prm) {
    extern __shared__ __attribute__((aligned(16))) unsigned char lds_raw[];
    LAS unsigned char* lds = (LAS unsigned char*)lds_raw;
    cg::grid_group grid = cg::this_grid();
    const int lo = prm.ph_lo, hi = prm.ph_hi;
    {   LAS unsigned long long* tab = (LAS unsigned long long*)(lds + 141 * 1024);
        if (threadIdx.x < 36) tab[threadIdx.x] = (unsigned long long)prm.in[threadIdx.x];
        if (threadIdx.x == 36) tab[36] = (unsigned long long)prm.out;
        if (threadIdx.x == 37) tab[37] = (unsigned long long)prm.ws;
        __syncthreads(); }
    Ctx p{(const LAS unsigned*)(lds + 141 * 1024)};
volatile LAS unsigned* bst = (volatile LAS unsigned*)(lds + 142 * 1024);
    if (threadIdx.x < 2) bst[threadIdx.x] = 0u;
    __syncthreads();
    XcdBarrier bar = xcd_barrier_post((unsigned*)(p.ws() + WS_CTR) + 1024, bst);
#define ws (p.ws())
#define IN(k) (lo <= (k) && (k) < hi)
#define SEAM(k) do { if (IN(k) && IN((k) + 1)) xcd_barrier(bar); } while (0)
    unsigned nbar = 0;
    if (IN(0)) { phase_prologue(p, lds); } if (IN(0) && IN(1)) grid.sync();
    if (IN(1)) { EpiSwiglu E{(bf16_t*)(ws + WS_G)}; run_gemm(lds, (const bf16_t*)(ws + WS_XN), (const bf16_t*)(ws + WS_W1T), NFF, DM, E);
        { constexpr int NFULL = (MP / 256) * (NFF / 256) - 5 * 256;
          if ((int)blockIdx.x >= NFULL) prologue_part2(p, lds, (int)blockIdx.x - NFULL, 256 - NFULL); } } SEAM(1);
    if (IN(2)) { EpiF32 E{(float*)(ws + WS_F)}; run_gemm(lds, (const bf16_t*)(ws + WS_G), (const bf16_t*)(ws + WS_W2T), DM, DFF, E, MPR); run_gemm_sample(lds, (const bf16_t*)(ws + WS_G), (const bf16_t*)(ws + WS_W2T), DFF, (float*)(ws + WS_PART)); } SEAM(2);
    if (IN(3)) { phase_rowpass(p, (const float*)(ws + WS_F), 1, 0.5f, p.in(9), p.in(10), (bf16_t*)(ws + WS_XN), (const float*)(ws + WS_PART), DFF / KSL); } SEAM(3);
    if (IN(4)) { EpiZ E{p.out(), (bf16_t*)(ws + WS_QB), (bf16_t*)(ws + WS_KB), (bf16_t*)(ws + WS_VT), (bf16_t*)(ws + WS_ZRW), (bf16_t*)(ws + WS_GATE), (const f32x2*)(ws + WS_TAB)};
        run_gemm(lds, (const bf16_t*)(ws + WS_XN), (const bf16_t*)(ws + WS_WINT), INW, DM, E); } SEAM(4);
    if (IN(5)) { phase_lora(p, lds); } SEAM(5);
    if (IN(6)) { phase_mixer(p, lds);
        if (blockIdx.x >= 128) {
            sub_barrier(p, 128u);
            EpiGate1 E{(bf16_t*)(ws + WS_KB), (const bf16_t*)(ws + WS_GATE)};
            pg8::Gemm g{(const bf16_t*)(ws + WS_QB), (const bf16_t*)(ws + WS_WAT), MP, DM, 512, 512}; pg8::StaticOrder S; S.init(MP, DM, 128, (int)blockIdx.x - 128);
            pg8::gemm_phase<EpiGate1, pg8::StaticOrder, true, true>(lds, g, S, E);
        } } SEAM(6);
    if (IN(14)) { phase_lnpass(p); } if (IN(14) && IN(7)) xcd_barrier(bar);
    if (IN(8)) { EpiGate2 E{(const bf16_t*)(ws + WS_KB), (const bf16_t*)(ws + WS_GATE), (bf16_t*)(ws + WS_MG)}; run_gemm(lds, (const bf16_t*)(ws + WS_ORW), (const bf16_t*)(ws + WS_WRT), DM, 512, E); } SEAM(8);
    if (IN(9)) { EpiF32 E{(float*)(ws + WS_T)}; run_gemm(lds, (const bf16_t*)(ws + WS_MG), (const bf16_t*)(ws + WS_WOT), DM, DM, E, MPR); run_gemm_sample(lds, (const bf16_t*)(ws + WS_MG), (const bf16_t*)(ws + WS_WOT), DM, (float*)(ws + WS_PART)); } SEAM(9);
    if (IN(10)) { phase_rowpass(p, (const float*)(ws + WS_T), 0, 1.0f, p.in(31), p.in(32), (bf16_t*)(ws + WS_XN), (const float*)(ws + WS_PART), DM / KSL); } SEAM(10);
    if (IN(11)) { EpiSwiglu E{(bf16_t*)(ws + WS_G)}; run_gemm(lds, (const bf16_t*)(ws + WS_XN), (const bf16_t*)(ws + WS_W3T), NFF, DM, E); } SEAM(11);
    if (IN(12)) { EpiF32 E{(float*)(ws + WS_F)}; run_gemm(lds, (const bf16_t*)(ws + WS_G), (const bf16_t*)(ws + WS_W4T), DM, DFF, E, MPR); run_gemm_sample(lds, (const bf16_t*)(ws + WS_G), (const bf16_t*)(ws + WS_W4T), DFF, (float*)(ws + WS_PART)); } SEAM(12);
    if (IN(13)) { phase_rowpass(p, (const float*)(ws + WS_F), 0, 0.5f, p.in(35), nullptr, nullptr, (const float*)(ws + WS_PART), DFF / KSL); }
#undef IN
#undef SEAM
#undef ws
}

extern "C" void kernel_launch(void* const* d_in, const int* in_sizes, int n_in, void* d_out, int out_size, void* d_ws, size_t ws_size, hipStream_t stream) {
    static int grid = 0;
    if (grid == 0) {
        int dev = 0, cus = 0, per_cu = 0;
        (void)hipGetDevice(&dev);
        (void)hipDeviceGetAttribute(&cus, hipDeviceAttributeMultiprocessorCount, dev);
        (void)hipFuncSetAttribute((const void*)fwd_kernel, hipFuncAttributeMaxDynamicSharedMemorySize, LDS_BYTES);
        if (hipOccupancyMaxActiveBlocksPerMultiprocessor(&per_cu, (const void*)fwd_kernel, 512, LDS_BYTES) != hipSuccess || per_cu < 1) per_cu = 1;
        (void)hipGetLastError();
        grid = cus * per_cu;
        if (grid <= 0) grid = 256;
        if (n_in != 36 || (size_t)out_size != O_END || ws_size < WS_NEED) { fprintf(stderr, "kernel_launch: unexpected sizes n_in %d out %d ws %zu (need %zu)\n", n_in, out_size, ws_size, (size_t)WS_NEED); grid = -1; }
    }
    if (grid < 0) return;
    Params p{};
    for (int i = 0; i < 36; ++i) p.in[i] = (const float*)d_in[i];
    p.out = (float*)d_out; p.ws = (unsigned char*)d_ws;
    (void)hipMemsetAsync((unsigned char*)d_ws + WS_CTR, 0, 4096 + 3456 * 4, stream);
#if SINGLE_LAUNCH
    p.ph_lo = 0; p.ph_hi = NPHASE;
    void* args[] = {&p};
    hipError_t e = hipLaunchCooperativeKernel((const void*)fwd_kernel, dim3(grid), dim3(512), args, LDS_BYTES, stream);
    if (e != hipSuccess) fprintf(stderr, "cooperative launch failed: %s (grid %d)\n", hipGetErrorString(e), grid);
#else
    for (int ph = 0; ph < NPHASE; ++ph) { p.ph_lo = ph; p.ph_hi = ph + 1; hipLaunchKernelGGL(fwd_kernel, dim3(grid), dim3(512), LDS_BYTES, stream, p); }
#endif
}
```

```cpp
#include <hip/hip_runtime.h>
#include <hip/hip_cooperative_groups.h>
#include <cstdio>
#include <cstdint>
namespace cg = cooperative_groups;
namespace pg8 {
#define PG8_LAS __attribute__((address_space(3)))
typedef unsigned short bf16_t;
typedef short bf16x8 __attribute__((ext_vector_type(8)));
typedef float f32x4 __attribute__((ext_vector_type(4)));
typedef unsigned u32x4 __attribute__((ext_vector_type(4)));
constexpr int BM = 256, BK = 64, HALF = 128, HTB = HALF * BK * 2  , STAGE_BYTES = 8 * HTB, NXCD = 8, WGM = 8;

__host__ __device__ __forceinline__ int lds_byte(int r, int c) { const int st = (r >> 4) * 2 + (c >> 5), rr = r & 15, cc = c & 31, ob = rr * 64 + cc * 2; return st * 1024 + (ob ^ (((ob >> 9) & 1) << 5)); }
__host__ __device__ __forceinline__ void stage_rc(int b, int& R, int& C) { const int st = b / 1024, sb = b % 1024, swz = sb ^ (((sb >> 9) & 1) << 5); R = (st >> 1) * 16 + swz / 64; C = (st & 1) * 32 + (swz % 64) / 2; }
__host__ __device__ __forceinline__ int perm32(int rho) { const int n = rho >> 4, i = rho & 15; return 8 * (i >> 2) + 4 * n + (i & 3); }

struct Unit { int pm, pn; };
struct Gemm { const bf16_t* A; const bf16_t* Bt; int M, N, K, ld; };

struct StaticOrder {
    int nM, nN, nwg, G, c;
    __host__ __device__ void init(int M, int N, int G_, int c_) { nM = M / BM; nN = N / BM; nwg = nM * nN; G = G_; c = c_; }
    __host__ __device__ bool next(int i, Unit& u) const {
        const long L = (long)i * G + c; if (L >= nwg) return false;
        int wgid = (int)L; { const int q = nwg / NXCD, r = nwg % NXCD, xcd = wgid % NXCD, off = wgid / NXCD; wgid = (xcd < r ? xcd * (q + 1) : r * (q + 1) + (xcd - r) * q) + off; }
        const int nig = WGM * nN, gid = wgid / nig, fm = gid * WGM, gsz = (nM - fm) < WGM ? (nM - fm) : WGM;
        u.pm = fm + ((wgid % nig) % gsz); u.pn = (wgid % nig) / gsz; return true;
    }
    __device__ __forceinline__ void a_ready(const Unit&) const {}
    __device__ __forceinline__ void done(const Unit&) const {}
};

__device__ __forceinline__ unsigned cvt_pk_bf16(float lo, float hi) { unsigned r; asm volatile("v_cvt_pk_bf16_f32 %0, %1, %2" : "=v"(r) : "v"(lo), "v"(hi)); return r; }
typedef float f32x2 __attribute__((ext_vector_type(2)));
template <class Epi, class Sched, bool ALIGN_EPI = false, bool SP2 = false>
__device__ __forceinline__ void gemm_phase(PG8_LAS unsigned char* lds, const Gemm g, const Sched& S, const Epi& E) {
    const int tid = threadIdx.x, wid = __builtin_amdgcn_readfirstlane(tid >> 6), lane = tid & 63, wr = wid >> 2, wc = wid & 3, fr = lane & 15, fq = lane >> 4;
    const int K = g.K, nt = K / BK;
    unsigned voffA[2], voffB[2];
#pragma unroll
    for (int i = 0; i < 2; ++i) { int R, C; stage_rc(tid * 16 + i * 8192, R, C); const int Rb = Epi::PERM ? ((R & ~31) + perm32(R & 31)) : R;
        voffA[i] = (unsigned)(R * g.ld + C) * 2u; voffB[i] = (unsigned)(Rb * g.ld + C) * 2u; }
    const size_t kstep = (size_t)(BK * 2);
    const size_t hstep = (size_t)HALF * g.ld * 2;
    const size_t tstep = 2 * hstep;
    const unsigned ldsw = (unsigned)wid * 1024u;
    const int aoff = lds_byte(wr * 64 + fr, fq * 8), boff = lds_byte(wc * 32 + fr, fq * 8);
#define PG8_SA(b, h) (((b) * 2 + (h)) * HTB)
#define PG8_SB(b, h) ((4 + (b) * 2 + (h)) * HTB)
#define PG8_STAGE(bufoff, gbase, voff) do { _Pragma("unroll") for (int _i = 0; _i < 2; ++_i) \
        __builtin_amdgcn_global_load_lds((const unsigned*)((const char*)(gbase) + (voff)[_i]), (PG8_LAS unsigned*)(lds + (bufoff) + ldsw + _i * 8192), 16, 0, 0); } while (0)
#define PG8_LDA(dst, b, h) do { _Pragma("unroll") for (int m = 0; m < 4; ++m) _Pragma("unroll") for (int k = 0; k < 2; ++k) dst[m][k] = *(const PG8_LAS bf16x8*)(lds + PG8_SA(b, h) + aoff + m * 2048 + k * 1024); } while (0)
#define PG8_LDB(dst, b, h) do { _Pragma("unroll") for (int n = 0; n < 2; ++n) _Pragma("unroll") for (int k = 0; k < 2; ++k) dst[n][k] = *(const PG8_LAS bf16x8*)(lds + PG8_SB(b, h) + boff + n * 2048 + k * 1024); } while (0)
#define PG8_MMA(ai, bj, At, Bt) do { __builtin_amdgcn_s_setprio(1); _Pragma("unroll") for (int m = 0; m < 4; ++m) _Pragma("unroll") for (int n = 0; n < 2; ++n) _Pragma("unroll") for (int k = 0; k < 2; ++k) \
        acc[ai][bj][m][n] = __builtin_amdgcn_mfma_f32_16x16x32_bf16(Bt[n][k], At[m][k], acc[ai][bj][m][n], 0, 0, 0); __builtin_amdgcn_s_setprio(0); } while (0)
#define PG8_WAIT_V(n) asm volatile("s_waitcnt vmcnt(" #n ")" ::: "memory")
#define PG8_WAIT_L(n) asm volatile("s_waitcnt lgkmcnt(" #n ")" ::: "memory")
#define PG8_BAR __builtin_amdgcn_s_barrier()
#define PG8_SCHED __builtin_amdgcn_sched_barrier(0)
    Unit cur, nxt; int ui = 0;
    if (!S.next(0, cur)) return;
    f32x4 acc[2][2][4][2];
#pragma unroll
    for (int a = 0; a < 2; ++a)
#pragma unroll
        for (int b = 0; b < 2; ++b)
#pragma unroll
            for (int m = 0; m < 4; ++m)
#pragma unroll
                for (int n = 0; n < 2; ++n) acc[a][b][m][n] = (f32x4){0.f, 0.f, 0.f, 0.f};
    bf16x8 At[4][2], B0[2][2], B1[2][2];
    const char* cA = (const char*)g.A + (size_t)cur.pm * tstep; const char* cB = (const char*)g.Bt + (size_t)cur.pn * tstep;
    S.a_ready(cur);
    if constexpr (SP2) {
        PG8_STAGE(PG8_SB(0, 0), cB, voffB); PG8_STAGE(PG8_SB(0, 1), cB + hstep, voffB); PG8_STAGE(PG8_SA(0, 0), cA, voffA); PG8_STAGE(PG8_SA(0, 1), cA + hstep, voffA);
        if (wr == 1) PG8_BAR;
        PG8_WAIT_V(2); PG8_BAR;
        PG8_STAGE(PG8_SB(1, 0), cB + kstep, voffB); PG8_STAGE(PG8_SA(1, 0), cA + kstep, voffA); PG8_STAGE(PG8_SB(1, 1), cB + hstep + kstep, voffB);
        PG8_WAIT_V(6); PG8_BAR;
    } else {
        PG8_STAGE(PG8_SB(0, 0), cB, voffB); PG8_STAGE(PG8_SA(0, 0), cA, voffA); PG8_STAGE(PG8_SB(0, 1), cB + hstep, voffB); PG8_STAGE(PG8_SA(0, 1), cA + hstep, voffA);
        if (wr == 1) PG8_BAR;
        PG8_WAIT_V(4); PG8_BAR;
        PG8_STAGE(PG8_SB(1, 0), cB + kstep, voffB); PG8_STAGE(PG8_SA(1, 0), cA + kstep, voffA); PG8_STAGE(PG8_SB(1, 1), cB + hstep + kstep, voffB);
        PG8_WAIT_V(6); PG8_BAR;
    }
    for (;;) {
        const bool has_next = S.next(ui + 1, nxt);
        const char* nA = has_next ? (const char*)g.A + (size_t)nxt.pm * tstep : cA; const char* nB = has_next ? (const char*)g.Bt + (size_t)nxt.pn * tstep : cB;
        for (int t = 0; t < nt; t += 2) {
            const bool last = (t == nt - 2);
            const char* a1 = cA + (size_t)(t + 1) * kstep;
            const char* a2 = last ? nA : cA + (size_t)(t + 2) * kstep; const char* b2 = last ? nB : cB + (size_t)(t + 2) * kstep;
            const char* a3 = a2 + kstep; const char* b3 = b2 + kstep;
            if (last && has_next) S.a_ready(nxt);
            if constexpr (SP2) {
            PG8_LDB(B0, 0, 0); PG8_LDB(B1, 0, 1); PG8_SCHED; PG8_LDA(At, 0, 0); PG8_STAGE(PG8_SA(1, 1), a1 + hstep, voffA);
            PG8_WAIT_V(8); PG8_WAIT_L(0); PG8_BAR; PG8_MMA(0, 0, At, B0); PG8_MMA(0, 1, At, B1); PG8_BAR; PG8_SCHED;
            PG8_LDA(At, 0, 1); PG8_STAGE(PG8_SB(0, 0), b2, voffB); PG8_STAGE(PG8_SB(0, 1), b2 + hstep, voffB); PG8_STAGE(PG8_SA(0, 0), a2, voffA);
            PG8_WAIT_V(8); PG8_WAIT_L(0); PG8_BAR; PG8_MMA(1, 0, At, B0); PG8_MMA(1, 1, At, B1); PG8_BAR; PG8_SCHED;
            PG8_LDB(B0, 1, 0); PG8_LDB(B1, 1, 1); PG8_SCHED; PG8_LDA(At, 1, 0); PG8_STAGE(PG8_SA(0, 1), a2 + hstep, voffA);
            PG8_WAIT_V(8); PG8_WAIT_L(0); PG8_BAR; PG8_MMA(0, 0, At, B0); PG8_MMA(0, 1, At, B1); PG8_BAR; PG8_SCHED;
            PG8_LDA(At, 1, 1); PG8_STAGE(PG8_SB(1, 0), b3, voffB); PG8_STAGE(PG8_SB(1, 1), b3 + hstep, voffB); PG8_STAGE(PG8_SA(1, 0), a3, voffA);
            PG8_WAIT_V(8); PG8_WAIT_L(0); PG8_BAR; PG8_MMA(1, 0, At, B0); PG8_MMA(1, 1, At, B1); PG8_BAR; PG8_SCHED;
            } else {
            PG8_LDB(B0, 0, 0); PG8_SCHED; PG8_LDA(At, 0, 0); PG8_STAGE(PG8_SA(1, 1), a1 + hstep, voffA);
            PG8_WAIT_L(8); PG8_BAR; PG8_WAIT_L(0); PG8_MMA(0, 0, At, B0); PG8_BAR; PG8_SCHED;
            PG8_LDB(B1, 0, 1); PG8_STAGE(PG8_SB(0, 0), b2, voffB);
            PG8_BAR; PG8_WAIT_L(0); PG8_MMA(0, 1, At, B1); PG8_BAR;
            PG8_LDA(At, 0, 1); PG8_STAGE(PG8_SA(0, 0), a2, voffA);
            PG8_BAR; PG8_WAIT_L(0); PG8_MMA(1, 0, At, B0); PG8_BAR; PG8_SCHED;
            PG8_STAGE(PG8_SB(0, 1), b2 + hstep, voffB);
            PG8_WAIT_V(6); PG8_BAR; PG8_MMA(1, 1, At, B1); PG8_BAR;
            PG8_LDB(B0, 1, 0); PG8_SCHED; PG8_LDA(At, 1, 0); PG8_STAGE(PG8_SA(0, 1), a2 + hstep, voffA);
            PG8_WAIT_L(8); PG8_BAR; PG8_WAIT_L(0); PG8_MMA(0, 0, At, B0); PG8_BAR; PG8_SCHED;
            PG8_LDB(B1, 1, 1); PG8_STAGE(PG8_SB(1, 0), b3, voffB);
            PG8_BAR; PG8_WAIT_L(0); PG8_MMA(0, 1, At, B1); PG8_BAR;
            PG8_LDA(At, 1, 1); PG8_STAGE(PG8_SA(1, 0), a3, voffA);
            PG8_BAR; PG8_WAIT_L(0); PG8_MMA(1, 0, At, B0); PG8_BAR; PG8_SCHED;
            PG8_STAGE(PG8_SB(1, 1), b3 + hstep, voffB);
            PG8_WAIT_V(6); PG8_BAR; PG8_MMA(1, 1, At, B1); PG8_BAR;
            }
        }
        if constexpr (ALIGN_EPI) { if (wr == 0) PG8_BAR; }
        if constexpr (!Epi::AFTER_DRAIN) { E(acc, cur, wr, wc, fr, fq); S.done(cur); }
        if (!has_next) break;
#pragma unroll
        for (int a = 0; a < 2; ++a)
#pragma unroll
            for (int b = 0; b < 2; ++b)
#pragma unroll
                for (int m = 0; m < 4; ++m)
#pragma unroll
                    for (int n = 0; n < 2; ++n) acc[a][b][m][n] = (f32x4){0.f, 0.f, 0.f, 0.f};
        cur = nxt; cA = nA; cB = nB; ++ui;
        if constexpr (ALIGN_EPI) { if (wr == 1) PG8_BAR; }
    }
    PG8_WAIT_V(0);
    if constexpr (!ALIGN_EPI) { if (wr == 0) PG8_BAR; }
    PG8_BAR;
    if constexpr (Epi::AFTER_DRAIN) { E.fused(acc, cur, wr, wc, fr, fq, lds, wid, lane); S.done(cur); }
#undef PG8_SA
#undef PG8_SB
#undef PG8_STAGE
#undef PG8_LDA
#undef PG8_LDB
#undef PG8_MMA
#undef PG8_WAIT_V
#undef PG8_WAIT_L
#undef PG8_BAR
#undef PG8_SCHED
}
}

constexpr int DM = 1024, TP = 4096, BP = 4, MPR = BP * TP, BS = 8, TS = 16, MR = MPR + BS * TS, MP = 16640;
constexpr int DFF = 2816, NFF = 2 * DFF, INW = 5376, SHW = 1792, PAST = 4096, NPOS = PAST + TS;
constexpr float EPS = 1e-6f, LNX_EPS = 64e-5f;
constexpr float QSCALE = 0.125f * 1.4426950408889634f;
constexpr size_t O_Y = 0, O_KP = (size_t)MR * DM, O_VP = O_KP + (size_t)MPR * 512, O_SP = O_VP + (size_t)MPR * 512, O_SHP = O_SP + 131072,
                 O_KS = O_SHP + 7168, O_VS = O_KS + 65536, O_SS = O_VS + 65536, O_SHS = O_SS + 262144, O_END = O_SHS + 14336;
constexpr size_t KiB = 1024, MiB = 1u << 20;
constexpr size_t WS_W1T = 0, WS_W2T = 11 * MiB, WS_WINT = 16 * MiB + 512 * KiB, WS_WAT = 27 * MiB, WS_WRT = 28 * MiB, WS_WOT = 29 * MiB, WS_W3T = 31 * MiB, WS_W4T = 42 * MiB,
                 WS_TAB = 48 * MiB, WS_CTR = 49 * MiB + 512 * KiB, WS_ORW = 0,
                 WS_XN = 50 * MiB, WS_ABUF = 50 * MiB, WS_GG = 66 * MiB + 256 * KiB, WS_MG = 50 * MiB,
                 WS_G = 82 * MiB + 512 * KiB, WS_QB = WS_G, WS_KB = 98 * MiB + 768 * KiB, WS_VT = 115 * MiB, WS_ZRW = 131 * MiB + 256 * KiB,
                 WS_GATE = 188 * MiB + 128 * KiB, WS_DEC = 253 * MiB + 128 * KiB, WS_T = WS_KB, WS_F = 171 * MiB + 896 * KiB, WS_NEED = 286 * MiB;
constexpr size_t WS_LW = 49 * MiB + 64 * KiB;
static_assert(WS_ZRW + (size_t)MP * SHW * 2 <= WS_GATE && WS_GATE + (size_t)MP * 2048 * 2 <= WS_DEC && WS_DEC + (size_t)MP * 512 * 4 <= WS_NEED, "ws map");
static_assert(WS_G + (size_t)MP * DFF * 2 <= WS_F && WS_F + (size_t)MP * DM * 4 <= WS_NEED && WS_T + (size_t)MP * DM * 4 <= WS_F, "ws map 2");
static_assert(WS_XN + (size_t)MP * DM * 2 <= WS_G && WS_ORW + (size_t)MP * 512 * 2 <= WS_WINT && WS_VT + (size_t)MP * 512 * 2 <= WS_ZRW, "ws map 3");

#define LAS __attribute__((address_space(3)))
typedef unsigned short bf16_t;
typedef short bf16x8 __attribute__((ext_vector_type(8)));
typedef float f32x4 __attribute__((ext_vector_type(4)));
typedef float f32x2 __attribute__((ext_vector_type(2)));
typedef unsigned u32x4 __attribute__((ext_vector_type(4)));
typedef unsigned u32x2 __attribute__((ext_vector_type(2)));
typedef __bf16 bf16x2_t __attribute__((ext_vector_type(2)));
using pg8::Unit;

__device__ __forceinline__ unsigned pk2(float lo, float hi) { f32x2 v = {lo, hi}; bf16x2_t b = __builtin_convertvector(v, bf16x2_t); return __builtin_bit_cast(unsigned, b); }
__device__ __forceinline__ bf16_t f2bf(float f) { return (bf16_t)(pk2(f, 0.f) & 0xffffu); }
__device__ __forceinline__ float bf2f(bf16_t h) { return __uint_as_float((unsigned)h << 16); }
__device__ __forceinline__ float bflo(unsigned w) { return __uint_as_float(w << 16); }
__device__ __forceinline__ float bfhi(unsigned w) { return __uint_as_float(w & 0xffff0000u); }
__device__ __forceinline__ float fexp2(float x) { return __builtin_amdgcn_exp2f(x); }
__device__ __forceinline__ float frcp(float x) { return __builtin_amdgcn_rcpf(x); }
__device__ __forceinline__ float sigmoidf_(float x) { return frcp(1.f + fexp2(-1.4426950408889634f * x)); }
template <int CTRL> __device__ __forceinline__ float dpp_add_(float x) {
    return x + __builtin_bit_cast(float, __builtin_amdgcn_update_dpp(0, __builtin_bit_cast(int, x), CTRL, 0xf, 0xf, true));
}
__device__ __forceinline__ float wave_sum_fast(float x) {
    x = dpp_add_<0xB1>(x); x = dpp_add_<0x4E>(x); x = dpp_add_<0x141>(x); x = dpp_add_<0x140>(x);
    { auto rr = __builtin_amdgcn_permlane16_swap(__float_as_uint(x), __float_as_uint(x), false, false); x = __uint_as_float(rr[0]) + __uint_as_float(rr[1]); }
    { auto rr = __builtin_amdgcn_permlane32_swap(__float_as_uint(x), __float_as_uint(x), false, false); x = __uint_as_float(rr[0]) + __uint_as_float(rr[1]); }
    return x;
}
__device__ __forceinline__ float wave_sum(float v) { return wave_sum_fast(v); }
__device__ __forceinline__ float half_sum(float v) {
#pragma unroll
    for (int o = 1; o < 32; o <<= 1) v += __shfl_xor(v, o);
    return v;
}

struct Params {
    const float* in[36];
    float* out;
    unsigned char* ws;
    int ph_lo, ph_hi;
};
struct Ctx {
    const LAS unsigned* tab;
    __device__ __forceinline__ const void* ptr(int i) const {
        const unsigned lo = __builtin_amdgcn_readfirstlane(tab[2 * i]), hi = __builtin_amdgcn_readfirstlane(tab[2 * i + 1]);
        return (const void*)(const __attribute__((address_space(1))) void*)(((unsigned long long)hi << 32) | lo);
    }
    __device__ __forceinline__ const float* in(int i) const { return (const float*)ptr(i); }
    __device__ __forceinline__ float* out() const { return (float*)ptr(36); }
    __device__ __forceinline__ unsigned char* ws() const { return (unsigned char*)ptr(37); }
};

struct EpiSwiglu {
    static constexpr bool PERM = true, AFTER_DRAIN = false;
    bf16_t* O;
    __device__ __forceinline__ void operator()(const f32x4 (&acc)[2][2][4][2], const Unit& u, int wr, int wc, int fr, int fq) const {
        const int col0 = u.pn * 128 + wc * 32 + 8 * fq;
#pragma unroll
        for (int ai = 0; ai < 2; ++ai)
#pragma unroll
            for (int m = 0; m < 4; ++m) {
                const int row = u.pm * 256 + ai * 128 + wr * 64 + m * 16 + fr;
                float v[8];
#pragma unroll
                for (int n = 0; n < 2; ++n)
#pragma unroll
                    for (int i = 0; i < 4; ++i) { const float g = acc[ai][0][m][n][i], up = acc[ai][1][m][n][i]; v[n * 4 + i] = g * sigmoidf_(g) * up; }
                u32x4 w; w.x = pk2(v[0], v[1]); w.y = pk2(v[2], v[3]); w.z = pk2(v[4], v[5]); w.w = pk2(v[6], v[7]);
                if (row < MR) *(u32x4*)(O + (size_t)row * DFF + col0) = w;
                asm volatile("" ::: "memory");
            }
    }
};
struct EpiF32 {
    static constexpr bool PERM = false, AFTER_DRAIN = false;
    float* O;
    __device__ __forceinline__ void operator()(const f32x4 (&acc)[2][2][4][2], const Unit& u, int wr, int wc, int fr, int fq) const {
        const int col0 = u.pn * 256 + wc * 32 + 4 * fq;
#pragma unroll
        for (int ai = 0; ai < 2; ++ai)
#pragma unroll
            for (int m = 0; m < 4; ++m) {
                const int row = u.pm * 256 + ai * 128 + wr * 64 + m * 16 + fr;
                if (row < MR) {
#pragma unroll
                    for (int bj = 0; bj < 2; ++bj)
#pragma unroll
                        for (int n = 0; n < 2; ++n) *(f32x4*)(O + (size_t)row * DM + col0 + bj * 128 + n * 16) = acc[ai][bj][m][n];
                }
                asm volatile("" ::: "memory");
            }
    }
};
struct EpiGate1 {
    static constexpr bool PERM = true, AFTER_DRAIN = false;
    bf16_t* T; const bf16_t* GATE;
    __device__ __forceinline__ void operator()(const f32x4 (&acc)[2][2][4][2], const Unit& u, int wr, int wc, int fr, int fq) const {
        const int col0 = u.pn * 256 + wc * 32 + 8 * fq;
#pragma unroll
        for (int ai = 0; ai < 2; ++ai)
#pragma unroll
            for (int m = 0; m < 4; ++m) {
                const int row = u.pm * 256 + ai * 128 + wr * 64 + m * 16 + fr;
                if (row < MR) {
#pragma unroll
                    for (int bj = 0; bj < 2; ++bj) {
                        const u32x4 gv = *(const u32x4*)(GATE + (size_t)row * 2048 + col0 + bj * 128);
                        f32x4 a = acc[ai][bj][m][0], b = acc[ai][bj][m][1];
                        a[0] *= bflo(gv.x); a[1] *= bfhi(gv.x); a[2] *= bflo(gv.y); a[3] *= bfhi(gv.y);
                        b[0] *= bflo(gv.z); b[1] *= bfhi(gv.z); b[2] *= bflo(gv.w); b[3] *= bfhi(gv.w);
                        u32x4 w; w.x = pk2(a[0], a[1]); w.y = pk2(a[2], a[3]); w.z = pk2(b[0], b[1]); w.w = pk2(b[2], b[3]);
                        *(u32x4*)(T + (size_t)row * DM + col0 + bj * 128) = w;
                    }
                }
                asm volatile("" ::: "memory");
            }
    }
};
struct EpiGate2 {
    static constexpr bool PERM = true, AFTER_DRAIN = false;
    const bf16_t* T; const bf16_t* GATE; bf16_t* MG;
    __device__ __forceinline__ void operator()(const f32x4 (&acc)[2][2][4][2], const Unit& u, int wr, int wc, int fr, int fq) const {
        const int col0 = u.pn * 256 + wc * 32 + 8 * fq;
#pragma unroll
        for (int ai = 0; ai < 2; ++ai)
#pragma unroll
            for (int m = 0; m < 4; ++m) {
                const int row = u.pm * 256 + ai * 128 + wr * 64 + m * 16 + fr;
                if (row < MR) {
#pragma unroll
                    for (int bj = 0; bj < 2; ++bj) {
                        const u32x4 gv = *(const u32x4*)(GATE + (size_t)row * 2048 + 1024 + col0 + bj * 128);
                        const u32x4 tv = *(const u32x4*)(T + (size_t)row * DM + col0 + bj * 128);
                        f32x4 a = (f32x4){bflo(tv.x), bfhi(tv.x), bflo(tv.y), bfhi(tv.y)}, b = (f32x4){bflo(tv.z), bfhi(tv.z), bflo(tv.w), bfhi(tv.w)};
                        const f32x4 x = acc[ai][bj][m][0], y = acc[ai][bj][m][1];
                        a[0] += x[0] * bflo(gv.x); a[1] += x[1] * bfhi(gv.x); a[2] += x[2] * bflo(gv.y); a[3] += x[3] * bfhi(gv.y);
                        b[0] += y[0] * bflo(gv.z); b[1] += y[1] * bfhi(gv.z); b[2] += y[2] * bflo(gv.w); b[3] += y[3] * bfhi(gv.w);
                        u32x4 w; w.x = pk2(a[0], a[1]); w.y = pk2(a[2], a[3]); w.z = pk2(b[0], b[1]); w.w = pk2(b[2], b[3]);
                        *(u32x4*)(MG + (size_t)row * DM + col0 + bj * 128) = w;
                    }
                }
                asm volatile("" ::: "memory");
            }
    }
};
struct EpiZ {
    static constexpr bool PERM = true, AFTER_DRAIN = false;
    float* out; bf16_t *QB, *KB, *VT, *ZRW, *GATE; const f32x2* TAB;
    __device__ __forceinline__ void operator()(const f32x4 (&acc)[2][2][4][2], const Unit& u, int wr, int wc, int fr, int fq) const {
        const int pn = u.pn;
#pragma unroll
        for (int ai = 0; ai < 2; ++ai)
#pragma unroll
            for (int m = 0; m < 4; ++m) {
                const int row = u.pm * 256 + ai * 128 + wr * 64 + m * 16 + fr;
                asm volatile("" ::: "memory");
                if (row >= MR) continue;
                const bool smp = row >= MPR;
                if (pn < 4) {
                    const int pos = smp ? PAST + ((row - MPR) & 15) : (row & (TP - 1));
                    const int d0 = 8 * fq;
                    float o1[8], o2[8];
#pragma unroll
                    for (int n = 0; n < 2; ++n)
#pragma unroll
                        for (int i = 0; i < 4; ++i) {
                            const f32x2 cs = TAB[pos * 32 + d0 + n * 4 + i];
                            const float x1 = acc[ai][0][m][n][i], x2 = acc[ai][1][m][n][i];
                            o1[n * 4 + i] = x1 * cs.x - x2 * cs.y; o2[n * 4 + i] = x1 * cs.y + x2 * cs.x;
                        }
                    const int cb = (pn & 1) * 256 + 64 * wc + d0;
                    if (pn < 2) {
                        u32x4 w1, w2;
                        w1.x = pk2(o1[0] * QSCALE, o1[1] * QSCALE); w1.y = pk2(o1[2] * QSCALE, o1[3] * QSCALE); w1.z = pk2(o1[4] * QSCALE, o1[5] * QSCALE); w1.w = pk2(o1[6] * QSCALE, o1[7] * QSCALE);
                        w2.x = pk2(o2[0] * QSCALE, o2[1] * QSCALE); w2.y = pk2(o2[2] * QSCALE, o2[3] * QSCALE); w2.z = pk2(o2[4] * QSCALE, o2[5] * QSCALE); w2.w = pk2(o2[6] * QSCALE, o2[7] * QSCALE);
                        *(u32x4*)(QB + (size_t)row * 512 + cb) = w1; *(u32x4*)(QB + (size_t)row * 512 + cb + 32) = w2;
                    } else {
                        float* ko = smp ? out + O_KS + (size_t)(row - MPR) * 512 + cb : out + O_KP + (size_t)row * 512 + cb;
                        *(f32x4*)ko = (f32x4){o1[0], o1[1], o1[2], o1[3]}; *(f32x4*)(ko + 4) = (f32x4){o1[4], o1[5], o1[6], o1[7]};
                        *(f32x4*)(ko + 32) = (f32x4){o2[0], o2[1], o2[2], o2[3]}; *(f32x4*)(ko + 36) = (f32x4){o2[4], o2[5], o2[6], o2[7]};
                        u32x4 w1, w2;
                        w1.x = pk2(o1[0], o1[1]); w1.y = pk2(o1[2], o1[3]); w1.z = pk2(o1[4], o1[5]); w1.w = pk2(o1[6], o1[7]);
                        w2.x = pk2(o2[0], o2[1]); w2.y = pk2(o2[2], o2[3]); w2.z = pk2(o2[4], o2[5]); w2.w = pk2(o2[6], o2[7]);
                        *(u32x4*)(KB + (size_t)row * 512 + cb) = w1; *(u32x4*)(KB + (size_t)row * 512 + cb + 32) = w2;
                    }
                } else {
#pragma unroll
                    for (int bj = 0; bj < 2; ++bj) {
                        const int c = pn * 256 + bj * 128 + wc * 32 + 8 * fq;
                        const f32x4 a = acc[ai][bj][m][0], b = acc[ai][bj][m][1];
                        if (pn < 6) {
                            const int vc = c - 1024;
                            float* vo = smp ? out + O_VS + (size_t)(row - MPR) * 512 + vc : out + O_VP + (size_t)row * 512 + vc;
                            *(f32x4*)vo = a; *(f32x4*)(vo + 4) = b;
                            if (!smp) {
                                const int bb = row >> 12, t = row & (TP - 1), hh = vc >> 7, dd = vc & 127;
                                bf16_t* vt = VT + ((size_t)(bb * 4 + hh) * 128 + dd) * TP + t;
                                vt[0] = f2bf(a[0]); vt[TP] = f2bf(a[1]); vt[2 * TP] = f2bf(a[2]); vt[3 * TP] = f2bf(a[3]);
                                vt[4 * TP] = f2bf(b[0]); vt[5 * TP] = f2bf(b[1]); vt[6 * TP] = f2bf(b[2]); vt[7 * TP] = f2bf(b[3]);
                            }
                        } else if (pn < 13) {
                            const int zc = c - 1536;
                            u32x4 w; w.x = pk2(a[0], a[1]); w.y = pk2(a[2], a[3]); w.z = pk2(b[0], b[1]); w.w = pk2(b[2], b[3]);
                            *(u32x4*)(ZRW + (size_t)row * SHW + zc) = w;
                            const bool last = smp ? (((row - MPR) & 15) == 15) : ((row & (TP - 1)) == TP - 1);
                            if (last) { float* so = smp ? out + O_SHS + (size_t)((row - MPR) >> 4) * SHW + zc : out + O_SHP + (size_t)(row >> 12) * SHW + zc;
                                *(f32x4*)so = a; *(f32x4*)(so + 4) = b; }
                        } else {
                            const int gc = c - 3328;
                            u32x4 w; w.x = pk2(sigmoidf_(a[0]), sigmoidf_(a[1])); w.y = pk2(sigmoidf_(a[2]), sigmoidf_(a[3])); w.z = pk2(sigmoidf_(b[0]), sigmoidf_(b[1])); w.w = pk2(sigmoidf_(b[2]), sigmoidf_(b[3]));
                            *(u32x4*)(GATE + (size_t)row * 2048 + gc) = w;
                        }
                    }
                }
            }
    }
};

__device__ __forceinline__ void transpose_item(const float* W, int K, int N, bf16_t* WT, int k0, int n0, int drow0, LAS float* scr, int lane) {
#pragma unroll 8
    for (int i = 0; i < 32; ++i) { const int kk = 2 * i + (lane >> 5); scr[kk * 33 + (lane & 31)] = W[(size_t)(k0 + kk) * N + n0 + (lane & 31)]; }
    asm volatile("s_waitcnt lgkmcnt(0)" ::: "memory");
    const int c = lane & 7;
#pragma unroll
    for (int j = 0; j < 4; ++j) { const int n = (lane >> 3) + 8 * j; const LAS float* s = scr + (8 * c) * 33 + n;
        u32x4 o; o.x = pk2(s[0 * 33], s[1 * 33]); o.y = pk2(s[2 * 33], s[3 * 33]); o.z = pk2(s[4 * 33], s[5 * 33]); o.w = pk2(s[6 * 33], s[7 * 33]);
        *(u32x4*)(WT + (size_t)(drow0 + n) * K + k0 + 8 * c) = o; }
    asm volatile("s_waitcnt lgkmcnt(0)" ::: "memory");
}
__device__ __forceinline__ int map_w1(int n) { return n < DFF ? 256 * (n >> 7) + (n & 127) : 256 * ((n - DFF) >> 7) + 128 + ((n - DFF) & 127); }
__device__ __forceinline__ int map_win(int n) { return n < 1024 ? (n & ~255) + 128 * ((n >> 5) & 1) + 32 * ((n >> 6) & 3) + (n & 31) : n; }

__device__ __forceinline__ void sincos_d(double ang, float& c, float& s) {
    const double TWO_PI = 6.283185307179586476925286766559, HALF_PI = 1.5707963267948966192313216916398;
    double r = ang - TWO_PI * __builtin_rint(ang / TWO_PI);
    const double qd = __builtin_rint(r / HALF_PI); const int q = (int)qd; r -= qd * HALF_PI;
    const double r2 = r * r;
    double sp = r * (1.0 + r2 * (-1.0 / 6 + r2 * (1.0 / 120 + r2 * (-1.0 / 5040 + r2 * (1.0 / 362880 + r2 * (-1.0 / 39916800 + r2 * (1.0 / 6227020800.0)))))));
    double cp = 1.0 + r2 * (-0.5 + r2 * (1.0 / 24 + r2 * (-1.0 / 720 + r2 * (1.0 / 40320 + r2 * (-1.0 / 3628800 + r2 * (1.0 / 479001600.0 + r2 * (-1.0 / 87178291200.0)))))));
    double cc, ss;
    switch (q & 3) { case 0: cc = cp; ss = sp; break; case 1: cc = -sp; ss = cp; break; case 2: cc = -cp; ss = -sp; break; default: cc = sp; ss = -cp; break; }
    c = (float)cc; s = (float)ss;
}
__device__ __forceinline__ void rms_row_to_bf16(const float* xrow, const float* g, bf16_t* orow, int lane) {
    const f32x4* xr = (const f32x4*)xrow + lane; const f32x4* gr = (const f32x4*)g + lane;
    f32x4 v[4]; float s = 0.f;
#pragma unroll
    for (int j = 0; j < 4; ++j) { v[j] = xr[64 * j]; s += (v[j].x * v[j].x + v[j].y * v[j].y) + (v[j].z * v[j].z + v[j].w * v[j].w); }
    const float rs = 1.f / sqrtf(wave_sum(s) * (1.f / DM) + EPS);
    u32x2* o8 = (u32x2*)orow + lane;
#pragma unroll
    for (int j = 0; j < 4; ++j) { const f32x4 gg = gr[64 * j]; u32x2 w; w.x = pk2(v[j].x * rs * gg.x, v[j].y * rs * gg.y); w.y = pk2(v[j].z * rs * gg.z, v[j].w * rs * gg.w); o8[64 * j] = w; }
}
__device__ __forceinline__ const float* xrow_ptr(const Ctx& p, int row) { return row < MPR ? p.in(0) + (size_t)row * DM : p.in(1) + (size_t)(row - MPR) * DM; }

__device__ __forceinline__ void prologue_part2(const Ctx& p, LAS unsigned char* lds, int bidx, int nblk) {
    const int tid = threadIdx.x, lane = tid & 63, wave = __builtin_amdgcn_readfirstlane(tid >> 6);
    const int gw = bidx * 8 + wave, NGW = nblk * 8;
    unsigned char* ws = p.ws();
    LAS float* scr = (LAS float*)(lds + wave * 16384);
    constexpr int I2 = 44 * 32, I3 = 16 * 168, I4 = 8 * 32, I5 = 8 * 32, I6 = 16 * 32;
    __syncthreads();
    for (int it = gw; it < I2 + I3 + I4 + I5 + I6; it += NGW) {
        int r = it;
        if (r < I2) { const int kb = r / 32, nb = r % 32; transpose_item(p.in(8), DFF, DM, (bf16_t*)(ws + WS_W2T), 64 * kb, 32 * nb, 32 * nb, scr, lane); continue; } r -= I2;
        if (r < I3) { const int kb = r / 168, nb = r % 168; transpose_item(p.in(11), DM, INW, (bf16_t*)(ws + WS_WINT), 64 * kb, 32 * nb, map_win(32 * nb), scr, lane); continue; } r -= I3;
        if (r < I4) { const int kb = r / 32, nb = r % 32; transpose_item(p.in(28), 512, DM, (bf16_t*)(ws + WS_WAT), 64 * kb, 32 * nb, 32 * nb, scr, lane); continue; } r -= I4;
        if (r < I5) { const int kb = r / 32, nb = r % 32; transpose_item(p.in(29), 512, DM, (bf16_t*)(ws + WS_WRT), 64 * kb, 32 * nb, 32 * nb, scr, lane); continue; } r -= I5;
        { const int kb = r / 32, nb = r % 32; transpose_item(p.in(30), DM, DM, (bf16_t*)(ws + WS_WOT), 64 * kb, 32 * nb, 32 * nb, scr, lane); }
    }
    {   bf16_t* LW = (bf16_t*)(ws + WS_LW);
        for (int e = bidx * 512 + tid; e < 512 * 256; e += nblk * 512) {
            const int n = e & 511, k = e >> 9;
            if (k < 64) LW[n * 64 + k] = f2bf(p.in(19)[k * 512 + n]);
            else if (k < 128) LW[512 * 64 + n * 64 + (k - 64)] = f2bf(p.in(21)[(k - 64) * 512 + n]);
            else LW[2 * 512 * 64 + n * 128 + (k - 128)] = f2bf(p.in(22)[(k - 128) * 512 + n]);
        } }
    for (int e = bidx * 512 + tid; e < NPOS * 32; e += nblk * 512) {
        const int pos = e >> 5, d = e & 31;
        const double inv = exp(-(double)d * (9.210340371976182736071965818737 / 32.0));
        float c, s; sincos_d((double)pos * inv, c, s);
        ((f32x2*)(ws + WS_TAB))[e] = (f32x2){c, s};
    }
}
__device__ __forceinline__ void phase_prologue(const Ctx& p, LAS unsigned char* lds) {
    const int tid = threadIdx.x, lane = tid & 63, wave = __builtin_amdgcn_readfirstlane(tid >> 6);
    const int gw = blockIdx.x * 8 + wave, NGW = gridDim.x * 8;
    unsigned char* ws = p.ws();
    LAS float* scr = (LAS float*)(lds + wave * 16384);
    constexpr int I1 = 16 * 176;
    for (int it = gw; it < I1; it += NGW) { const int kb = it / 176, nb = it % 176; transpose_item(p.in(7), DM, NFF, (bf16_t*)(ws + WS_W1T), 64 * kb, 32 * nb, map_w1(32 * nb), scr, lane); }
    bf16_t* XN = (bf16_t*)(ws + WS_XN);
    {   f32x4 g4[4], v[4], v2[4];
#pragma unroll
        for (int j = 0; j < 4; ++j) g4[j] = ((const f32x4*)p.in(6))[lane + 64 * j];
        if (gw < MR) {
#pragma unroll
            for (int j = 0; j < 4; ++j) v[j] = ((const f32x4*)xrow_ptr(p, gw))[lane + 64 * j]; }
        for (int m = gw; m < MP; m += NGW) {
            const int mn = m + NGW;
            if (mn < MR) {
#pragma unroll
                for (int j = 0; j < 4; ++j) v2[j] = ((const f32x4*)xrow_ptr(p, mn))[lane + 64 * j]; }
            u32x2* o8 = (u32x2*)(XN + (size_t)m * DM) + lane;
            if (m < MR) {
                float sq = 0.f;
#pragma unroll
                for (int j = 0; j < 4; ++j) sq += (v[j].x * v[j].x + v[j].y * v[j].y) + (v[j].z * v[j].z + v[j].w * v[j].w);
                const float rs = 1.f / sqrtf(wave_sum(sq) * (1.f / DM) + EPS);
#pragma unroll
                for (int j = 0; j < 4; ++j) { u32x2 w; w.x = pk2(v[j].x * rs * g4[j].x, v[j].y * rs * g4[j].y); w.y = pk2(v[j].z * rs * g4[j].z, v[j].w * rs * g4[j].w); o8[64 * j] = w; }
            } else {
#pragma unroll
                for (int j = 0; j < 4; ++j) o8[64 * j] = (u32x2){0u, 0u}; }
#pragma unroll
            for (int j = 0; j < 4; ++j) v[j] = v2[j];
        }
    }
}

__device__ __forceinline__ void phase_rowpass(const Ctx& p, const float* F, int base_is_x, float alpha, const float* gpost, const float* gnext, bf16_t* XN, const float* PART, int nsplit) {
    const int tid = threadIdx.x, lane = tid & 63, wave = __builtin_amdgcn_readfirstlane(tid >> 6);
    const int gw = blockIdx.x * 8 + wave, NGW = gridDim.x * 8;
    float* H = p.out() + O_Y;
    auto loadrow = [&](int m, f32x4 (&f)[4], f32x4 (&b)[4]) {
        const f32x4* fr = (const f32x4*)(F + (size_t)m * DM) + lane;
        const f32x4* br = (const f32x4*)(base_is_x ? xrow_ptr(p, m) : H + (size_t)m * DM) + lane;
#pragma unroll
        for (int j = 0; j < 4; ++j) { b[j] = br[64 * j];
            if (m < MPR) f[j] = fr[64 * j];
            else { f[j] = (f32x4){0.f, 0.f, 0.f, 0.f};
                for (int ks = 0; ks < nsplit; ++ks) f[j] = f[j] + ((const f32x4*)(PART + ((size_t)ks * 128 + (m - MPR)) * DM))[lane + 64 * j]; } }
    };
    f32x4 gp[4], gn[4];
#pragma unroll
    for (int j = 0; j < 4; ++j) { gp[j] = ((const f32x4*)gpost)[lane + 64 * j]; gn[j] = gnext ? ((const f32x4*)gnext)[lane + 64 * j] : (f32x4){0.f, 0.f, 0.f, 0.f}; }
    f32x4 f[4], b[4], f2[4], b2[4];
    if (gw < MR) loadrow(gw, f, b);
    for (int m = gw; m < MR; m += NGW) {
        const bool more = m + NGW < MR;
        if (more) loadrow(m + NGW, f2, b2);
        float s = 0.f;
#pragma unroll
        for (int j = 0; j < 4; ++j) s += (f[j].x * f[j].x + f[j].y * f[j].y) + (f[j].z * f[j].z + f[j].w * f[j].w);
        const float rs = alpha / sqrtf(wave_sum_fast(s) * (1.f / DM) + EPS);
        float s2 = 0.f;
#pragma unroll
        for (int j = 0; j < 4; ++j) { b[j] = b[j] + f[j] * rs * gp[j]; s2 += (b[j].x * b[j].x + b[j].y * b[j].y) + (b[j].z * b[j].z + b[j].w * b[j].w);
            ((f32x4*)(H + (size_t)m * DM))[lane + 64 * j] = b[j]; }
        if (gnext) {
            const float r2 = 1.f / sqrtf(wave_sum_fast(s2) * (1.f / DM) + EPS);
            u32x2* o8 = (u32x2*)(XN + (size_t)m * DM) + lane;
#pragma unroll
            for (int j = 0; j < 4; ++j) { u32x2 w; w.x = pk2(b[j].x * r2 * gn[j].x, b[j].y * r2 * gn[j].y); w.y = pk2(b[j].z * r2 * gn[j].z, b[j].w * r2 * gn[j].w); o8[64 * j] = w; }
        }
        if (more) {
#pragma unroll
            for (int j = 0; j < 4; ++j) { f[j] = f2[j]; b[j] = b2[j]; } }
    }
}

__device__ __forceinline__ float zshift(const Ctx& p, const bf16_t* ZRW, int row, int c) {
    const float z = bf2f(ZRW[(size_t)row * SHW + c]);
    float prev;
    if (row < MPR) prev = (row & (TP - 1)) ? bf2f(ZRW[(size_t)(row - 1) * SHW + c]) : 0.f;
    else { const int r = row - MPR; prev = (r & 15) ? bf2f(ZRW[(size_t)(row - 1) * SHW + c]) : p.in(5)[(size_t)(r >> 4) * SHW + c]; }
    return z + (prev - z) * p.in(17)[c];
}
__device__ __forceinline__ void unpack8(const u32x4 w, float (&f)[8]) { f[0] = bflo(w.x); f[1] = bfhi(w.x); f[2] = bflo(w.y); f[3] = bfhi(w.y); f[4] = bflo(w.z); f[5] = bfhi(w.z); f[6] = bflo(w.w); f[7] = bfhi(w.w); }
__device__ __forceinline__ void zshift8(const Ctx& p, const bf16_t* ZRW, int row, int c, const float (&mu)[8], float (&o)[8]) {
    float z[8], pv[8];
    unpack8(*(const u32x4*)(ZRW + (size_t)row * SHW + c), z);
    bool first; int bsmp = 0;
    if (row < MPR) first = (row & (TP - 1)) == 0; else { first = ((row - MPR) & 15) == 0; bsmp = (row - MPR) >> 4; }
    if (!first) unpack8(*(const u32x4*)(ZRW + (size_t)(row - 1) * SHW + c), pv);
    else if (row < MPR) {
#pragma unroll
        for (int e = 0; e < 8; ++e) pv[e] = 0.f;
    } else { const float* s0 = p.in(5) + (size_t)bsmp * SHW + c;
#pragma unroll
        for (int e = 0; e < 8; ++e) pv[e] = s0[e]; }
#pragma unroll
    for (int e = 0; e < 8; ++e) o[e] = z[e] + (pv[e] - z[e]) * mu[e];
}
__device__ __forceinline__ void phase_lora(const Ctx& p, LAS unsigned char* lds) {
    const int tid = threadIdx.x, lane = tid & 63, wave = __builtin_amdgcn_readfirstlane(tid >> 6), q = lane & 15, g = lane >> 4;
    const bf16_t* ZRW = (const bf16_t*)(p.ws() + WS_ZRW);
    float* DEC = (float*)(p.ws() + WS_DEC); bf16_t* AB = (bf16_t*)(p.ws() + WS_ABUF); bf16_t* GG = (bf16_t*)(p.ws() + WS_GG);
    const bf16_t* w2T = (const bf16_t*)(p.ws() + WS_LW); const bf16_t* a2T = w2T + 512 * 64; const bf16_t* g2T = a2T + 512 * 64;
    LAS bf16_t* X = (LAS bf16_t*)(lds + wave * 16 * 264 * 2);
    const float* mu = p.in(17) + 1536;
    for (int it = blockIdx.x + gridDim.x * wave; it < MR / 16; it += gridDim.x * 8) {
        const int r0 = it * 16;
        {
            const int tt = lane >> 2, cq = lane & 3, row = r0 + tt;
#pragma unroll
            for (int j = 0; j < 8; ++j) {
                const int c = cq * 64 + j * 8;
                float m8[8], z[8];
#pragma unroll
                for (int e = 0; e < 8; ++e) m8[e] = mu[c + e];
                zshift8(p, ZRW, row, 1536 + c, m8, z);
#pragma unroll
                for (int e = 0; e < 8; ++e) z[e] = cq == 0 ? tanhf(z[e]) : (cq == 1 ? z[e] : sigmoidf_(z[e]));
                u32x4 w; w.x = pk2(z[0], z[1]); w.y = pk2(z[2], z[3]); w.z = pk2(z[4], z[5]); w.w = pk2(z[6], z[7]);
                *(LAS u32x4*)(X + tt * 264 + c) = w;
            }
        }
        asm volatile("s_waitcnt lgkmcnt(0)" ::: "memory");
        bf16x8 bx[8];
#pragma unroll
        for (int ks = 0; ks < 8; ++ks) bx[ks] = *(const LAS bf16x8*)(X + q * 264 + ks * 32 + 8 * g);
        const int row = r0 + q;
#pragma unroll 2
        for (int nt = 0; nt < 32; ++nt) {
            const int n = nt * 16 + q;
            f32x4 aw = (f32x4){0.f, 0.f, 0.f, 0.f}, aa = aw, ag = aw;
#pragma unroll
            for (int ks = 0; ks < 2; ++ks) {
                aw = __builtin_amdgcn_mfma_f32_16x16x32_bf16(*(const bf16x8*)(w2T + n * 64 + ks * 32 + 8 * g), bx[ks], aw, 0, 0, 0);
                aa = __builtin_amdgcn_mfma_f32_16x16x32_bf16(*(const bf16x8*)(a2T + n * 64 + ks * 32 + 8 * g), bx[2 + ks], aa, 0, 0, 0);
            }
#pragma unroll
            for (int ks = 0; ks < 4; ++ks) ag = __builtin_amdgcn_mfma_f32_16x16x32_bf16(*(const bf16x8*)(g2T + n * 128 + ks * 32 + 8 * g), bx[4 + ks], ag, 0, 0, 0);
            const int c = nt * 16 + 4 * g;
            const f32x4 w0 = *(const f32x4*)(p.in(18) + c), a0 = *(const f32x4*)(p.in(20) + c);
            f32x4 dec; float av[4];
#pragma unroll
            for (int e = 0; e < 4; ++e) {
                const float x = w0[e] + aw[e];
                const float sp = fmaxf(-x, 0.f) + log1pf(expf(-fabsf(x)));
                dec[e] = expf(-expf(-sp - 0.5f));
                av[e] = sigmoidf_(a0[e] + aa[e]);
            }
            *(f32x4*)(DEC + (size_t)row * 512 + c) = dec;
            *(u32x2*)(AB + (size_t)row * 512 + c) = (u32x2){pk2(av[0], av[1]), pk2(av[2], av[3])};
            *(u32x2*)(GG + (size_t)row * 512 + c) = (u32x2){pk2(ag[0], ag[1]), pk2(ag[2], ag[3])};
        }
        asm volatile("s_waitcnt lgkmcnt(0)" ::: "memory");
    }
}

#define MFMA16(a, b, c) __builtin_amdgcn_mfma_f32_16x16x32_bf16((a), (b), (c), 0, 0, 0)
struct AttAcc { f32x4 O[2][8]; float m[2], l[2]; };
__device__ __forceinline__ void att_init(AttAcc& A) {
#pragma unroll
    for (int mm = 0; mm < 2; ++mm) { A.m[mm] = -1e30f; A.l[mm] = 0.f;
#pragma unroll
        for (int d = 0; d < 8; ++d) A.O[mm][d] = (f32x4){0.f, 0.f, 0.f, 0.f}; }
}
template <class LK> __device__ __forceinline__ void att_qk(AttAcc& A, const LK& lk, const bf16x8 (&bq)[2][2], int nvalid, int g, bf16x8 (&bP)[2][2]) {
#pragma unroll
    for (int mm = 0; mm < 2; ++mm) {
        f32x4 s[4];
#pragma unroll
        for (int t = 0; t < 4; ++t) { s[t] = (f32x4){0.f, 0.f, 0.f, 0.f};
#pragma unroll
            for (int ks = 0; ks < 2; ++ks) s[t] = MFMA16(lk(mm, ks, t), bq[mm][ks], s[t]); }
        if (nvalid < 64) {
#pragma unroll
            for (int t = 0; t < 4; ++t)
#pragma unroll
                for (int r = 0; r < 4; ++r) if (16 * t + 4 * g + r >= nvalid) s[t][r] = -1e30f;
        }
        float mx = s[0][0];
#pragma unroll
        for (int t = 0; t < 4; ++t)
#pragma unroll
            for (int r = 0; r < 4; ++r) mx = fmaxf(mx, s[t][r]);
        { auto rr = __builtin_amdgcn_permlane16_swap(__float_as_uint(mx), __float_as_uint(mx), false, false); mx = fmaxf(__uint_as_float(rr[0]), __uint_as_float(rr[1])); }
        { auto rr = __builtin_amdgcn_permlane32_swap(__float_as_uint(mx), __float_as_uint(mx), false, false); mx = fmaxf(__uint_as_float(rr[0]), __uint_as_float(rr[1])); }
        const float mnew = fmaxf(A.m[mm], mx), alpha = fexp2(A.m[mm] - mnew);
        const bool grew = __builtin_amdgcn_ballot_w64(mnew > A.m[mm]) != 0ull;
        A.m[mm] = mnew;
        float ls = 0.f;
#pragma unroll
        for (int t = 0; t < 4; ++t)
#pragma unroll
            for (int r = 0; r < 4; ++r) { s[t][r] = fexp2(s[t][r] - mnew); ls += s[t][r]; }
        A.l[mm] = A.l[mm] * alpha + ls;
        if (grew) {
#pragma unroll
            for (int d = 0; d < 8; ++d) A.O[mm][d] = A.O[mm][d] * alpha;
        }
#pragma unroll
        for (int k2 = 0; k2 < 2; ++k2) {
            u32x4 w; w.x = pk2(s[2 * k2][0], s[2 * k2][1]); w.y = pk2(s[2 * k2][2], s[2 * k2][3]); w.z = pk2(s[2 * k2 + 1][0], s[2 * k2 + 1][1]); w.w = pk2(s[2 * k2 + 1][2], s[2 * k2 + 1][3]);
            bP[mm][k2] = __builtin_bit_cast(bf16x8, w);
        }
        asm volatile("" ::: "memory");
    }
}
__device__ __forceinline__ void att_final(const AttAcc& A, float l0, float l1, float lam, const float* subg, bf16_t* orow, int g) {
    const float i0 = 1.f / l0, i1 = lam / l1;
    f32x4 o[8]; float ss = 0.f;
#pragma unroll
    for (int d = 0; d < 8; ++d) { o[d] = A.O[0][d] * i0 - A.O[1][d] * i1; ss += (o[d][0] * o[d][0] + o[d][1] * o[d][1]) + (o[d][2] * o[d][2] + o[d][3] * o[d][3]); }
    ss += __shfl_xor(ss, 16); ss += __shfl_xor(ss, 32);
    const float rs = 0.8f / sqrtf(ss * (1.f / 128.f) + EPS);
#pragma unroll
    for (int d = 0; d < 8; ++d) { const f32x4 gg = *(const f32x4*)(subg + 16 * d + 4 * g);
        u32x2 w; w.x = pk2(o[d][0] * rs * gg[0], o[d][1] * rs * gg[1]); w.y = pk2(o[d][2] * rs * gg[2], o[d][3] * rs * gg[3]);
        *(u32x2*)(orow + 16 * d + 4 * g) = w; }
}
__device__ __forceinline__ float att_lambda(const Ctx& p, int lane) {
    const float a = wave_sum(p.in(12)[lane] * p.in(13)[lane]), b = wave_sum(p.in(14)[lane] * p.in(15)[lane]);
    return expf(a) - expf(b) + 0.2f;
}
constexpr int KS_STRIDE = 136, VS_STRIDE = 72, ATT_BUF = 64 * KS_STRIDE + 128 * VS_STRIDE;
__device__ __forceinline__ void att_prompt_unit(const Ctx& p, int bh, int qb, LAS unsigned char* lds) {
    const int tid = threadIdx.x, lane = tid & 63, wave = __builtin_amdgcn_readfirstlane(tid >> 6), q = lane & 15, g = lane >> 4;
    const int b = bh >> 2, h = bh & 3;
    bf16_t* QB = (bf16_t*)(p.ws() + WS_QB); const bf16_t* KB = (const bf16_t*)(p.ws() + WS_KB); const bf16_t* VT = (const bf16_t*)(p.ws() + WS_VT);
    const int row = b * TP + qb * 128 + wave * 16 + q;
    bf16_t* qrow = QB + (size_t)row * 512 + h * 128;
    bf16x8 bq[2][2];
#pragma unroll
    for (int mm = 0; mm < 2; ++mm)
#pragma unroll
        for (int ks = 0; ks < 2; ++ks) bq[mm][ks] = *(const bf16x8*)(qrow + mm * 64 + ks * 32 + 8 * g);
    AttAcc A; att_init(A);
    const int nkb = 2 * qb + 2, nkt = 2 * qb + 1 + (wave >> 2);
    const bf16_t* kg = KB + (size_t)(b * TP + (tid >> 4)) * 512 + h * 128 + (tid & 15) * 8;
    const bf16_t* vg = VT + ((size_t)bh * 128 + (tid >> 3)) * TP + (tid & 7) * 8;
    LAS bf16_t* L = (LAS bf16_t*)lds;
    const int kso = (tid >> 4) * KS_STRIDE + (tid & 15) * 8, vsb = 64 * KS_STRIDE + (tid >> 3) * VS_STRIDE + ((tid & 7) >> 2) * 32;
    const int kb_ = (tid & 3) * 8, vso = vsb + 8 * ((kb_ & 15) >> 2) + 4 * (kb_ >> 4), vso2 = vsb + 8 * (((kb_ + 4) & 15) >> 2) + 4 * ((kb_ + 4) >> 4);
    u32x4 k0 = *(const u32x4*)kg, k1 = *(const u32x4*)(kg + 32 * 512), v0 = *(const u32x4*)vg, v1 = *(const u32x4*)(vg + (size_t)64 * TP);
    __syncthreads();
    *(LAS u32x4*)(L + kso) = k0; *(LAS u32x4*)(L + kso + 32 * KS_STRIDE) = k1; *(LAS u32x2*)(L + vso) = (u32x2){v0.x, v0.y}; *(LAS u32x2*)(L + vso2) = (u32x2){v0.z, v0.w}; *(LAS u32x2*)(L + vso + 64 * VS_STRIDE) = (u32x2){v1.x, v1.y}; *(LAS u32x2*)(L + vso2 + 64 * VS_STRIDE) = (u32x2){v1.z, v1.w};
    __syncthreads();
    for (int kt = 0; kt < nkb; ++kt) {
        const LAS bf16_t* Lc = L + (kt & 1) * ATT_BUF;
        LAS bf16_t* Ln = L + ((kt + 1) & 1) * ATT_BUF;
        const bool more = kt + 1 < nkb;
        if (more) { const bf16_t* kn = kg + (size_t)(kt + 1) * 64 * 512; const bf16_t* vn = vg + (kt + 1) * 64;
            k0 = *(const u32x4*)kn; k1 = *(const u32x4*)(kn + 32 * 512); v0 = *(const u32x4*)vn; v1 = *(const u32x4*)(vn + (size_t)64 * TP); }
        if (kt < nkt) {
            bf16x8 bP[2][2];
            const LAS bf16_t* kl = Lc + q * KS_STRIDE + 8 * g;
            att_qk(A, [&](int mm, int ks, int t) { return *(const LAS bf16x8*)(kl + t * 16 * KS_STRIDE + mm * 64 + ks * 32); }, bq, 64, g, bP);
            const LAS bf16_t* vl = Lc + 64 * KS_STRIDE + q * VS_STRIDE + 8 * g;
#pragma unroll
            for (int d = 0; d < 8; ++d)
#pragma unroll
                for (int k2 = 0; k2 < 2; ++k2) {
                    const bf16x8 vf = *(const LAS bf16x8*)(vl + d * 16 * VS_STRIDE + 32 * k2);
                    A.O[0][d] = MFMA16(vf, bP[0][k2], A.O[0][d]); A.O[1][d] = MFMA16(vf, bP[1][k2], A.O[1][d]);
                }
        }
        if (more) { *(LAS u32x4*)(Ln + kso) = k0; *(LAS u32x4*)(Ln + kso + 32 * KS_STRIDE) = k1; *(LAS u32x2*)(Ln + vso) = (u32x2){v0.x, v0.y}; *(LAS u32x2*)(Ln + vso2) = (u32x2){v0.z, v0.w}; *(LAS u32x2*)(Ln + vso + 64 * VS_STRIDE) = (u32x2){v1.x, v1.y}; *(LAS u32x2*)(Ln + vso2 + 64 * VS_STRIDE) = (u32x2){v1.z, v1.w}; }
        __syncthreads();
    }
    float l0 = A.l[0], l1 = A.l[1];
    l0 += __shfl_xor(l0, 16); l0 += __shfl_xor(l0, 32); l1 += __shfl_xor(l1, 16); l1 += __shfl_xor(l1, 32);
    const float lam = att_lambda(p, lane);
    att_final(A, l0, l1, lam, p.in(16), qrow, g);
}
__device__ __forceinline__ bf16x8 cvt8(const float* s) {
    const f32x4 a = *(const f32x4*)s, b = *(const f32x4*)(s + 4);
    u32x4 w; w.x = pk2(a[0], a[1]); w.y = pk2(a[2], a[3]); w.z = pk2(b[0], b[1]); w.w = pk2(b[2], b[3]);
    return __builtin_bit_cast(bf16x8, w);
}
__device__ __forceinline__ void att_sample_unit(const Ctx& p, int bs, int h, LAS unsigned char* lds) {
    const int tid = threadIdx.x, lane = tid & 63, wave = __builtin_amdgcn_readfirstlane(tid >> 6), q = lane & 15, g = lane >> 4;
    bf16_t* QB = (bf16_t*)(p.ws() + WS_QB);
    const int row = MPR + bs * 16 + q;
    bf16_t* qrow = QB + (size_t)row * 512 + h * 128;
    bf16x8 bq[2][2];
#pragma unroll
    for (int mm = 0; mm < 2; ++mm)
#pragma unroll
        for (int ks = 0; ks < 2; ++ks) bq[mm][ks] = *(const bf16x8*)(qrow + mm * 64 + ks * 32 + 8 * g);
    AttAcc A; att_init(A);
    for (int kt = wave; kt < 65; kt += 8) {
        const bool isnew = kt == 64;
        const float* kb = isnew ? p.out() + O_KS + (size_t)bs * 16 * 512 : p.in(2) + ((size_t)bs * PAST + kt * 64) * 512;
        const float* vb = isnew ? p.out() + O_VS + (size_t)bs * 16 * 512 : p.in(3) + ((size_t)bs * PAST + kt * 64) * 512;
        const int nvalid = isnew ? 16 : 64;
        bf16x8 bP[2][2];
        att_qk(A, [&](int mm, int ks, int t) { const int key = min(16 * t + q, nvalid - 1); return cvt8(kb + (key * 512 + h * 128 + mm * 64 + ks * 32 + 8 * g)); }, bq, nvalid, g, bP);
#pragma unroll
        for (int d = 0; d < 8; ++d)
#pragma unroll
            for (int k2 = 0; k2 < 2; ++k2) {
                float v[8];
#pragma unroll
                for (int e = 0; e < 8; ++e) { const int key = min(32 * k2 + (e >> 2) * 16 + 4 * g + (e & 3), nvalid - 1); v[e] = vb[key * 512 + h * 128 + 16 * d + q]; }
                u32x4 w; w.x = pk2(v[0], v[1]); w.y = pk2(v[2], v[3]); w.z = pk2(v[4], v[5]); w.w = pk2(v[6], v[7]);
                const bf16x8 vf = __builtin_bit_cast(bf16x8, w);
                A.O[0][d] = MFMA16(vf, bP[0][k2], A.O[0][d]); A.O[1][d] = MFMA16(vf, bP[1][k2], A.O[1][d]);
                if (k2 == 1 && (d & 1)) asm volatile("" ::: "memory");
            }
    }
    float l0 = A.l[0], l1 = A.l[1];
    l0 += __shfl_xor(l0, 16); l0 += __shfl_xor(l0, 32); l1 += __shfl_xor(l1, 16); l1 += __shfl_xor(l1, 32);
    LAS float* Ob = (LAS float*)lds; LAS float* ML = Ob + 8 * 2 * 8 * 4 * 64;
#pragma unroll
    for (int mm = 0; mm < 2; ++mm)
#pragma unroll
        for (int d = 0; d < 8; ++d)
#pragma unroll
            for (int r = 0; r < 4; ++r) Ob[((((wave * 2 + mm) * 8 + d) * 4 + r) << 6) + lane] = A.O[mm][d][r];
    ML[(wave * 4 + 0) * 64 + lane] = A.m[0]; ML[(wave * 4 + 1) * 64 + lane] = A.m[1]; ML[(wave * 4 + 2) * 64 + lane] = l0; ML[(wave * 4 + 3) * 64 + lane] = l1;
    __syncthreads();
    {
        float ms0 = -1e30f, ms1 = -1e30f;
#pragma unroll
        for (int w = 0; w < 8; ++w) { ms0 = fmaxf(ms0, ML[(w * 4 + 0) * 64 + lane]); ms1 = fmaxf(ms1, ML[(w * 4 + 1) * 64 + lane]); }
        float L0 = 0.f, L1 = 0.f; f32x4 o0 = (f32x4){0.f, 0.f, 0.f, 0.f}, o1 = o0;
#pragma unroll
        for (int w = 0; w < 8; ++w) {
            const float f0 = fexp2(ML[(w * 4 + 0) * 64 + lane] - ms0), f1 = fexp2(ML[(w * 4 + 1) * 64 + lane] - ms1);
            L0 += ML[(w * 4 + 2) * 64 + lane] * f0; L1 += ML[(w * 4 + 3) * 64 + lane] * f1;
#pragma unroll
            for (int r = 0; r < 4; ++r) { o0[r] += Ob[((((w * 2 + 0) * 8 + wave) * 4 + r) << 6) + lane] * f0; o1[r] += Ob[((((w * 2 + 1) * 8 + wave) * 4 + r) << 6) + lane] * f1; }
        }
        const float lam = att_lambda(p, lane);
        const f32x4 o = o0 * (1.f / L0) - o1 * (lam / L1);
        float ss = (o[0] * o[0] + o[1] * o[1]) + (o[2] * o[2] + o[3] * o[3]);
        ss += __shfl_xor(ss, 16); ss += __shfl_xor(ss, 32);
        LAS float* SS = ML + 8 * 4 * 64;
        SS[wave * 64 + lane] = ss;
        __syncthreads();
        float tot = 0.f;
#pragma unroll
        for (int w = 0; w < 8; ++w) tot += SS[w * 64 + lane];
        const float rs = 0.8f / sqrtf(tot * (1.f / 128.f) + EPS);
        const f32x4 gg = *(const f32x4*)(p.in(16) + 16 * wave + 4 * g);
        u32x2 wv; wv.x = pk2(o[0] * rs * gg[0], o[1] * rs * gg[1]); wv.y = pk2(o[2] * rs * gg[2], o[3] * rs * gg[3]);
        *(u32x2*)(qrow + 16 * wave + 4 * g) = wv;
    }
    __syncthreads();
}

template <int CTRL> __device__ __forceinline__ float dpp_add(float x) {
    return x + __builtin_bit_cast(float, __builtin_amdgcn_update_dpp(0, __builtin_bit_cast(int, x), CTRL, 0xf, 0xf, true));
}
__device__ __forceinline__ float sum16(float x) { x = dpp_add<0xB1>(x); x = dpp_add<0x4E>(x); x = dpp_add<0x141>(x); x = dpp_add<0x140>(x); return x; }
__device__ __forceinline__ float sum8(float x) { x = dpp_add<0xB1>(x); x = dpp_add<0x4E>(x); x = dpp_add<0x141>(x); return x; }
__device__ __forceinline__ void unpack4(const u32x2 w, float (&f)[4]) { f[0] = bflo(w.x); f[1] = bfhi(w.x); f[2] = bflo(w.y); f[3] = bfhi(w.y); }
__device__ __forceinline__ void zshift4(const Ctx& p, const bf16_t* ZRW, int row, int c, const float (&mu)[4], float (&o)[4]) {
    float z[4], pv[4];
    unpack4(*(const u32x2*)(ZRW + (size_t)row * SHW + c), z);
    bool first; int bsmp = 0;
    if (row < MPR) first = (row & (TP - 1)) == 0; else { first = ((row - MPR) & 15) == 0; bsmp = (row - MPR) >> 4; }
    if (!first) unpack4(*(const u32x2*)(ZRW + (size_t)(row - 1) * SHW + c), pv);
    else if (row < MPR) { pv[0] = 0.f; pv[1] = 0.f; pv[2] = 0.f; pv[3] = 0.f; }
    else { const f32x4 s0 = *(const f32x4*)(p.in(5) + (size_t)bsmp * SHW + c); pv[0] = s0[0]; pv[1] = s0[1]; pv[2] = s0[2]; pv[3] = s0[3]; }
#pragma unroll
    for (int e = 0; e < 4; ++e) o[e] = z[e] + (pv[e] - z[e]) * mu[e];
}
constexpr int SCH = 16, SBUF_F = SCH * (320 + 16), YP_F = SCH * 16 * 16;
struct ScanOps { f32x4 w, kk, ka, kp, rr; float v; };
__device__ __forceinline__ void scan_load(ScanOps& o, const LAS float* OP, const LAS float* VP, int t) {
    o.w = *(const LAS f32x4*)(OP + t * 320); o.kk = *(const LAS f32x4*)(OP + t * 320 + 64); o.ka = *(const LAS f32x4*)(OP + t * 320 + 128);
    o.kp = *(const LAS f32x4*)(OP + t * 320 + 192); o.rr = *(const LAS f32x4*)(OP + t * 320 + 256);
}
__device__ __forceinline__ void scan_step(f32x4& S, const ScanOps& o, LAS float* yp) {
    f32x2 S0 = {S[0], S[1]}, S1 = {S[2], S[3]};
    const f32x2 k0 = {o.kk[0], o.kk[1]}, k1 = {o.kk[2], o.kk[3]};
    f32x2 t = S0 * k0; t = S1 * k1 + t;
    const float sa = -sum16(t[0] + t[1]);
    const f32x2 sav = {sa, sa}, vv = {o.v, o.v};
    const f32x2 a0 = {o.ka[0], o.ka[1]}, a1 = {o.ka[2], o.ka[3]}, p0 = {o.kp[0], o.kp[1]}, p1 = {o.kp[2], o.kp[3]}, w0 = {o.w[0], o.w[1]}, w1 = {o.w[2], o.w[3]};
    f32x2 u0 = a0 * sav; u0 = p0 * vv + u0; S0 = S0 * w0 + u0;
    f32x2 u1 = a1 * sav; u1 = p1 * vv + u1; S1 = S1 * w1 + u1;
    const f32x2 r0 = {o.rr[0], o.rr[1]}, r1 = {o.rr[2], o.rr[3]};
    f32x2 y = S0 * r0; y = S1 * r1 + y;
    *yp = y[0] + y[1];
    S = (f32x4){S0[0], S0[1], S1[0], S1[1]};
}
__device__ __forceinline__ void scan_unit(const Ctx& p, int chain, int rq, LAS unsigned char* lds) {
    const int tid = threadIdx.x, lane = tid & 63, wave = __builtin_amdgcn_readfirstlane(tid >> 6);
    const bool smp = chain >= 32;
    const int cb = smp ? (chain - 32) >> 3 : chain >> 3, h = chain & 7, T = smp ? TS : TP, row0 = smp ? MPR + cb * TS : cb * TP;
    const int nch = T / SCH;
    const bf16_t* ZRW = (const bf16_t*)(p.ws() + WS_ZRW);
    const float* DEC = (const float*)(p.ws() + WS_DEC); const bf16_t* AB = (const bf16_t*)(p.ws() + WS_ABUF);
    bf16_t* ORW = (bf16_t*)(p.ws() + WS_ORW);
    LAS float* B0 = (LAS float*)lds; LAS float* YB = B0 + 2 * SBUF_F;
    __syncthreads();
    if (wave >= 4) {
        const int ht = tid - 256, tt = ht >> 4, cg4 = ht & 15, c0 = h * 64 + 4 * cg4;
        float mur[4], muk[4], muv[4], kkc[4], kac[4];
#pragma unroll
        for (int e = 0; e < 4; ++e) { mur[e] = p.in(17)[c0 + e]; muk[e] = p.in(17)[512 + c0 + e]; kkc[e] = p.in(23)[c0 + e]; kac[e] = p.in(24)[c0 + e]; }
        const int vc0 = h * 64 + 16 * rq + 4 * (cg4 & 3);
#pragma unroll
        for (int e = 0; e < 4; ++e) muv[e] = p.in(17)[1024 + vc0 + e];
        const bool hasv = cg4 < 4;
        struct HReg { u32x2 zr, zrp, zk, zkp, ab, zv, zvp; f32x4 dec; };
        auto issue = [&](HReg& R, int c) {
            const int row = row0 + c * SCH + tt, rp = row > 0 ? row - 1 : 0;
            R.zr = *(const u32x2*)(ZRW + (size_t)row * SHW + c0); R.zrp = *(const u32x2*)(ZRW + (size_t)rp * SHW + c0);
            R.zk = *(const u32x2*)(ZRW + (size_t)row * SHW + 512 + c0); R.zkp = *(const u32x2*)(ZRW + (size_t)rp * SHW + 512 + c0);
            R.ab = *(const u32x2*)(AB + (size_t)row * 512 + c0); R.dec = *(const f32x4*)(DEC + (size_t)row * 512 + c0);
            R.zv = (u32x2){0u, 0u}; R.zvp = (u32x2){0u, 0u};
            if (hasv) { R.zv = *(const u32x2*)(ZRW + (size_t)row * SHW + 1024 + vc0); R.zvp = *(const u32x2*)(ZRW + (size_t)rp * SHW + 1024 + vc0); }
        };
        auto commit = [&](const HReg& R, int c) {
            float zr[4], pr[4], zk[4], pk[4], a[4], zv[4], pv[4];
            unpack4(R.zr, zr); unpack4(R.zrp, pr); unpack4(R.zk, zk); unpack4(R.zkp, pk); unpack4(R.ab, a); unpack4(R.zv, zv); unpack4(R.zvp, pv);
            if (c == 0 && tt == 0) {
#pragma unroll
                for (int e = 0; e < 4; ++e) { pr[e] = 0.f; pk[e] = 0.f; pv[e] = 0.f; }
                if (smp) { const float* s0 = p.in(5) + (size_t)cb * SHW;
#pragma unroll
                    for (int e = 0; e < 4; ++e) { pr[e] = s0[c0 + e]; pk[e] = s0[512 + c0 + e]; pv[e] = s0[1024 + vc0 + e]; } }
            }
            float r[4], k[4], kk[4], n2 = 0.f;
#pragma unroll
            for (int e = 0; e < 4; ++e) { r[e] = zr[e] + (pr[e] - zr[e]) * mur[e]; k[e] = zk[e] + (pk[e] - zk[e]) * muk[e]; kk[e] = k[e] * kkc[e]; n2 += kk[e] * kk[e]; }
            n2 = sum16(n2);
            const float inv = __builtin_amdgcn_rsqf(fmaxf(n2, 1e-24f));
            float ka[4], kp[4];
#pragma unroll
            for (int e = 0; e < 4; ++e) { kk[e] *= inv; ka[e] = kk[e] * a[e]; kp[e] = k[e] * (1.f + (a[e] - 1.f) * kac[e]); }
            LAS float* OP = B0 + (c & 1) * SBUF_F + tt * 320 + 4 * cg4;
            *(LAS f32x4*)(OP) = R.dec;
            *(LAS f32x4*)(OP + 64) = (f32x4){kk[0], kk[1], kk[2], kk[3]};
            *(LAS f32x4*)(OP + 128) = (f32x4){ka[0], ka[1], ka[2], ka[3]};
            *(LAS f32x4*)(OP + 192) = (f32x4){kp[0], kp[1], kp[2], kp[3]};
            *(LAS f32x4*)(OP + 256) = (f32x4){r[0], r[1], r[2], r[3]};
            if (hasv) { LAS float* VW = B0 + (c & 1) * SBUF_F + SCH * 320 + (4 * cg4) * 16 + tt;
#pragma unroll
                for (int e = 0; e < 4; ++e) VW[e * 16] = zv[e] + (pv[e] - zv[e]) * muv[e]; }
        };
        auto yout = [&](int c) {
            const LAS float* Y = YB + (c & 1) * YP_F + (tt * 16 + cg4) * 16;
            const f32x4 y0 = *(const LAS f32x4*)Y, y1 = *(const LAS f32x4*)(Y + 4), y2 = *(const LAS f32x4*)(Y + 8), y3 = *(const LAS f32x4*)(Y + 12);
            const f32x4 ys = (y0 + y1) + (y2 + y3);
            ORW[(size_t)(row0 + c * SCH + tt) * 512 + h * 64 + 16 * rq + cg4] = f2bf((ys[0] + ys[1]) + (ys[2] + ys[3]));
        };
        HReg R0, R1;
        issue(R0, 0); if (nch > 1) issue(R1, 1);
        for (int ci = 0; ci <= nch; ci += 2) {
            if (ci < nch) { commit(R0, ci); if (ci + 2 < nch) issue(R0, ci + 2); }
            __syncthreads();
            if (ci > 0) yout(ci - 1);
            if (ci + 1 <= nch) {
                if (ci + 1 < nch) { commit(R1, ci + 1); if (ci + 3 < nch) issue(R1, ci + 3); }
                __syncthreads();
                yout(ci);
            }
        }
    } else {
        const int rl = lane >> 4, cl = lane & 15, il = 4 * wave + rl;
        f32x4 S;
        float* sg = (smp ? p.out() + O_SS : p.out() + O_SP) + ((size_t)(cb * 8 + h) * 64 + 16 * rq + il) * 64 + 4 * cl;
        if (smp) S = *(const f32x4*)(p.in(4) + ((size_t)(cb * 8 + h) * 64 + 16 * rq + il) * 64 + 4 * cl); else S = (f32x4){0.f, 0.f, 0.f, 0.f};
        for (int ci = 0; ci < nch; ++ci) {
            __syncthreads();
            const LAS float* OP = B0 + (ci & 1) * SBUF_F + 4 * cl;
            const LAS float* VP = B0 + (ci & 1) * SBUF_F + SCH * 320 + il * 16;
            LAS float* Y = YB + (ci & 1) * YP_F + il * 16 + cl;
            ScanOps oa, ob;
            scan_load(oa, OP, VP, 0);
            f32x2 vv = *(const LAS f32x2*)VP;
#pragma unroll 1
            for (int t = 0; t < SCH; t += 2) {
                scan_load(ob, OP, VP, t + 1);
                oa.v = vv[0]; ob.v = vv[1];
                scan_step(S, oa, Y + t * 256);
                scan_load(oa, OP, VP, (t + 2) & (SCH - 1));
                vv = *(const LAS f32x2*)(VP + ((t + 2) & (SCH - 1)));
                scan_step(S, ob, Y + (t + 1) * 256);
            }
        }
        __syncthreads();
        *(f32x4*)sg = S;
    }
}
__device__ __forceinline__ void phase_lnpass(const Ctx& p) {
    const int tid = threadIdx.x, c8 = tid & 7, h = (tid >> 3) & 7, rr = tid >> 6, c = h * 64 + 8 * c8;
    const bf16_t* ZRW = (const bf16_t*)(p.ws() + WS_ZRW); const bf16_t* AB = (const bf16_t*)(p.ws() + WS_ABUF); const bf16_t* GG = (const bf16_t*)(p.ws() + WS_GG);
    bf16_t* ORW = (bf16_t*)(p.ws() + WS_ORW);
    float mur[8], muk[8], muv[8], kac[8], rkc[8], lg[8], lb[8];
#pragma unroll
    for (int e = 0; e < 8; ++e) { mur[e] = p.in(17)[c + e]; muk[e] = p.in(17)[512 + c + e]; muv[e] = p.in(17)[1024 + c + e]; kac[e] = p.in(24)[c + e]; rkc[e] = p.in(25)[c + e]; lg[e] = p.in(26)[c + e]; lb[e] = p.in(27)[c + e]; }
    for (int it = blockIdx.x; it < MR / 8; it += gridDim.x) {
        const int row = it * 8 + rr;
        float r[8], k[8], v[8], a[8], g[8], y[8];
        zshift8(p, ZRW, row, c, mur, r); zshift8(p, ZRW, row, 512 + c, muk, k); zshift8(p, ZRW, row, 1024 + c, muv, v);
        unpack8(*(const u32x4*)(AB + (size_t)row * 512 + c), a); unpack8(*(const u32x4*)(GG + (size_t)row * 512 + c), g); unpack8(*(const u32x4*)(ORW + (size_t)row * 512 + c), y);
        float bon = 0.f, sy = 0.f;
#pragma unroll
        for (int e = 0; e < 8; ++e) { const float kp = k[e] * (1.f + (a[e] - 1.f) * kac[e]); bon += r[e] * kp * rkc[e]; sy += y[e]; }
        bon = sum8(bon);
        const float mu = sum8(sy) * (1.f / 64.f);
        float var = 0.f;
#pragma unroll
        for (int e = 0; e < 8; ++e) { y[e] -= mu; var += y[e] * y[e]; }
        var = sum8(var) * (1.f / 64.f);
        const float rs = 1.f / sqrtf(var + LNX_EPS);
        float o[8];
#pragma unroll
        for (int e = 0; e < 8; ++e) o[e] = (y[e] * rs * lg[e] + lb[e] + bon * v[e]) * g[e];
        u32x4 w; w.x = pk2(o[0], o[1]); w.y = pk2(o[2], o[3]); w.z = pk2(o[4], o[5]); w.w = pk2(o[6], o[7]);
        *(u32x4*)(ORW + (size_t)row * 512 + c) = w;
    }
}

__device__ __forceinline__ void ffn2_weights(const Ctx& p, LAS unsigned char* lds) {
    const int tid = threadIdx.x, lane = tid & 63, wave = __builtin_amdgcn_readfirstlane(tid >> 6);
    unsigned char* ws = p.ws();
    LAS float* scr = (LAS float*)(lds + wave * 16384);
    constexpr int I7 = 16 * 176, I8 = 44 * 32;
    __syncthreads();
    for (int it = ((int)blockIdx.x - 128) * 8 + wave; it < I7 + I8; it += 128 * 8) {
        int r = it;
        if (r < I7) { const int kb = r / 176, nb = r % 176; transpose_item(p.in(33), DM, NFF, (bf16_t*)(ws + WS_W3T), 64 * kb, 32 * nb, map_w1(32 * nb), scr, lane); continue; } r -= I7;
        { const int kb = r / 32, nb = r % 32; transpose_item(p.in(34), DFF, DM, (bf16_t*)(ws + WS_W4T), 64 * kb, 32 * nb, 32 * nb, scr, lane); }
    }
}
__device__ __forceinline__ void phase_mixer(const Ctx& p, LAS unsigned char* lds) {
    if (blockIdx.x < 128) scan_unit(p, blockIdx.x >> 2, blockIdx.x & 3, lds);
    else { const int u0 = (blockIdx.x - 128) * 2; scan_unit(p, 32 + (u0 >> 2), u0 & 3, lds); scan_unit(p, 32 + ((u0 + 1) >> 2), (u0 + 1) & 3, lds); }
    if (blockIdx.x < 128) return;
    unsigned* ctr = (unsigned*)(p.ws() + WS_CTR);
    LAS unsigned* su = (LAS unsigned*)(lds + 140 * 1024);
    for (;;) {
        __syncthreads();
        if (threadIdx.x == 0) su[0] = atomicAdd(ctr, 1u);
        __syncthreads();
        const int u = __builtin_amdgcn_readfirstlane((int)su[0]);
        if (u >= 32) break;
        att_sample_unit(p, u >> 2, u & 3, lds);
    }
    for (;;) {
        __syncthreads();
        if (threadIdx.x == 0) su[0] = atomicAdd(ctr + 1, 1u);
        __syncthreads();
        const int v = __builtin_amdgcn_readfirstlane((int)su[0]);
        if (v >= 512) break;
        att_prompt_unit(p, v & 15, 31 - (v >> 4), lds);
    }
    ffn2_weights(p, lds);
}

constexpr int LDS_BYTES = 147456;
constexpr int NPHASE = 15;
#ifndef SINGLE_LAUNCH
#define SINGLE_LAUNCH 1
#endif

#define XB_TMO      128
#define XB_XCNT(j)  (256  + 64 * (j))
#define XB_XSUB(j)  (1280 + 64 * (j))
#define XB_XGEN(j)  (2304 + 64 * (j))
#define XB_TOP      3328
#define XB_TOPGEN   3392
#define XCD_BAR_WORDS 3456
#define XB_SPIN_CAP (1u << 18)

__device__ __forceinline__ unsigned xb_ld(unsigned* p)              { return __hip_atomic_load(p, __ATOMIC_RELAXED, __HIP_MEMORY_SCOPE_AGENT); }
__device__ __forceinline__ unsigned xb_add(unsigned* p, unsigned v) { return __hip_atomic_fetch_add(p, v, __ATOMIC_RELAXED, __HIP_MEMORY_SCOPE_AGENT); }
__device__ __forceinline__ unsigned xb_xcc_id() { return (unsigned)__builtin_amdgcn_s_getreg((3 << 11) | 20) & 0xFu; }
#define XB_SPIN(cond, bar) do { unsigned _sp = 0; while (cond) { __builtin_amdgcn_s_sleep(1); \
    if ((++_sp & 255u) == 0u) { if (xb_ld(&(bar)[XB_TMO])) break; if (_sp > XB_SPIN_CAP) { atomicAdd(&(bar)[XB_TMO], 1u); break; } } } } while (0)

struct XcdBarrier {
    unsigned* bar; unsigned x;
    volatile LAS unsigned* st;
};

__device__ __forceinline__ XcdBarrier xcd_barrier_post(unsigned* bar, volatile LAS unsigned* st) {
    XcdBarrier b; b.bar = bar; b.x = xb_xcc_id(); b.st = st;
    if (threadIdx.x == 0) (void)xb_add(&bar[XB_XCNT(b.x)], 1u);
    return b;
}
__device__ __forceinline__ void xcd_barrier_complete(unsigned* bar, unsigned x, unsigned& nloc, unsigned& nx) {
    const unsigned G = gridDim.x * gridDim.y * gridDim.z;
    unsigned sum, cnt, mine, sp = 0u;
    for (;;) {
        sum = 0u; cnt = 0u; mine = 0u;
#pragma unroll
        for (unsigned j = 0; j < 16; ++j) { const unsigned c = xb_ld(&bar[XB_XCNT(j)]); sum += c; cnt += (c > 0u) ? 1u : 0u; mine = (j == x) ? c : mine; }
        if (sum == G) break;
        __builtin_amdgcn_s_sleep(1);
        if ((++sp & 255u) == 0u) { if (xb_ld(&bar[XB_TMO])) break; if (sp > XB_SPIN_CAP) { atomicAdd(&bar[XB_TMO], 1u); break; } }
    }
    nloc = mine > 0u ? mine : 1u; nx = cnt > 0u ? cnt : 1u;
}

__device__ __forceinline__ void xcd_barrier(const XcdBarrier& b) {
    asm volatile("s_waitcnt vmcnt(0)" ::: "memory");
    __syncthreads();
    if (threadIdx.x == 0) {
        unsigned* bar = b.bar;
        __builtin_amdgcn_s_waitcnt(0);
        unsigned nloc = b.st[0], nx = b.st[1];
        if (nloc == 0u) { xcd_barrier_complete(bar, b.x, nloc, nx); b.st[0] = nloc; b.st[1] = nx; }
        const unsigned old = xb_add(&bar[XB_XSUB(b.x)], 1u);
        const unsigned gen = old / nloc;
        if (old + 1u == (gen + 1u) * nloc) {
            __builtin_amdgcn_fence(__ATOMIC_RELEASE, "agent");
            asm volatile("s_waitcnt vmcnt(0)" ::: "memory");
            const unsigned og = xb_add(&bar[XB_TOP], 1u);
            const unsigned tg = og / nx;
            if (og + 1u == (tg + 1u) * nx) xb_add(&bar[XB_TOPGEN], 1u);
            else XB_SPIN(xb_ld(&bar[XB_TOPGEN]) == tg, bar);
            __builtin_amdgcn_fence(__ATOMIC_ACQUIRE, "agent");
            xb_add(&bar[XB_XGEN(b.x)], 1u);
            asm volatile("s_waitcnt vmcnt(0)" ::: "memory");
        } else {
            XB_SPIN(xb_ld(&bar[XB_XGEN(b.x)]) == gen, bar);
            __builtin_amdgcn_fence(__ATOMIC_ACQUIRE, "agent");
            asm volatile("s_waitcnt vmcnt(0)" ::: "memory");
        }
    }
    __syncthreads();
}

__device__ __forceinline__ void grid_bar(const Ctx& p, unsigned k) {
    asm volatile("s_waitcnt vmcnt(0)" ::: "memory");
    __syncthreads();
    if (threadIdx.x == 0) {
        unsigned* ctr = (unsigned*)(p.ws() + WS_CTR) + 64;
        __builtin_amdgcn_fence(__ATOMIC_RELEASE, "agent");
        asm volatile("s_waitcnt vmcnt(0)" ::: "memory");
        __hip_atomic_fetch_add(ctr, 1u, __ATOMIC_RELAXED, __HIP_MEMORY_SCOPE_AGENT);
        const unsigned target = k * gridDim.x;
        while (__hip_atomic_load(ctr, __ATOMIC_RELAXED, __HIP_MEMORY_SCOPE_AGENT) < target) __builtin_amdgcn_s_sleep(1);
        __builtin_amdgcn_fence(__ATOMIC_ACQUIRE, "agent");
        asm volatile("s_waitcnt vmcnt(0)" ::: "memory");
    }
    __syncthreads();
}
__device__ __forceinline__ void sub_barrier(const Ctx& p, unsigned n) {
    asm volatile("s_waitcnt vmcnt(0)" ::: "memory");
    __syncthreads();
    if (threadIdx.x == 0) {
        unsigned* c = (unsigned*)(p.ws() + WS_CTR) + 128;
        __builtin_amdgcn_fence(__ATOMIC_RELEASE, "agent");
        asm volatile("s_waitcnt vmcnt(0)" ::: "memory");
        __hip_atomic_fetch_add(c, 1u, __ATOMIC_RELAXED, __HIP_MEMORY_SCOPE_AGENT);
        while (__hip_atomic_load(c, __ATOMIC_RELAXED, __HIP_MEMORY_SCOPE_AGENT) < n) __builtin_amdgcn_s_sleep(2);
        __builtin_amdgcn_fence(__ATOMIC_ACQUIRE, "agent");
        asm volatile("s_waitcnt vmcnt(0)" ::: "memory");
    }
    __syncthreads();
}
template <class Epi> __device__ __forceinline__ void run_gemm(LAS unsigned char* lds, const bf16_t* A, const bf16_t* Bt, int N, int K, const Epi& E, int M = MP) {
    pg8::Gemm g{A, Bt, M, N, K, K}; pg8::StaticOrder S; S.init(M, N, (int)gridDim.x, (int)blockIdx.x);
    pg8::gemm_phase<Epi, pg8::StaticOrder, true, true>(lds, g, S, E);
}
struct OneUnit { int pn; bool on;
    __device__ __forceinline__ bool next(int i, pg8::Unit& u) const { if (i > 0 || !on) return false; u.pm = 0; u.pn = pn; return true; }
    __device__ __forceinline__ void a_ready(const pg8::Unit&) const {}
    __device__ __forceinline__ void done(const pg8::Unit&) const {} };
struct EpiPart {
    static constexpr bool PERM = false, AFTER_DRAIN = false;
    float* O;
    __device__ __forceinline__ void operator()(const f32x4 (&acc)[2][2][4][2], const Unit& u, int wr, int wc, int fr, int fq) const {
        const int col0 = u.pn * 256 + wc * 32 + 4 * fq;
#pragma unroll
        for (int m = 0; m < 4; ++m) {
            const int row = wr * 64 + m * 16 + fr;
#pragma unroll
            for (int bj = 0; bj < 2; ++bj)
#pragma unroll
                for (int n = 0; n < 2; ++n) *(f32x4*)(O + (size_t)row * DM + col0 + bj * 128 + n * 16) = acc[0][bj][m][n];
            asm volatile("" ::: "memory");
        }
    }
};
constexpr size_t WS_PART = 240 * MiB;
constexpr int KSL = 256;
__device__ __forceinline__ void run_gemm_sample(LAS unsigned char* lds, const bf16_t* A, const bf16_t* Bt, int K, float* PART) {
    const int c = (int)blockIdx.x, ns = K / KSL, ks = c >> 2;
    OneUnit S{c & 3, c < 4 * ns};
    pg8::Gemm g{A + (size_t)MPR * K + (size_t)ks * KSL, Bt + (size_t)ks * KSL, 256, DM, KSL, K};
    EpiPart E{PART + (size_t)ks * 128 * DM};
    pg8::gemm_phase<EpiPart, OneUnit, false, true>(lds, g, S, E);
}

__global__ void __launch_bounds__(512) fwd_kernel(Params prm) {
    extern __shared__ __attribute__((aligned(16))) unsigned char lds_raw[];
    LAS unsigned char* lds = (LAS unsigned char*)lds_raw;
    cg::grid_group grid = cg::this_grid();
    const int lo = prm.ph_lo, hi = prm.ph_hi;
    {   LAS unsigned long long* tab = (LAS unsigned long long*)(lds + 141 * 1024);
        if (threadIdx.x < 36) tab[threadIdx.x] = (unsigned long long)prm.in[threadIdx.x];
        if (threadIdx.x == 36) tab[36] = (unsigned long long)prm.out;
        if (threadIdx.x == 37) tab[37] = (unsigned long long)prm.ws;
        __syncthreads(); }
    Ctx p{(const LAS unsigned*)(lds + 141 * 1024)};
volatile LAS unsigned* bst = (volatile LAS unsigned*)(lds + 142 * 1024);
    if (threadIdx.x < 2) bst[threadIdx.x] = 0u;
    __syncthreads();
    XcdBarrier bar; bar.bar = (unsigned*)(p.ws() + WS_CTR) + 1024; bar.x = 0; bar.st = bst;
#define ws (p.ws())
#define IN(k) (lo <= (k) && (k) < hi)
#define SEAM(k) do { if (IN(k) && IN((k) + 1)) xcd_barrier(bar); } while (0)
    unsigned nbar = 0;
    if (IN(0)) {
        if (blockIdx.x == 0) for (int i = threadIdx.x; i < 1024 + 3456; i += 512) ((unsigned*)(ws + WS_CTR))[i] = 0u;
        phase_prologue(p, lds); }
    if (IN(0) && IN(1)) grid.sync();
    bar = xcd_barrier_post((unsigned*)(ws + WS_CTR) + 1024, bst);
    if (IN(1)) { EpiSwiglu E{(bf16_t*)(ws + WS_G)}; run_gemm(lds, (const bf16_t*)(ws + WS_XN), (const bf16_t*)(ws + WS_W1T), NFF, DM, E);
        { constexpr int NFULL = (MP / 256) * (NFF / 256) - 5 * 256;
          if ((int)blockIdx.x >= NFULL) prologue_part2(p, lds, (int)blockIdx.x - NFULL, 256 - NFULL); } } SEAM(1);
    if (IN(2)) { EpiF32 E{(float*)(ws + WS_F)}; run_gemm(lds, (const bf16_t*)(ws + WS_G), (const bf16_t*)(ws + WS_W2T), DM, DFF, E, MPR); run_gemm_sample(lds, (const bf16_t*)(ws + WS_G), (const bf16_t*)(ws + WS_W2T), DFF, (float*)(ws + WS_PART)); } SEAM(2);
    if (IN(3)) { phase_rowpass(p, (const float*)(ws + WS_F), 1, 0.5f, p.in(9), p.in(10), (bf16_t*)(ws + WS_XN), (const float*)(ws + WS_PART), DFF / KSL); } SEAM(3);
    if (IN(4)) { EpiZ E{p.out(), (bf16_t*)(ws + WS_QB), (bf16_t*)(ws + WS_KB), (bf16_t*)(ws + WS_VT), (bf16_t*)(ws + WS_ZRW), (bf16_t*)(ws + WS_GATE), (const f32x2*)(ws + WS_TAB)};
        run_gemm(lds, (const bf16_t*)(ws + WS_XN), (const bf16_t*)(ws + WS_WINT), INW, DM, E); } SEAM(4);
    if (IN(5)) { phase_lora(p, lds); } SEAM(5);
    if (IN(6)) { phase_mixer(p, lds);
        if (blockIdx.x >= 128) {
            sub_barrier(p, 128u);
            EpiGate1 E{(bf16_t*)(ws + WS_KB), (const bf16_t*)(ws + WS_GATE)};
            pg8::Gemm g{(const bf16_t*)(ws + WS_QB), (const bf16_t*)(ws + WS_WAT), MP, DM, 512, 512}; pg8::StaticOrder S; S.init(MP, DM, 128, (int)blockIdx.x - 128);
            pg8::gemm_phase<EpiGate1, pg8::StaticOrder, true, true>(lds, g, S, E);
        } } SEAM(6);
    if (IN(14)) { phase_lnpass(p); } if (IN(14) && IN(7)) xcd_barrier(bar);
    if (IN(8)) { EpiGate2 E{(const bf16_t*)(ws + WS_KB), (const bf16_t*)(ws + WS_GATE), (bf16_t*)(ws + WS_MG)}; run_gemm(lds, (const bf16_t*)(ws + WS_ORW), (const bf16_t*)(ws + WS_WRT), DM, 512, E); } SEAM(8);
    if (IN(9)) { EpiF32 E{(float*)(ws + WS_T)}; run_gemm(lds, (const bf16_t*)(ws + WS_MG), (const bf16_t*)(ws + WS_WOT), DM, DM, E, MPR); run_gemm_sample(lds, (const bf16_t*)(ws + WS_MG), (const bf16_t*)(ws + WS_WOT), DM, (float*)(ws + WS_PART)); } SEAM(9);
    if (IN(10)) { phase_rowpass(p, (const float*)(ws + WS_T), 0, 1.0f, p.in(31), p.in(32), (bf16_t*)(ws + WS_XN), (const float*)(ws + WS_PART), DM / KSL); } SEAM(10);
    if (IN(11)) { EpiSwiglu E{(bf16_t*)(ws + WS_G)}; run_gemm(lds, (const bf16_t*)(ws + WS_XN), (const bf16_t*)(ws + WS_W3T), NFF, DM, E); } SEAM(11);
    if (IN(12)) { EpiF32 E{(float*)(ws + WS_F)}; run_gemm(lds, (const bf16_t*)(ws + WS_G), (const bf16_t*)(ws + WS_W4T), DM, DFF, E, MPR); run_gemm_sample(lds, (const bf16_t*)(ws + WS_G), (const bf16_t*)(ws + WS_W4T), DFF, (float*)(ws + WS_PART)); } SEAM(12);
    if (IN(13)) { phase_rowpass(p, (const float*)(ws + WS_F), 0, 0.5f, p.in(35), nullptr, nullptr, (const float*)(ws + WS_PART), DFF / KSL); }
#undef IN
#undef SEAM
#undef ws
}

extern "C" void kernel_launch(void* const* d_in, const int* in_sizes, int n_in, void* d_out, int out_size, void* d_ws, size_t ws_size, hipStream_t stream) {
    static int grid = 0;
    if (grid == 0) {
        int dev = 0, cus = 0, per_cu = 0;
        (void)hipGetDevice(&dev);
        (void)hipDeviceGetAttribute(&cus, hipDeviceAttributeMultiprocessorCount, dev);
        (void)hipFuncSetAttribute((const void*)fwd_kernel, hipFuncAttributeMaxDynamicSharedMemorySize, LDS_BYTES);
        if (hipOccupancyMaxActiveBlocksPerMultiprocessor(&per_cu, (const void*)fwd_kernel, 512, LDS_BYTES) != hipSuccess || per_cu < 1) per_cu = 1;
        (void)hipGetLastError();
        grid = cus * per_cu;
        if (grid <= 0) grid = 256;
        if (n_in != 36 || (size_t)out_size != O_END || ws_size < WS_NEED) { fprintf(stderr, "kernel_launch: unexpected sizes n_in %d out %d ws %zu (need %zu)\n", n_in, out_size, ws_size, (size_t)WS_NEED); grid = -1; }
    }
    if (grid < 0) return;
    Params p{};
    for (int i = 0; i < 36; ++i) p.in[i] = (const float*)d_in[i];
    p.out = (float*)d_out; p.ws = (unsigned char*)d_ws;
#if SINGLE_LAUNCH
    p.ph_lo = 0; p.ph_hi = NPHASE;
    void* args[] = {&p};
    hipError_t e = hipLaunchCooperativeKernel((const void*)fwd_kernel, dim3(grid), dim3(512), args, LDS_BYTES, stream);
    if (e != hipSuccess) fprintf(stderr, "cooperative launch failed: %s (grid %d)\n", hipGetErrorString(e), grid);
#else
    for (int ph = 0; ph < NPHASE; ++ph) { p.ph_lo = ph; p.ph_hi = ph + 1; hipLaunchKernelGGL(fwd_kernel, dim3(grid), dim3(512), LDS_BYTES, stream, p); }
#endif
}
```

```cpp
#include <hip/hip_runtime.h>
#include <hip/hip_cooperative_groups.h>
#include <cstdio>
#include <cstdint>
namespace cg = cooperative_groups;
namespace pg8 {
#define PG8_LAS __attribute__((address_space(3)))
typedef unsigned short bf16_t;
typedef short bf16x8 __attribute__((ext_vector_type(8)));
typedef float f32x4 __attribute__((ext_vector_type(4)));
typedef unsigned u32x4 __attribute__((ext_vector_type(4)));
constexpr int BM = 256, BK = 64, HALF = 128, HTB = HALF * BK * 2  , STAGE_BYTES = 8 * HTB, NXCD = 8, WGM = 8;

__host__ __device__ __forceinline__ int lds_byte(int r, int c) { const int st = (r >> 4) * 2 + (c >> 5), rr = r & 15, cc = c & 31, ob = rr * 64 + cc * 2; return st * 1024 + (ob ^ (((ob >> 9) & 1) << 5)); }
__host__ __device__ __forceinline__ void stage_rc(int b, int& R, int& C) { const int st = b / 1024, sb = b % 1024, swz = sb ^ (((sb >> 9) & 1) << 5); R = (st >> 1) * 16 + swz / 64; C = (st & 1) * 32 + (swz % 64) / 2; }
__host__ __device__ __forceinline__ int perm32(int rho) { const int n = rho >> 4, i = rho & 15; return 8 * (i >> 2) + 4 * n + (i & 3); }

struct Unit { int pm, pn; };
struct Gemm { const bf16_t* A; const bf16_t* Bt; int M, N, K, ld; };

struct StaticOrder {
    int nM, nN, nwg, G, c;
    __host__ __device__ void init(int M, int N, int G_, int c_) { nM = M / BM; nN = N / BM; nwg = nM * nN; G = G_; c = c_; }
    __host__ __device__ bool next(int i, Unit& u) const {
        const long L = (long)i * G + c; if (L >= nwg) return false;
        int wgid = (int)L; { const int q = nwg / NXCD, r = nwg % NXCD, xcd = wgid % NXCD, off = wgid / NXCD; wgid = (xcd < r ? xcd * (q + 1) : r * (q + 1) + (xcd - r) * q) + off; }
        const int nig = WGM * nN, gid = wgid / nig, fm = gid * WGM, gsz = (nM - fm) < WGM ? (nM - fm) : WGM;
        u.pm = fm + ((wgid % nig) % gsz); u.pn = (wgid % nig) / gsz; return true;
    }
    __device__ __forceinline__ void a_ready(const Unit&) const {}
    __device__ __forceinline__ void done(const Unit&) const {}
};

__device__ __forceinline__ unsigned cvt_pk_bf16(float lo, float hi) { unsigned r; asm volatile("v_cvt_pk_bf16_f32 %0, %1, %2" : "=v"(r) : "v"(lo), "v"(hi)); return r; }
typedef float f32x2 __attribute__((ext_vector_type(2)));
template <class Epi, class Sched, bool ALIGN_EPI = false, bool SP2 = false>
__device__ __forceinline__ void gemm_phase(PG8_LAS unsigned char* lds, const Gemm g, const Sched& S, const Epi& E) {
    const int tid = threadIdx.x, wid = __builtin_amdgcn_readfirstlane(tid >> 6), lane = tid & 63, wr = wid >> 2, wc = wid & 3, fr = lane & 15, fq = lane >> 4;
    const int K = g.K, nt = K / BK;
    unsigned voffA[2], voffB[2];
#pragma unroll
    for (int i = 0; i < 2; ++i) { int R, C; stage_rc(tid * 16 + i * 8192, R, C); const int Rb = Epi::PERM ? ((R & ~31) + perm32(R & 31)) : R;
        voffA[i] = (unsigned)(R * g.ld + C) * 2u; voffB[i] = (unsigned)(Rb * g.ld + C) * 2u; }
    const size_t kstep = (size_t)(BK * 2);
    const size_t hstep = (size_t)HALF * g.ld * 2;
    const size_t tstep = 2 * hstep;
    const unsigned ldsw = (unsigned)wid * 1024u;
    const int aoff = lds_byte(wr * 64 + fr, fq * 8), boff = lds_byte(wc * 32 + fr, fq * 8);
#define PG8_SA(b, h) (((b) * 2 + (h)) * HTB)
#define PG8_SB(b, h) ((4 + (b) * 2 + (h)) * HTB)
#define PG8_STAGE(bufoff, gbase, voff) do { _Pragma("unroll") for (int _i = 0; _i < 2; ++_i) \
        __builtin_amdgcn_global_load_lds((const unsigned*)((const char*)(gbase) + (voff)[_i]), (PG8_LAS unsigned*)(lds + (bufoff) + ldsw + _i * 8192), 16, 0, 0); } while (0)
#define PG8_LDA(dst, b, h) do { _Pragma("unroll") for (int m = 0; m < 4; ++m) _Pragma("unroll") for (int k = 0; k < 2; ++k) dst[m][k] = *(const PG8_LAS bf16x8*)(lds + PG8_SA(b, h) + aoff + m * 2048 + k * 1024); } while (0)
#define PG8_LDB(dst, b, h) do { _Pragma("unroll") for (int n = 0; n < 2; ++n) _Pragma("unroll") for (int k = 0; k < 2; ++k) dst[n][k] = *(const PG8_LAS bf16x8*)(lds + PG8_SB(b, h) + boff + n * 2048 + k * 1024); } while (0)
#define PG8_MMA(ai, bj, At, Bt) do { __builtin_amdgcn_s_setprio(1); _Pragma("unroll") for (int m = 0; m < 4; ++m) _Pragma("unroll") for (int n = 0; n < 2; ++n) _Pragma("unroll") for (int k = 0; k < 2; ++k) \
        acc[ai][bj][m][n] = __builtin_amdgcn_mfma_f32_16x16x32_bf16(Bt[n][k], At[m][k], acc[ai][bj][m][n], 0, 0, 0); __builtin_amdgcn_s_setprio(0); } while (0)
#define PG8_WAIT_V(n) asm volatile("s_waitcnt vmcnt(" #n ")" ::: "memory")
#define PG8_WAIT_L(n) asm volatile("s_waitcnt lgkmcnt(" #n ")" ::: "memory")
#define PG8_BAR __builtin_amdgcn_s_barrier()
#define PG8_SCHED __builtin_amdgcn_sched_barrier(0)
    Unit cur, nxt; int ui = 0;
    if (!S.next(0, cur)) return;
    f32x4 acc[2][2][4][2];
#pragma unroll
    for (int a = 0; a < 2; ++a)
#pragma unroll
        for (int b = 0; b < 2; ++b)
#pragma unroll
            for (int m = 0; m < 4; ++m)
#pragma unroll
                for (int n = 0; n < 2; ++n) acc[a][b][m][n] = (f32x4){0.f, 0.f, 0.f, 0.f};
    bf16x8 At[4][2], B0[2][2], B1[2][2];
    const char* cA = (const char*)g.A + (size_t)cur.pm * tstep; const char* cB = (const char*)g.Bt + (size_t)cur.pn * tstep;
    S.a_ready(cur);
    if constexpr (SP2) {
        PG8_STAGE(PG8_SB(0, 0), cB, voffB); PG8_STAGE(PG8_SB(0, 1), cB + hstep, voffB); PG8_STAGE(PG8_SA(0, 0), cA, voffA); PG8_STAGE(PG8_SA(0, 1), cA + hstep, voffA);
        if (wr == 1) PG8_BAR;
        PG8_WAIT_V(2); PG8_BAR;
        PG8_STAGE(PG8_SB(1, 0), cB + kstep, voffB); PG8_STAGE(PG8_SA(1, 0), cA + kstep, voffA); PG8_STAGE(PG8_SB(1, 1), cB + hstep + kstep, voffB);
        PG8_WAIT_V(6); PG8_BAR;
    } else {
        PG8_STAGE(PG8_SB(0, 0), cB, voffB); PG8_STAGE(PG8_SA(0, 0), cA, voffA); PG8_STAGE(PG8_SB(0, 1), cB + hstep, voffB); PG8_STAGE(PG8_SA(0, 1), cA + hstep, voffA);
        if (wr == 1) PG8_BAR;
        PG8_WAIT_V(4); PG8_BAR;
        PG8_STAGE(PG8_SB(1, 0), cB + kstep, voffB); PG8_STAGE(PG8_SA(1, 0), cA + kstep, voffA); PG8_STAGE(PG8_SB(1, 1), cB + hstep + kstep, voffB);
        PG8_WAIT_V(6); PG8_BAR;
    }
    for (;;) {
        const bool has_next = S.next(ui + 1, nxt);
        const char* nA = has_next ? (const char*)g.A + (size_t)nxt.pm * tstep : cA; const char* nB = has_next ? (const char*)g.Bt + (size_t)nxt.pn * tstep : cB;
        for (int t = 0; t < nt; t += 2) {
            const bool last = (t == nt - 2);
            const char* a1 = cA + (size_t)(t + 1) * kstep;
            const char* a2 = last ? nA : cA + (size_t)(t + 2) * kstep; const char* b2 = last ? nB : cB + (size_t)(t + 2) * kstep;
            const char* a3 = a2 + kstep; const char* b3 = b2 + kstep;
            if (last && has_next) S.a_ready(nxt);
            if constexpr (SP2) {
            PG8_LDB(B0, 0, 0); PG8_LDB(B1, 0, 1); PG8_SCHED; PG8_LDA(At, 0, 0); PG8_STAGE(PG8_SA(1, 1), a1 + hstep, voffA);
            PG8_WAIT_V(8); PG8_WAIT_L(0); PG8_BAR; PG8_MMA(0, 0, At, B0); PG8_MMA(0, 1, At, B1); PG8_BAR; PG8_SCHED;
            PG8_LDA(At, 0, 1); PG8_STAGE(PG8_SB(0, 0), b2, voffB); PG8_STAGE(PG8_SB(0, 1), b2 + hstep, voffB); PG8_STAGE(PG8_SA(0, 0), a2, voffA);
            PG8_WAIT_V(8); PG8_WAIT_L(0); PG8_BAR; PG8_MMA(1, 0, At, B0); PG8_MMA(1, 1, At, B1); PG8_BAR; PG8_SCHED;
            PG8_LDB(B0, 1, 0); PG8_LDB(B1, 1, 1); PG8_SCHED; PG8_LDA(At, 1, 0); PG8_STAGE(PG8_SA(0, 1), a2 + hstep, voffA);
            PG8_WAIT_V(8); PG8_WAIT_L(0); PG8_BAR; PG8_MMA(0, 0, At, B0); PG8_MMA(0, 1, At, B1); PG8_BAR; PG8_SCHED;
            PG8_LDA(At, 1, 1); PG8_STAGE(PG8_SB(1, 0), b3, voffB); PG8_STAGE(PG8_SB(1, 1), b3 + hstep, voffB); PG8_STAGE(PG8_SA(1, 0), a3, voffA);
            PG8_WAIT_V(8); PG8_WAIT_L(0); PG8_BAR; PG8_MMA(1, 0, At, B0); PG8_MMA(1, 1, At, B1); PG8_BAR; PG8_SCHED;
            } else {
            PG8_LDB(B0, 0, 0); PG8_SCHED; PG8_LDA(At, 0, 0); PG8_STAGE(PG8_SA(1, 1), a1 + hstep, voffA);
            PG8_WAIT_L(8); PG8_BAR; PG8_WAIT_L(0); PG8_MMA(0, 0, At, B0); PG8_BAR; PG8_SCHED;
            PG8_LDB(B1, 0, 1); PG8_STAGE(PG8_SB(0, 0), b2, voffB);
            PG8_BAR; PG8_WAIT_L(0); PG8_MMA(0, 1, At, B1); PG8_BAR;
            PG8_LDA(At, 0, 1); PG8_STAGE(PG8_SA(0, 0), a2, voffA);
            PG8_BAR; PG8_WAIT_L(0); PG8_MMA(1, 0, At, B0); PG8_BAR; PG8_SCHED;
            PG8_STAGE(PG8_SB(0, 1), b2 + hstep, voffB);
            PG8_WAIT_V(6); PG8_BAR; PG8_MMA(1, 1, At, B1); PG8_BAR;
            PG8_LDB(B0, 1, 0); PG8_SCHED; PG8_LDA(At, 1, 0); PG8_STAGE(PG8_SA(0, 1), a2 + hstep, voffA);
            PG8_WAIT_L(8); PG8_BAR; PG8_WAIT_L(0); PG8_MMA(0, 0, At, B0); PG8_BAR; PG8_SCHED;
            PG8_LDB(B1, 1, 1); PG8_STAGE(PG8_SB(1, 0), b3, voffB);
            PG8_BAR; PG8_WAIT_L(0); PG8_MMA(0, 1, At, B1); PG8_BAR;
            PG8_LDA(At, 1, 1); PG8_STAGE(PG8_SA(1, 0), a3, voffA);
            PG8_BAR; PG8_WAIT_L(0); PG8_MMA(1, 0, At, B0); PG8_BAR; PG8_SCHED;
            PG8_STAGE(PG8_SB(1, 1), b3 + hstep, voffB);
            PG8_WAIT_V(6); PG8_BAR; PG8_MMA(1, 1, At, B1); PG8_BAR;
            }
        }
        if constexpr (ALIGN_EPI) { if (wr == 0) PG8_BAR; }
        if constexpr (!Epi::AFTER_DRAIN) { E(acc, cur, wr, wc, fr, fq); S.done(cur); }
        if (!has_next) break;
#pragma unroll
        for (int a = 0; a < 2; ++a)
#pragma unroll
            for (int b = 0; b < 2; ++b)
#pragma unroll
                for (int m = 0; m < 4; ++m)
#pragma unroll
                    for (int n = 0; n < 2; ++n) acc[a][b][m][n] = (f32x4){0.f, 0.f, 0.f, 0.f};
        cur = nxt; cA = nA; cB = nB; ++ui;
        if constexpr (ALIGN_EPI) { if (wr == 1) PG8_BAR; }
    }
    PG8_WAIT_V(0);
    if constexpr (!ALIGN_EPI) { if (wr == 0) PG8_BAR; }
    PG8_BAR;
    if constexpr (Epi::AFTER_DRAIN) { E.fused(acc, cur, wr, wc, fr, fq, lds, wid, lane); S.done(cur); }
#undef PG8_SA
#undef PG8_SB
#undef PG8_STAGE
#undef PG8_LDA
#undef PG8_LDB
#undef PG8_MMA
#undef PG8_WAIT_V
#undef PG8_WAIT_L
#undef PG8_BAR
#undef PG8_SCHED
}
}

constexpr int DM = 1024, TP = 4096, BP = 4, MPR = BP * TP, BS = 8, TS = 16, MR = MPR + BS * TS, MP = 16640;
constexpr int DFF = 2816, NFF = 2 * DFF, INW = 5376, SHW = 1792, PAST = 4096, NPOS = PAST + TS;
constexpr float EPS = 1e-6f, LNX_EPS = 64e-5f;
constexpr float QSCALE = 0.125f * 1.4426950408889634f;
constexpr size_t O_Y = 0, O_KP = (size_t)MR * DM, O_VP = O_KP + (size_t)MPR * 512, O_SP = O_VP + (size_t)MPR * 512, O_SHP = O_SP + 131072,
                 O_KS = O_SHP + 7168, O_VS = O_KS + 65536, O_SS = O_VS + 65536, O_SHS = O_SS + 262144, O_END = O_SHS + 14336;
constexpr size_t KiB = 1024, MiB = 1u << 20;
constexpr size_t WS_W1T = 0, WS_W2T = 11 * MiB, WS_WINT = 16 * MiB + 512 * KiB, WS_WAT = 27 * MiB, WS_WRT = 28 * MiB, WS_WOT = 29 * MiB, WS_W3T = 31 * MiB, WS_W4T = 42 * MiB,
                 WS_TAB = 48 * MiB, WS_CTR = 49 * MiB + 512 * KiB, WS_ORW = 0,
                 WS_XN = 50 * MiB, WS_ABUF = 50 * MiB, WS_GG = 66 * MiB + 256 * KiB, WS_MG = 50 * MiB,
                 WS_G = 82 * MiB + 512 * KiB, WS_QB = WS_G, WS_KB = 98 * MiB + 768 * KiB, WS_VT = 115 * MiB, WS_ZRW = 131 * MiB + 256 * KiB,
                 WS_GATE = 188 * MiB + 128 * KiB, WS_DEC = 253 * MiB + 128 * KiB, WS_T = WS_KB, WS_F = 171 * MiB + 896 * KiB, WS_NEED = 286 * MiB;
constexpr size_t WS_LW = 49 * MiB + 64 * KiB;
static_assert(WS_ZRW + (size_t)MP * SHW * 2 <= WS_GATE && WS_GATE + (size_t)MP * 2048 * 2 <= WS_DEC && WS_DEC + (size_t)MP * 512 * 4 <= WS_NEED, "ws map");
static_assert(WS_G + (size_t)MP * DFF * 2 <= WS_F && WS_F + (size_t)MP * DM * 4 <= WS_NEED && WS_T + (size_t)MP * DM * 4 <= WS_F, "ws map 2");
static_assert(WS_XN + (size_t)MP * DM * 2 <= WS_G && WS_ORW + (size_t)MP * 512 * 2 <= WS_WINT && WS_VT + (size_t)MP * 512 * 2 <= WS_ZRW, "ws map 3");

#define LAS __attribute__((address_space(3)))
typedef unsigned short bf16_t;
typedef short bf16x8 __attribute__((ext_vector_type(8)));
typedef float f32x4 __attribute__((ext_vector_type(4)));
typedef float f32x2 __attribute__((ext_vector_type(2)));
typedef unsigned u32x4 __attribute__((ext_vector_type(4)));
typedef unsigned u32x2 __attribute__((ext_vector_type(2)));
typedef __bf16 bf16x2_t __attribute__((ext_vector_type(2)));
using pg8::Unit;

__device__ __forceinline__ unsigned pk2(float lo, float hi) { f32x2 v = {lo, hi}; bf16x2_t b = __builtin_convertvector(v, bf16x2_t); return __builtin_bit_cast(unsigned, b); }
__device__ __forceinline__ bf16_t f2bf(float f) { return (bf16_t)(pk2(f, 0.f) & 0xffffu); }
__device__ __forceinline__ float bf2f(bf16_t h) { return __uint_as_float((unsigned)h << 16); }
__device__ __forceinline__ float bflo(unsigned w) { return __uint_as_float(w << 16); }
__device__ __forceinline__ float bfhi(unsigned w) { return __uint_as_float(w & 0xffff0000u); }
__device__ __forceinline__ float fexp2(float x) { return __builtin_amdgcn_exp2f(x); }
__device__ __forceinline__ float frcp(float x) { return __builtin_amdgcn_rcpf(x); }
__device__ __forceinline__ float sigmoidf_(float x) { return frcp(1.f + fexp2(-1.4426950408889634f * x)); }
template <int CTRL> __device__ __forceinline__ float dpp_add_(float x) {
    return x + __builtin_bit_cast(float, __builtin_amdgcn_update_dpp(0, __builtin_bit_cast(int, x), CTRL, 0xf, 0xf, true));
}
__device__ __forceinline__ float wave_sum_fast(float x) {
    x = dpp_add_<0xB1>(x); x = dpp_add_<0x4E>(x); x = dpp_add_<0x141>(x); x = dpp_add_<0x140>(x);
    { auto rr = __builtin_amdgcn_permlane16_swap(__float_as_uint(x), __float_as_uint(x), false, false); x = __uint_as_float(rr[0]) + __uint_as_float(rr[1]); }
    { auto rr = __builtin_amdgcn_permlane32_swap(__float_as_uint(x), __float_as_uint(x), false, false); x = __uint_as_float(rr[0]) + __uint_as_float(rr[1]); }
    return x;
}
__device__ __forceinline__ float wave_sum(float v) { return wave_sum_fast(v); }
__device__ __forceinline__ float half_sum(float v) {
#pragma unroll
    for (int o = 1; o < 32; o <<= 1) v += __shfl_xor(v, o);
    return v;
}

struct Params {
    const float* in[36];
    float* out;
    unsigned char* ws;
    int ph_lo, ph_hi;
};
struct Ctx {
    const LAS unsigned* tab;
    __device__ __forceinline__ const void* ptr(int i) const {
        const unsigned lo = __builtin_amdgcn_readfirstlane(tab[2 * i]), hi = __builtin_amdgcn_readfirstlane(tab[2 * i + 1]);
        return (const void*)(const __attribute__((address_space(1))) void*)(((unsigned long long)hi << 32) | lo);
    }
    __device__ __forceinline__ const float* in(int i) const { return (const float*)ptr(i); }
    __device__ __forceinline__ float* out() const { return (float*)ptr(36); }
    __device__ __forceinline__ unsigned char* ws() const { return (unsigned char*)ptr(37); }
};

struct EpiSwiglu {
    static constexpr bool PERM = true, AFTER_DRAIN = false;
    bf16_t* O;
    __device__ __forceinline__ void operator()(const f32x4 (&acc)[2][2][4][2], const Unit& u, int wr, int wc, int fr, int fq) const {
        const int col0 = u.pn * 128 + wc * 32 + 8 * fq;
#pragma unroll
        for (int ai = 0; ai < 2; ++ai)
#pragma unroll
            for (int m = 0; m < 4; ++m) {
                const int row = u.pm * 256 + ai * 128 + wr * 64 + m * 16 + fr;
                float v[8];
#pragma unroll
                for (int n = 0; n < 2; ++n)
#pragma unroll
                    for (int i = 0; i < 4; ++i) { const float g = acc[ai][0][m][n][i], up = acc[ai][1][m][n][i]; v[n * 4 + i] = g * sigmoidf_(g) * up; }
                u32x4 w; w.x = pk2(v[0], v[1]); w.y = pk2(v[2], v[3]); w.z = pk2(v[4], v[5]); w.w = pk2(v[6], v[7]);
                if (row < MR) *(u32x4*)(O + (size_t)row * DFF + col0) = w;
                asm volatile("" ::: "memory");
            }
    }
};
struct EpiF32 {
    static constexpr bool PERM = false, AFTER_DRAIN = false;
    float* O;
    __device__ __forceinline__ void operator()(const f32x4 (&acc)[2][2][4][2], const Unit& u, int wr, int wc, int fr, int fq) const {
        const int col0 = u.pn * 256 + wc * 32 + 4 * fq;
#pragma unroll
        for (int ai = 0; ai < 2; ++ai)
#pragma unroll
            for (int m = 0; m < 4; ++m) {
                const int row = u.pm * 256 + ai * 128 + wr * 64 + m * 16 + fr;
                if (row < MR) {
#pragma unroll
                    for (int bj = 0; bj < 2; ++bj)
#pragma unroll
                        for (int n = 0; n < 2; ++n) *(f32x4*)(O + (size_t)row * DM + col0 + bj * 128 + n * 16) = acc[ai][bj][m][n];
                }
                asm volatile("" ::: "memory");
            }
    }
};
struct EpiGate1 {
    static constexpr bool PERM = true, AFTER_DRAIN = false;
    bf16_t* T; const bf16_t* GATE;
    __device__ __forceinline__ void operator()(const f32x4 (&acc)[2][2][4][2], const Unit& u, int wr, int wc, int fr, int fq) const {
        const int col0 = u.pn * 256 + wc * 32 + 8 * fq;
#pragma unroll
        for (int ai = 0; ai < 2; ++ai)
#pragma unroll
            for (int m = 0; m < 4; ++m) {
                const int row = u.pm * 256 + ai * 128 + wr * 64 + m * 16 + fr;
                if (row < MR) {
#pragma unroll
                    for (int bj = 0; bj < 2; ++bj) {
                        const u32x4 gv = *(const u32x4*)(GATE + (size_t)row * 2048 + col0 + bj * 128);
                        f32x4 a = acc[ai][bj][m][0], b = acc[ai][bj][m][1];
                        a[0] *= bflo(gv.x); a[1] *= bfhi(gv.x); a[2] *= bflo(gv.y); a[3] *= bfhi(gv.y);
                        b[0] *= bflo(gv.z); b[1] *= bfhi(gv.z); b[2] *= bflo(gv.w); b[3] *= bfhi(gv.w);
                        u32x4 w; w.x = pk2(a[0], a[1]); w.y = pk2(a[2], a[3]); w.z = pk2(b[0], b[1]); w.w = pk2(b[2], b[3]);
                        *(u32x4*)(T + (size_t)row * DM + col0 + bj * 128) = w;
                    }
                }
                asm volatile("" ::: "memory");
            }
    }
};
struct EpiGate2 {
    static constexpr bool PERM = true, AFTER_DRAIN = false;
    const bf16_t* T; const bf16_t* GATE; bf16_t* MG;
    __device__ __forceinline__ void operator()(const f32x4 (&acc)[2][2][4][2], const Unit& u, int wr, int wc, int fr, int fq) const {
        const int col0 = u.pn * 256 + wc * 32 + 8 * fq;
#pragma unroll
        for (int ai = 0; ai < 2; ++ai)
#pragma unroll
            for (int m = 0; m < 4; ++m) {
                const int row = u.pm * 256 + ai * 128 + wr * 64 + m * 16 + fr;
                if (row < MR) {
#pragma unroll
                    for (int bj = 0; bj < 2; ++bj) {
                        const u32x4 gv = *(const u32x4*)(GATE + (size_t)row * 2048 + 1024 + col0 + bj * 128);
                        const u32x4 tv = *(const u32x4*)(T + (size_t)row * DM + col0 + bj * 128);
                        f32x4 a = (f32x4){bflo(tv.x), bfhi(tv.x), bflo(tv.y), bfhi(tv.y)}, b = (f32x4){bflo(tv.z), bfhi(tv.z), bflo(tv.w), bfhi(tv.w)};
                        const f32x4 x = acc[ai][bj][m][0], y = acc[ai][bj][m][1];
                        a[0] += x[0] * bflo(gv.x); a[1] += x[1] * bfhi(gv.x); a[2] += x[2] * bflo(gv.y); a[3] += x[3] * bfhi(gv.y);
                        b[0] += y[0] * bflo(gv.z); b[1] += y[1] * bfhi(gv.z); b[2] += y[2] * bflo(gv.w); b[3] += y[3] * bfhi(gv.w);
                        u32x4 w; w.x = pk2(a[0], a[1]); w.y = pk2(a[2], a[3]); w.z = pk2(b[0], b[1]); w.w = pk2(b[2], b[3]);
                        *(u32x4*)(MG + (size_t)row * DM + col0 + bj * 128) = w;
                    }
                }
                asm volatile("" ::: "memory");
            }
    }
};
struct EpiZ {
    static constexpr bool PERM = true, AFTER_DRAIN = false;
    float* out; bf16_t *QB, *KB, *VT, *ZRW, *GATE; const f32x2* TAB;
    __device__ __forceinline__ void operator()(const f32x4 (&acc)[2][2][4][2], const Unit& u, int wr, int wc, int fr, int fq) const {
        const int pn = u.pn;
#pragma unroll
        for (int ai = 0; ai < 2; ++ai)
#pragma unroll
            for (int m = 0; m < 4; ++m) {
                const int row = u.pm * 256 + ai * 128 + wr * 64 + m * 16 + fr;
                asm volatile("" ::: "memory");
                if (row >= MR) continue;
                const bool smp = row >= MPR;
                if (pn < 4) {
                    const int pos = smp ? PAST + ((row - MPR) & 15) : (row & (TP - 1));
                    const int d0 = 8 * fq;
                    float o1[8], o2[8];
#pragma unroll
                    for (int n = 0; n < 2; ++n)
#pragma unroll
                        for (int i = 0; i < 4; ++i) {
                            const f32x2 cs = TAB[pos * 32 + d0 + n * 4 + i];
                            const float x1 = acc[ai][0][m][n][i], x2 = acc[ai][1][m][n][i];
                            o1[n * 4 + i] = x1 * cs.x - x2 * cs.y; o2[n * 4 + i] = x1 * cs.y + x2 * cs.x;
                        }
                    const int cb = (pn & 1) * 256 + 64 * wc + d0;
                    if (pn < 2) {
                        u32x4 w1, w2;
                        w1.x = pk2(o1[0] * QSCALE, o1[1] * QSCALE); w1.y = pk2(o1[2] * QSCALE, o1[3] * QSCALE); w1.z = pk2(o1[4] * QSCALE, o1[5] * QSCALE); w1.w = pk2(o1[6] * QSCALE, o1[7] * QSCALE);
                        w2.x = pk2(o2[0] * QSCALE, o2[1] * QSCALE); w2.y = pk2(o2[2] * QSCALE, o2[3] * QSCALE); w2.z = pk2(o2[4] * QSCALE, o2[5] * QSCALE); w2.w = pk2(o2[6] * QSCALE, o2[7] * QSCALE);
                        *(u32x4*)(QB + (size_t)row * 512 + cb) = w1; *(u32x4*)(QB + (size_t)row * 512 + cb + 32) = w2;
                    } else {
                        float* ko = smp ? out + O_KS + (size_t)(row - MPR) * 512 + cb : out + O_KP + (size_t)row * 512 + cb;
                        *(f32x4*)ko = (f32x4){o1[0], o1[1], o1[2], o1[3]}; *(f32x4*)(ko + 4) = (f32x4){o1[4], o1[5], o1[6], o1[7]};
                        *(f32x4*)(ko + 32) = (f32x4){o2[0], o2[1], o2[2], o2[3]}; *(f32x4*)(ko + 36) = (f32x4){o2[4], o2[5], o2[6], o2[7]};
                        u32x4 w1, w2;
                        w1.x = pk2(o1[0], o1[1]); w1.y = pk2(o1[2], o1[3]); w1.z = pk2(o1[4], o1[5]); w1.w = pk2(o1[6], o1[7]);
                        w2.x = pk2(o2[0], o2[1]); w2.y = pk2(o2[2], o2[3]); w2.z = pk2(o2[4], o2[5]); w2.w = pk2(o2[6], o2[7]);
                        *(u32x4*)(KB + (size_t)row * 512 + cb) = w1; *(u32x4*)(KB + (size_t)row * 512 + cb + 32) = w2;
                    }
                } else {
#pragma unroll
                    for (int bj = 0; bj < 2; ++bj) {
                        const int c = pn * 256 + bj * 128 + wc * 32 + 8 * fq;
                        const f32x4 a = acc[ai][bj][m][0], b = acc[ai][bj][m][1];
                        if (pn < 6) {
                            const int vc = c - 1024;
                            float* vo = smp ? out + O_VS + (size_t)(row - MPR) * 512 + vc : out + O_VP + (size_t)row * 512 + vc;
                            *(f32x4*)vo = a; *(f32x4*)(vo + 4) = b;
                            if (!smp) {
                                const int bb = row >> 12, t = row & (TP - 1), hh = vc >> 7, dd = vc & 127;
                                bf16_t* vt = VT + ((size_t)(bb * 4 + hh) * 128 + dd) * TP + t;
                                vt[0] = f2bf(a[0]); vt[TP] = f2bf(a[1]); vt[2 * TP] = f2bf(a[2]); vt[3 * TP] = f2bf(a[3]);
                                vt[4 * TP] = f2bf(b[0]); vt[5 * TP] = f2bf(b[1]); vt[6 * TP] = f2bf(b[2]); vt[7 * TP] = f2bf(b[3]);
                            }
                        } else if (pn < 13) {
                            const int zc = c - 1536;
                            u32x4 w; w.x = pk2(a[0], a[1]); w.y = pk2(a[2], a[3]); w.z = pk2(b[0], b[1]); w.w = pk2(b[2], b[3]);
                            *(u32x4*)(ZRW + (size_t)row * SHW + zc) = w;
                            const bool last = smp ? (((row - MPR) & 15) == 15) : ((row & (TP - 1)) == TP - 1);
                            if (last) { float* so = smp ? out + O_SHS + (size_t)((row - MPR) >> 4) * SHW + zc : out + O_SHP + (size_t)(row >> 12) * SHW + zc;
                                *(f32x4*)so = a; *(f32x4*)(so + 4) = b; }
                        } else {
                            const int gc = c - 3328;
                            u32x4 w; w.x = pk2(sigmoidf_(a[0]), sigmoidf_(a[1])); w.y = pk2(sigmoidf_(a[2]), sigmoidf_(a[3])); w.z = pk2(sigmoidf_(b[0]), sigmoidf_(b[1])); w.w = pk2(sigmoidf_(b[2]), sigmoidf_(b[3]));
                            *(u32x4*)(GATE + (size_t)row * 2048 + gc) = w;
                        }
                    }
                }
            }
    }
};

__device__ __forceinline__ void transpose_item(const float* W, int K, int N, bf16_t* WT, int k0, int n0, int drow0, LAS float* scr, int lane) {
#pragma unroll 8
    for (int i = 0; i < 32; ++i) { const int kk = 2 * i + (lane >> 5); scr[kk * 33 + (lane & 31)] = W[(size_t)(k0 + kk) * N + n0 + (lane & 31)]; }
    asm volatile("s_waitcnt lgkmcnt(0)" ::: "memory");
    const int c = lane & 7;
#pragma unroll
    for (int j = 0; j < 4; ++j) { const int n = (lane >> 3) + 8 * j; const LAS float* s = scr + (8 * c) * 33 + n;
        u32x4 o; o.x = pk2(s[0 * 33], s[1 * 33]); o.y = pk2(s[2 * 33], s[3 * 33]); o.z = pk2(s[4 * 33], s[5 * 33]); o.w = pk2(s[6 * 33], s[7 * 33]);
        *(u32x4*)(WT + (size_t)(drow0 + n) * K + k0 + 8 * c) = o; }
    asm volatile("s_waitcnt lgkmcnt(0)" ::: "memory");
}
__device__ __forceinline__ int map_w1(int n) { return n < DFF ? 256 * (n >> 7) + (n & 127) : 256 * ((n - DFF) >> 7) + 128 + ((n - DFF) & 127); }
__device__ __forceinline__ int map_win(int n) { return n < 1024 ? (n & ~255) + 128 * ((n >> 5) & 1) + 32 * ((n >> 6) & 3) + (n & 31) : n; }

__device__ __forceinline__ void sincos_d(double ang, float& c, float& s) {
    const double TWO_PI = 6.283185307179586476925286766559, HALF_PI = 1.5707963267948966192313216916398;
    double r = ang - TWO_PI * __builtin_rint(ang / TWO_PI);
    const double qd = __builtin_rint(r / HALF_PI); const int q = (int)qd; r -= qd * HALF_PI;
    const double r2 = r * r;
    double sp = r * (1.0 + r2 * (-1.0 / 6 + r2 * (1.0 / 120 + r2 * (-1.0 / 5040 + r2 * (1.0 / 362880 + r2 * (-1.0 / 39916800 + r2 * (1.0 / 6227020800.0)))))));
    double cp = 1.0 + r2 * (-0.5 + r2 * (1.0 / 24 + r2 * (-1.0 / 720 + r2 * (1.0 / 40320 + r2 * (-1.0 / 3628800 + r2 * (1.0 / 479001600.0 + r2 * (-1.0 / 87178291200.0)))))));
    double cc, ss;
    switch (q & 3) { case 0: cc = cp; ss = sp; break; case 1: cc = -sp; ss = cp; break; case 2: cc = -cp; ss = -sp; break; default: cc = sp; ss = -cp; break; }
    c = (float)cc; s = (float)ss;
}
__device__ __forceinline__ void rms_row_to_bf16(const float* xrow, const float* g, bf16_t* orow, int lane) {
    const f32x4* xr = (const f32x4*)xrow + lane; const f32x4* gr = (const f32x4*)g + lane;
    f32x4 v[4]; float s = 0.f;
#pragma unroll
    for (int j = 0; j < 4; ++j) { v[j] = xr[64 * j]; s += (v[j].x * v[j].x + v[j].y * v[j].y) + (v[j].z * v[j].z + v[j].w * v[j].w); }
    const float rs = 1.f / sqrtf(wave_sum(s) * (1.f / DM) + EPS);
    u32x2* o8 = (u32x2*)orow + lane;
#pragma unroll
    for (int j = 0; j < 4; ++j) { const f32x4 gg = gr[64 * j]; u32x2 w; w.x = pk2(v[j].x * rs * gg.x, v[j].y * rs * gg.y); w.y = pk2(v[j].z * rs * gg.z, v[j].w * rs * gg.w); o8[64 * j] = w; }
}
__device__ __forceinline__ const float* xrow_ptr(const Ctx& p, int row) { return row < MPR ? p.in(0) + (size_t)row * DM : p.in(1) + (size_t)(row - MPR) * DM; }

__device__ __forceinline__ void prologue_part2(const Ctx& p, LAS unsigned char* lds, int bidx, int nblk) {
    const int tid = threadIdx.x, lane = tid & 63, wave = __builtin_amdgcn_readfirstlane(tid >> 6);
    const int gw = bidx * 8 + wave, NGW = nblk * 8;
    unsigned char* ws = p.ws();
    LAS float* scr = (LAS float*)(lds + wave * 16384);
    constexpr int I2 = 44 * 32, I3 = 16 * 168, I4 = 8 * 32, I5 = 8 * 32, I6 = 16 * 32;
    __syncthreads();
    for (int it = gw; it < I2 + I3 + I4 + I5 + I6; it += NGW) {
        int r = it;
        if (r < I2) { const int kb = r / 32, nb = r % 32; transpose_item(p.in(8), DFF, DM, (bf16_t*)(ws + WS_W2T), 64 * kb, 32 * nb, 32 * nb, scr, lane); continue; } r -= I2;
        if (r < I3) { const int kb = r / 168, nb = r % 168; transpose_item(p.in(11), DM, INW, (bf16_t*)(ws + WS_WINT), 64 * kb, 32 * nb, map_win(32 * nb), scr, lane); continue; } r -= I3;
        if (r < I4) { const int kb = r / 32, nb = r % 32; transpose_item(p.in(28), 512, DM, (bf16_t*)(ws + WS_WAT), 64 * kb, 32 * nb, 32 * nb, scr, lane); continue; } r -= I4;
        if (r < I5) { const int kb = r / 32, nb = r % 32; transpose_item(p.in(29), 512, DM, (bf16_t*)(ws + WS_WRT), 64 * kb, 32 * nb, 32 * nb, scr, lane); continue; } r -= I5;
        { const int kb = r / 32, nb = r % 32; transpose_item(p.in(30), DM, DM, (bf16_t*)(ws + WS_WOT), 64 * kb, 32 * nb, 32 * nb, scr, lane); }
    }
    {   bf16_t* LW = (bf16_t*)(ws + WS_LW);
        for (int e = bidx * 512 + tid; e < 512 * 256; e += nblk * 512) {
            const int n = e & 511, k = e >> 9;
            if (k < 64) LW[n * 64 + k] = f2bf(p.in(19)[k * 512 + n]);
            else if (k < 128) LW[512 * 64 + n * 64 + (k - 64)] = f2bf(p.in(21)[(k - 64) * 512 + n]);
            else LW[2 * 512 * 64 + n * 128 + (k - 128)] = f2bf(p.in(22)[(k - 128) * 512 + n]);
        } }
    for (int e = bidx * 512 + tid; e < NPOS * 32; e += nblk * 512) {
        const int pos = e >> 5, d = e & 31;
        const double inv = exp(-(double)d * (9.210340371976182736071965818737 / 32.0));
        float c, s; sincos_d((double)pos * inv, c, s);
        ((f32x2*)(ws + WS_TAB))[e] = (f32x2){c, s};
    }
}
__device__ __forceinline__ void phase_prologue(const Ctx& p, LAS unsigned char* lds) {
    const int tid = threadIdx.x, lane = tid & 63, wave = __builtin_amdgcn_readfirstlane(tid >> 6);
    const int gw = blockIdx.x * 8 + wave, NGW = gridDim.x * 8;
    unsigned char* ws = p.ws();
    LAS float* scr = (LAS float*)(lds + wave * 16384);
    constexpr int I1 = 16 * 176;
    for (int it = gw; it < I1; it += NGW) { const int kb = it / 176, nb = it % 176; transpose_item(p.in(7), DM, NFF, (bf16_t*)(ws + WS_W1T), 64 * kb, 32 * nb, map_w1(32 * nb), scr, lane); }
    bf16_t* XN = (bf16_t*)(ws + WS_XN);
    {   f32x4 g4[4], v[4], v2[4];
#pragma unroll
        for (int j = 0; j < 4; ++j) g4[j] = ((const f32x4*)p.in(6))[lane + 64 * j];
        if (gw < MR) {
#pragma unroll
            for (int j = 0; j < 4; ++j) v[j] = ((const f32x4*)xrow_ptr(p, gw))[lane + 64 * j]; }
        for (int m = gw; m < MP; m += NGW) {
            const int mn = m + NGW;
            if (mn < MR) {
#pragma unroll
                for (int j = 0; j < 4; ++j) v2[j] = ((const f32x4*)xrow_ptr(p, mn))[lane + 64 * j]; }
            u32x2* o8 = (u32x2*)(XN + (size_t)m * DM) + lane;
            if (m < MR) {
                float sq = 0.f;
#pragma unroll
                for (int j = 0; j < 4; ++j) sq += (v[j].x * v[j].x + v[j].y * v[j].y) + (v[j].z * v[j].z + v[j].w * v[j].w);
                const float rs = 1.f / sqrtf(wave_sum(sq) * (1.f / DM) + EPS);
#pragma unroll
                for (int j = 0; j < 4; ++j) { u32x2 w; w.x = pk2(v[j].x * rs * g4[j].x, v[j].y * rs * g4[j].y); w.y = pk2(v[j].z * rs * g4[j].z, v[j].w * rs * g4[j].w); o8[64 * j] = w; }
            } else {
#pragma unroll
                for (int j = 0; j < 4; ++j) o8[64 * j] = (u32x2){0u, 0u}; }
#pragma unroll
            for (int j = 0; j < 4; ++j) v[j] = v2[j];
        }
    }
}

__device__ __forceinline__ void phase_rowpass(const Ctx& p, const float* F, int base_is_x, float alpha, const float* gpost, const float* gnext, bf16_t* XN, const float* PART, int nsplit) {
    const int tid = threadIdx.x, lane = tid & 63, wave = __builtin_amdgcn_readfirstlane(tid >> 6);
    const int gw = blockIdx.x * 8 + wave, NGW = gridDim.x * 8;
    float* H = p.out() + O_Y;
    auto loadrow = [&](int m, f32x4 (&f)[4], f32x4 (&b)[4]) {
        const f32x4* fr = (const f32x4*)(F + (size_t)m * DM) + lane;
        const f32x4* br = (const f32x4*)(base_is_x ? xrow_ptr(p, m) : H + (size_t)m * DM) + lane;
#pragma unroll
        for (int j = 0; j < 4; ++j) { b[j] = br[64 * j];
            if (m < MPR) f[j] = fr[64 * j];
            else { f[j] = (f32x4){0.f, 0.f, 0.f, 0.f};
                for (int ks = 0; ks < nsplit; ++ks) f[j] = f[j] + ((const f32x4*)(PART + ((size_t)ks * 128 + (m - MPR)) * DM))[lane + 64 * j]; } }
    };
    f32x4 gp[4], gn[4];
#pragma unroll
    for (int j = 0; j < 4; ++j) { gp[j] = ((const f32x4*)gpost)[lane + 64 * j]; gn[j] = gnext ? ((const f32x4*)gnext)[lane + 64 * j] : (f32x4){0.f, 0.f, 0.f, 0.f}; }
    f32x4 f[4], b[4], f2[4], b2[4];
    if (gw < MR) loadrow(gw, f, b);
    for (int m = gw; m < MR; m += NGW) {
        const bool more = m + NGW < MR;
        if (more) loadrow(m + NGW, f2, b2);
        float s = 0.f;
#pragma unroll
        for (int j = 0; j < 4; ++j) s += (f[j].x * f[j].x + f[j].y * f[j].y) + (f[j].z * f[j].z + f[j].w * f[j].w);
        const float rs = alpha / sqrtf(wave_sum_fast(s) * (1.f / DM) + EPS);
        float s2 = 0.f;
#pragma unroll
        for (int j = 0; j < 4; ++j) { b[j] = b[j] + f[j] * rs * gp[j]; s2 += (b[j].x * b[j].x + b[j].y * b[j].y) + (b[j].z * b[j].z + b[j].w * b[j].w);
            ((f32x4*)(H + (size_t)m * DM))[lane + 64 * j] = b[j]; }
        if (gnext) {
            const float r2 = 1.f / sqrtf(wave_sum_fast(s2) * (1.f / DM) + EPS);
            u32x2* o8 = (u32x2*)(XN + (size_t)m * DM) + lane;
#pragma unroll
            for (int j = 0; j < 4; ++j) { u32x2 w; w.x = pk2(b[j].x * r2 * gn[j].x, b[j].y * r2 * gn[j].y); w.y = pk2(b[j].z * r2 * gn[j].z, b[j].w * r2 * gn[j].w); o8[64 * j] = w; }
        }
        if (more) {
#pragma unroll
            for (int j = 0; j < 4; ++j) { f[j] = f2[j]; b[j] = b2[j]; } }
    }
}

__device__ __forceinline__ float zshift(const Ctx& p, const bf16_t* ZRW, int row, int c) {
    const float z = bf2f(ZRW[(size_t)row * SHW + c]);
    float prev;
    if (row < MPR) prev = (row & (TP - 1)) ? bf2f(ZRW[(size_t)(row - 1) * SHW + c]) : 0.f;
    else { const int r = row - MPR; prev = (r & 15) ? bf2f(ZRW[(size_t)(row - 1) * SHW + c]) : p.in(5)[(size_t)(r >> 4) * SHW + c]; }
    return z + (prev - z) * p.in(17)[c];
}
__device__ __forceinline__ void unpack8(const u32x4 w, float (&f)[8]) { f[0] = bflo(w.x); f[1] = bfhi(w.x); f[2] = bflo(w.y); f[3] = bfhi(w.y); f[4] = bflo(w.z); f[5] = bfhi(w.z); f[6] = bflo(w.w); f[7] = bfhi(w.w); }
__device__ __forceinline__ void zshift8(const Ctx& p, const bf16_t* ZRW, int row, int c, const float (&mu)[8], float (&o)[8]) {
    float z[8], pv[8];
    unpack8(*(const u32x4*)(ZRW + (size_t)row * SHW + c), z);
    bool first; int bsmp = 0;
    if (row < MPR) first = (row & (TP - 1)) == 0; else { first = ((row - MPR) & 15) == 0; bsmp = (row - MPR) >> 4; }
    if (!first) unpack8(*(const u32x4*)(ZRW + (size_t)(row - 1) * SHW + c), pv);
    else if (row < MPR) {
#pragma unroll
        for (int e = 0; e < 8; ++e) pv[e] = 0.f;
    } else { const float* s0 = p.in(5) + (size_t)bsmp * SHW + c;
#pragma unroll
        for (int e = 0; e < 8; ++e) pv[e] = s0[e]; }
#pragma unroll
    for (int e = 0; e < 8; ++e) o[e] = z[e] + (pv[e] - z[e]) * mu[e];
}
__device__ __forceinline__ void phase_lora(const Ctx& p, LAS unsigned char* lds) {
    const int tid = threadIdx.x, lane = tid & 63, wave = __builtin_amdgcn_readfirstlane(tid >> 6), q = lane & 15, g = lane >> 4;
    const bf16_t* ZRW = (const bf16_t*)(p.ws() + WS_ZRW);
    float* DEC = (float*)(p.ws() + WS_DEC); bf16_t* AB = (bf16_t*)(p.ws() + WS_ABUF); bf16_t* GG = (bf16_t*)(p.ws() + WS_GG);
    const bf16_t* w2T = (const bf16_t*)(p.ws() + WS_LW); const bf16_t* a2T = w2T + 512 * 64; const bf16_t* g2T = a2T + 512 * 64;
    LAS bf16_t* X = (LAS bf16_t*)(lds + wave * 16 * 264 * 2);
    const float* mu = p.in(17) + 1536;
    for (int it = blockIdx.x + gridDim.x * wave; it < MR / 16; it += gridDim.x * 8) {
        const int r0 = it * 16;
        {
            const int tt = lane >> 2, cq = lane & 3, row = r0 + tt;
#pragma unroll
            for (int j = 0; j < 8; ++j) {
                const int c = cq * 64 + j * 8;
                float m8[8], z[8];
#pragma unroll
                for (int e = 0; e < 8; ++e) m8[e] = mu[c + e];
                zshift8(p, ZRW, row, 1536 + c, m8, z);
#pragma unroll
                for (int e = 0; e < 8; ++e) z[e] = cq == 0 ? tanhf(z[e]) : (cq == 1 ? z[e] : sigmoidf_(z[e]));
                u32x4 w; w.x = pk2(z[0], z[1]); w.y = pk2(z[2], z[3]); w.z = pk2(z[4], z[5]); w.w = pk2(z[6], z[7]);
                *(LAS u32x4*)(X + tt * 264 + c) = w;
            }
        }
        asm volatile("s_waitcnt lgkmcnt(0)" ::: "memory");
        bf16x8 bx[8];
#pragma unroll
        for (int ks = 0; ks < 8; ++ks) bx[ks] = *(const LAS bf16x8*)(X + q * 264 + ks * 32 + 8 * g);
        const int row = r0 + q;
        struct WF { bf16x8 w[2], a[2], gq[4]; f32x4 w0, a0; };
        auto ldw = [&](WF& f, int nt) {
            const int n = nt * 16 + q, c = nt * 16 + 4 * g;
#pragma unroll
            for (int ks = 0; ks < 2; ++ks) { f.w[ks] = *(const bf16x8*)(w2T + n * 64 + ks * 32 + 8 * g); f.a[ks] = *(const bf16x8*)(a2T + n * 64 + ks * 32 + 8 * g); }
#pragma unroll
            for (int ks = 0; ks < 4; ++ks) f.gq[ks] = *(const bf16x8*)(g2T + n * 128 + ks * 32 + 8 * g);
            f.w0 = *(const f32x4*)(p.in(18) + c); f.a0 = *(const f32x4*)(p.in(20) + c);
        };
        auto tile = [&](const WF& f, int nt) {
            f32x4 aw = (f32x4){0.f, 0.f, 0.f, 0.f}, aa = aw, ag = aw;
#pragma unroll
            for (int ks = 0; ks < 2; ++ks) { aw = __builtin_amdgcn_mfma_f32_16x16x32_bf16(f.w[ks], bx[ks], aw, 0, 0, 0); aa = __builtin_amdgcn_mfma_f32_16x16x32_bf16(f.a[ks], bx[2 + ks], aa, 0, 0, 0); }
#pragma unroll
            for (int ks = 0; ks < 4; ++ks) ag = __builtin_amdgcn_mfma_f32_16x16x32_bf16(f.gq[ks], bx[4 + ks], ag, 0, 0, 0);
            const int c = nt * 16 + 4 * g;
            f32x4 dec; float av[4];
#pragma unroll
            for (int e = 0; e < 4; ++e) {
                const float x = f.w0[e] + aw[e];
                const float sp = fmaxf(-x, 0.f) + log1pf(expf(-fabsf(x)));
                dec[e] = expf(-expf(-sp - 0.5f));
                av[e] = sigmoidf_(f.a0[e] + aa[e]);
            }
            *(f32x4*)(DEC + (size_t)row * 512 + c) = dec;
            *(u32x2*)(AB + (size_t)row * 512 + c) = (u32x2){pk2(av[0], av[1]), pk2(av[2], av[3])};
            *(u32x2*)(GG + (size_t)row * 512 + c) = (u32x2){pk2(ag[0], ag[1]), pk2(ag[2], ag[3])};
        };
        WF fa, fb;
        ldw(fa, 0);
#pragma unroll 1
        for (int nt = 0; nt < 32; nt += 2) {
            ldw(fb, nt + 1);
            tile(fa, nt);
            ldw(fa, (nt + 2) & 31);
            tile(fb, nt + 1);
        }
        asm volatile("s_waitcnt lgkmcnt(0)" ::: "memory");
    }
}

#define MFMA16(a, b, c) __builtin_amdgcn_mfma_f32_16x16x32_bf16((a), (b), (c), 0, 0, 0)
struct AttAcc { f32x4 O[2][8]; float m[2], l[2]; };
__device__ __forceinline__ void att_init(AttAcc& A) {
#pragma unroll
    for (int mm = 0; mm < 2; ++mm) { A.m[mm] = -1e30f; A.l[mm] = 0.f;
#pragma unroll
        for (int d = 0; d < 8; ++d) A.O[mm][d] = (f32x4){0.f, 0.f, 0.f, 0.f}; }
}
template <class LK> __device__ __forceinline__ void att_qk(AttAcc& A, const LK& lk, const bf16x8 (&bq)[2][2], int nvalid, int g, bf16x8 (&bP)[2][2]) {
#pragma unroll
    for (int mm = 0; mm < 2; ++mm) {
        f32x4 s[4];
#pragma unroll
        for (int t = 0; t < 4; ++t) { s[t] = (f32x4){0.f, 0.f, 0.f, 0.f};
#pragma unroll
            for (int ks = 0; ks < 2; ++ks) s[t] = MFMA16(lk(mm, ks, t), bq[mm][ks], s[t]); }
        if (nvalid < 64) {
#pragma unroll
            for (int t = 0; t < 4; ++t)
#pragma unroll
                for (int r = 0; r < 4; ++r) if (16 * t + 4 * g + r >= nvalid) s[t][r] = -1e30f;
        }
        float mx = s[0][0];
#pragma unroll
        for (int t = 0; t < 4; ++t)
#pragma unroll
            for (int r = 0; r < 4; ++r) mx = fmaxf(mx, s[t][r]);
        { auto rr = __builtin_amdgcn_permlane16_swap(__float_as_uint(mx), __float_as_uint(mx), false, false); mx = fmaxf(__uint_as_float(rr[0]), __uint_as_float(rr[1])); }
        { auto rr = __builtin_amdgcn_permlane32_swap(__float_as_uint(mx), __float_as_uint(mx), false, false); mx = fmaxf(__uint_as_float(rr[0]), __uint_as_float(rr[1])); }
        const float mnew = fmaxf(A.m[mm], mx), alpha = fexp2(A.m[mm] - mnew);
        const bool grew = __builtin_amdgcn_ballot_w64(mnew > A.m[mm]) != 0ull;
        A.m[mm] = mnew;
        float ls = 0.f;
#pragma unroll
        for (int t = 0; t < 4; ++t)
#pragma unroll
            for (int r = 0; r < 4; ++r) { s[t][r] = fexp2(s[t][r] - mnew); ls += s[t][r]; }
        A.l[mm] = A.l[mm] * alpha + ls;
        if (grew) {
#pragma unroll
            for (int d = 0; d < 8; ++d) A.O[mm][d] = A.O[mm][d] * alpha;
        }
#pragma unroll
        for (int k2 = 0; k2 < 2; ++k2) {
            u32x4 w; w.x = pk2(s[2 * k2][0], s[2 * k2][1]); w.y = pk2(s[2 * k2][2], s[2 * k2][3]); w.z = pk2(s[2 * k2 + 1][0], s[2 * k2 + 1][1]); w.w = pk2(s[2 * k2 + 1][2], s[2 * k2 + 1][3]);
            bP[mm][k2] = __builtin_bit_cast(bf16x8, w);
        }
        asm volatile("" ::: "memory");
    }
}
__device__ __forceinline__ void att_final(const AttAcc& A, float l0, float l1, float lam, const float* subg, bf16_t* orow, int g) {
    const float i0 = 1.f / l0, i1 = lam / l1;
    f32x4 o[8]; float ss = 0.f;
#pragma unroll
    for (int d = 0; d < 8; ++d) { o[d] = A.O[0][d] * i0 - A.O[1][d] * i1; ss += (o[d][0] * o[d][0] + o[d][1] * o[d][1]) + (o[d][2] * o[d][2] + o[d][3] * o[d][3]); }
    ss += __shfl_xor(ss, 16); ss += __shfl_xor(ss, 32);
    const float rs = 0.8f / sqrtf(ss * (1.f / 128.f) + EPS);
#pragma unroll
    for (int d = 0; d < 8; ++d) { const f32x4 gg = *(const f32x4*)(subg + 16 * d + 4 * g);
        u32x2 w; w.x = pk2(o[d][0] * rs * gg[0], o[d][1] * rs * gg[1]); w.y = pk2(o[d][2] * rs * gg[2], o[d][3] * rs * gg[3]);
        *(u32x2*)(orow + 16 * d + 4 * g) = w; }
}
__device__ __forceinline__ float att_lambda(const Ctx& p, int lane) {
    const float a = wave_sum(p.in(12)[lane] * p.in(13)[lane]), b = wave_sum(p.in(14)[lane] * p.in(15)[lane]);
    return expf(a) - expf(b) + 0.2f;
}
constexpr int KS_STRIDE = 136, VS_STRIDE = 72, ATT_BUF = 64 * KS_STRIDE + 128 * VS_STRIDE;
__device__ __forceinline__ void att_prompt_unit(const Ctx& p, int bh, int qb, LAS unsigned char* lds) {
    const int tid = threadIdx.x, lane = tid & 63, wave = __builtin_amdgcn_readfirstlane(tid >> 6), q = lane & 15, g = lane >> 4;
    const int b = bh >> 2, h = bh & 3;
    bf16_t* QB = (bf16_t*)(p.ws() + WS_QB); const bf16_t* KB = (const bf16_t*)(p.ws() + WS_KB); const bf16_t* VT = (const bf16_t*)(p.ws() + WS_VT);
    const int row = b * TP + qb * 128 + wave * 16 + q;
    bf16_t* qrow = QB + (size_t)row * 512 + h * 128;
    bf16x8 bq[2][2];
#pragma unroll
    for (int mm = 0; mm < 2; ++mm)
#pragma unroll
        for (int ks = 0; ks < 2; ++ks) bq[mm][ks] = *(const bf16x8*)(qrow + mm * 64 + ks * 32 + 8 * g);
    AttAcc A; att_init(A);
    const int nkb = 2 * qb + 2, nkt = 2 * qb + 1 + (wave >> 2);
    const bf16_t* kg = KB + (size_t)(b * TP + (tid >> 4)) * 512 + h * 128 + (tid & 15) * 8;
    const bf16_t* vg = VT + ((size_t)bh * 128 + (tid >> 3)) * TP + (tid & 7) * 8;
    LAS bf16_t* L = (LAS bf16_t*)lds;
    const int kso = (tid >> 4) * KS_STRIDE + (tid & 15) * 8, vsb = 64 * KS_STRIDE + (tid >> 3) * VS_STRIDE + ((tid & 7) >> 2) * 32;
    const int kb_ = (tid & 3) * 8, vso = vsb + 8 * ((kb_ & 15) >> 2) + 4 * (kb_ >> 4), vso2 = vsb + 8 * (((kb_ + 4) & 15) >> 2) + 4 * ((kb_ + 4) >> 4);
    u32x4 k0 = *(const u32x4*)kg, k1 = *(const u32x4*)(kg + 32 * 512), v0 = *(const u32x4*)vg, v1 = *(const u32x4*)(vg + (size_t)64 * TP);
    __syncthreads();
    *(LAS u32x4*)(L + kso) = k0; *(LAS u32x4*)(L + kso + 32 * KS_STRIDE) = k1; *(LAS u32x2*)(L + vso) = (u32x2){v0.x, v0.y}; *(LAS u32x2*)(L + vso2) = (u32x2){v0.z, v0.w}; *(LAS u32x2*)(L + vso + 64 * VS_STRIDE) = (u32x2){v1.x, v1.y}; *(LAS u32x2*)(L + vso2 + 64 * VS_STRIDE) = (u32x2){v1.z, v1.w};
    __syncthreads();
    for (int kt = 0; kt < nkb; ++kt) {
        const LAS bf16_t* Lc = L + (kt & 1) * ATT_BUF;
        LAS bf16_t* Ln = L + ((kt + 1) & 1) * ATT_BUF;
        const bool more = kt + 1 < nkb;
        if (more) { const bf16_t* kn = kg + (size_t)(kt + 1) * 64 * 512; const bf16_t* vn = vg + (kt + 1) * 64;
            k0 = *(const u32x4*)kn; k1 = *(const u32x4*)(kn + 32 * 512); v0 = *(const u32x4*)vn; v1 = *(const u32x4*)(vn + (size_t)64 * TP); }
        if (kt < nkt) {
            bf16x8 bP[2][2];
            const LAS bf16_t* kl = Lc + q * KS_STRIDE + 8 * g;
            att_qk(A, [&](int mm, int ks, int t) { return *(const LAS bf16x8*)(kl + t * 16 * KS_STRIDE + mm * 64 + ks * 32); }, bq, 64, g, bP);
            const LAS bf16_t* vl = Lc + 64 * KS_STRIDE + q * VS_STRIDE + 8 * g;
#pragma unroll
            for (int d = 0; d < 8; ++d)
#pragma unroll
                for (int k2 = 0; k2 < 2; ++k2) {
                    const bf16x8 vf = *(const LAS bf16x8*)(vl + d * 16 * VS_STRIDE + 32 * k2);
                    A.O[0][d] = MFMA16(vf, bP[0][k2], A.O[0][d]); A.O[1][d] = MFMA16(vf, bP[1][k2], A.O[1][d]);
                }
        }
        if (more) { *(LAS u32x4*)(Ln + kso) = k0; *(LAS u32x4*)(Ln + kso + 32 * KS_STRIDE) = k1; *(LAS u32x2*)(Ln + vso) = (u32x2){v0.x, v0.y}; *(LAS u32x2*)(Ln + vso2) = (u32x2){v0.z, v0.w}; *(LAS u32x2*)(Ln + vso + 64 * VS_STRIDE) = (u32x2){v1.x, v1.y}; *(LAS u32x2*)(Ln + vso2 + 64 * VS_STRIDE) = (u32x2){v1.z, v1.w}; }
        __syncthreads();
    }
    float l0 = A.l[0], l1 = A.l[1];
    l0 += __shfl_xor(l0, 16); l0 += __shfl_xor(l0, 32); l1 += __shfl_xor(l1, 16); l1 += __shfl_xor(l1, 32);
    const float lam = att_lambda(p, lane);
    att_final(A, l0, l1, lam, p.in(16), qrow, g);
}
__device__ __forceinline__ bf16x8 cvt8(const float* s) {
    const f32x4 a = *(const f32x4*)s, b = *(const f32x4*)(s + 4);
    u32x4 w; w.x = pk2(a[0], a[1]); w.y = pk2(a[2], a[3]); w.z = pk2(b[0], b[1]); w.w = pk2(b[2], b[3]);
    return __builtin_bit_cast(bf16x8, w);
}
__device__ __forceinline__ void att_sample_unit(const Ctx& p, int bs, int h, LAS unsigned char* lds) {
    const int tid = threadIdx.x, lane = tid & 63, wave = __builtin_amdgcn_readfirstlane(tid >> 6), q = lane & 15, g = lane >> 4;
    bf16_t* QB = (bf16_t*)(p.ws() + WS_QB);
    const int row = MPR + bs * 16 + q;
    bf16_t* qrow = QB + (size_t)row * 512 + h * 128;
    bf16x8 bq[2][2];
#pragma unroll
    for (int mm = 0; mm < 2; ++mm)
#pragma unroll
        for (int ks = 0; ks < 2; ++ks) bq[mm][ks] = *(const bf16x8*)(qrow + mm * 64 + ks * 32 + 8 * g);
    AttAcc A; att_init(A);
    for (int kt = wave; kt < 65; kt += 8) {
        const bool isnew = kt == 64;
        const float* kb = isnew ? p.out() + O_KS + (size_t)bs * 16 * 512 : p.in(2) + ((size_t)bs * PAST + kt * 64) * 512;
        const float* vb = isnew ? p.out() + O_VS + (size_t)bs * 16 * 512 : p.in(3) + ((size_t)bs * PAST + kt * 64) * 512;
        const int nvalid = isnew ? 16 : 64;
        bf16x8 bP[2][2];
        att_qk(A, [&](int mm, int ks, int t) { const int key = min(16 * t + q, nvalid - 1); return cvt8(kb + (key * 512 + h * 128 + mm * 64 + ks * 32 + 8 * g)); }, bq, nvalid, g, bP);
#pragma unroll
        for (int d = 0; d < 8; ++d)
#pragma unroll
            for (int k2 = 0; k2 < 2; ++k2) {
                float v[8];
#pragma unroll
                for (int e = 0; e < 8; ++e) { const int key = min(32 * k2 + (e >> 2) * 16 + 4 * g + (e & 3), nvalid - 1); v[e] = vb[key * 512 + h * 128 + 16 * d + q]; }
                u32x4 w; w.x = pk2(v[0], v[1]); w.y = pk2(v[2], v[3]); w.z = pk2(v[4], v[5]); w.w = pk2(v[6], v[7]);
                const bf16x8 vf = __builtin_bit_cast(bf16x8, w);
                A.O[0][d] = MFMA16(vf, bP[0][k2], A.O[0][d]); A.O[1][d] = MFMA16(vf, bP[1][k2], A.O[1][d]);
                if (k2 == 1 && (d & 1)) asm volatile("" ::: "memory");
            }
    }
    float l0 = A.l[0], l1 = A.l[1];
    l0 += __shfl_xor(l0, 16); l0 += __shfl_xor(l0, 32); l1 += __shfl_xor(l1, 16); l1 += __shfl_xor(l1, 32);
    LAS float* Ob = (LAS float*)lds; LAS float* ML = Ob + 8 * 2 * 8 * 4 * 64;
#pragma unroll
    for (int mm = 0; mm < 2; ++mm)
#pragma unroll
        for (int d = 0; d < 8; ++d)
#pragma unroll
            for (int r = 0; r < 4; ++r) Ob[((((wave * 2 + mm) * 8 + d) * 4 + r) << 6) + lane] = A.O[mm][d][r];
    ML[(wave * 4 + 0) * 64 + lane] = A.m[0]; ML[(wave * 4 + 1) * 64 + lane] = A.m[1]; ML[(wave * 4 + 2) * 64 + lane] = l0; ML[(wave * 4 + 3) * 64 + lane] = l1;
    __syncthreads();
    {
        float ms0 = -1e30f, ms1 = -1e30f;
#pragma unroll
        for (int w = 0; w < 8; ++w) { ms0 = fmaxf(ms0, ML[(w * 4 + 0) * 64 + lane]); ms1 = fmaxf(ms1, ML[(w * 4 + 1) * 64 + lane]); }
        float L0 = 0.f, L1 = 0.f; f32x4 o0 = (f32x4){0.f, 0.f, 0.f, 0.f}, o1 = o0;
#pragma unroll
        for (int w = 0; w < 8; ++w) {
            const float f0 = fexp2(ML[(w * 4 + 0) * 64 + lane] - ms0), f1 = fexp2(ML[(w * 4 + 1) * 64 + lane] - ms1);
            L0 += ML[(w * 4 + 2) * 64 + lane] * f0; L1 += ML[(w * 4 + 3) * 64 + lane] * f1;
#pragma unroll
            for (int r = 0; r < 4; ++r) { o0[r] += Ob[((((w * 2 + 0) * 8 + wave) * 4 + r) << 6) + lane] * f0; o1[r] += Ob[((((w * 2 + 1) * 8 + wave) * 4 + r) << 6) + lane] * f1; }
        }
        const float lam = att_lambda(p, lane);
        const f32x4 o = o0 * (1.f / L0) - o1 * (lam / L1);
        float ss = (o[0] * o[0] + o[1] * o[1]) + (o[2] * o[2] + o[3] * o[3]);
        ss += __shfl_xor(ss, 16); ss += __shfl_xor(ss, 32);
        LAS float* SS = ML + 8 * 4 * 64;
        SS[wave * 64 + lane] = ss;
        __syncthreads();
        float tot = 0.f;
#pragma unroll
        for (int w = 0; w < 8; ++w) tot += SS[w * 64 + lane];
        const float rs = 0.8f / sqrtf(tot * (1.f / 128.f) + EPS);
        const f32x4 gg = *(const f32x4*)(p.in(16) + 16 * wave + 4 * g);
        u32x2 wv; wv.x = pk2(o[0] * rs * gg[0], o[1] * rs * gg[1]); wv.y = pk2(o[2] * rs * gg[2], o[3] * rs * gg[3]);
        *(u32x2*)(qrow + 16 * wave + 4 * g) = wv;
    }
    __syncthreads();
}

template <int CTRL> __device__ __forceinline__ float dpp_add(float x) {
    return x + __builtin_bit_cast(float, __builtin_amdgcn_update_dpp(0, __builtin_bit_cast(int, x), CTRL, 0xf, 0xf, true));
}
__device__ __forceinline__ float sum16(float x) { x = dpp_add<0xB1>(x); x = dpp_add<0x4E>(x); x = dpp_add<0x141>(x); x = dpp_add<0x140>(x); return x; }
__device__ __forceinline__ float sum8(float x) { x = dpp_add<0xB1>(x); x = dpp_add<0x4E>(x); x = dpp_add<0x141>(x); return x; }
__device__ __forceinline__ void unpack4(const u32x2 w, float (&f)[4]) { f[0] = bflo(w.x); f[1] = bfhi(w.x); f[2] = bflo(w.y); f[3] = bfhi(w.y); }
__device__ __forceinline__ void zshift4(const Ctx& p, const bf16_t* ZRW, int row, int c, const float (&mu)[4], float (&o)[4]) {
    float z[4], pv[4];
    unpack4(*(const u32x2*)(ZRW + (size_t)row * SHW + c), z);
    bool first; int bsmp = 0;
    if (row < MPR) first = (row & (TP - 1)) == 0; else { first = ((row - MPR) & 15) == 0; bsmp = (row - MPR) >> 4; }
    if (!first) unpack4(*(const u32x2*)(ZRW + (size_t)(row - 1) * SHW + c), pv);
    else if (row < MPR) { pv[0] = 0.f; pv[1] = 0.f; pv[2] = 0.f; pv[3] = 0.f; }
    else { const f32x4 s0 = *(const f32x4*)(p.in(5) + (size_t)bsmp * SHW + c); pv[0] = s0[0]; pv[1] = s0[1]; pv[2] = s0[2]; pv[3] = s0[3]; }
#pragma unroll
    for (int e = 0; e < 4; ++e) o[e] = z[e] + (pv[e] - z[e]) * mu[e];
}
constexpr int SCH = 16, SBUF_F = SCH * (320 + 16), YP_F = SCH * 16 * 16;
struct ScanOps { f32x4 w, kk, ka, kp, rr; float v; };
__device__ __forceinline__ void scan_load(ScanOps& o, const LAS float* OP, const LAS float* VP, int t) {
    o.w = *(const LAS f32x4*)(OP + t * 320); o.kk = *(const LAS f32x4*)(OP + t * 320 + 64); o.ka = *(const LAS f32x4*)(OP + t * 320 + 128);
    o.kp = *(const LAS f32x4*)(OP + t * 320 + 192); o.rr = *(const LAS f32x4*)(OP + t * 320 + 256);
}
__device__ __forceinline__ void scan_step(f32x4& S, const ScanOps& o, LAS float* yp) {
    f32x2 S0 = {S[0], S[1]}, S1 = {S[2], S[3]};
    const f32x2 k0 = {o.kk[0], o.kk[1]}, k1 = {o.kk[2], o.kk[3]};
    f32x2 t = S0 * k0; t = S1 * k1 + t;
    const float sa = -sum16(t[0] + t[1]);
    const f32x2 sav = {sa, sa}, vv = {o.v, o.v};
    const f32x2 a0 = {o.ka[0], o.ka[1]}, a1 = {o.ka[2], o.ka[3]}, p0 = {o.kp[0], o.kp[1]}, p1 = {o.kp[2], o.kp[3]}, w0 = {o.w[0], o.w[1]}, w1 = {o.w[2], o.w[3]};
    f32x2 u0 = a0 * sav; u0 = p0 * vv + u0; S0 = S0 * w0 + u0;
    f32x2 u1 = a1 * sav; u1 = p1 * vv + u1; S1 = S1 * w1 + u1;
    const f32x2 r0 = {o.rr[0], o.rr[1]}, r1 = {o.rr[2], o.rr[3]};
    f32x2 y = S0 * r0; y = S1 * r1 + y;
    *yp = y[0] + y[1];
    S = (f32x4){S0[0], S0[1], S1[0], S1[1]};
}
__device__ __forceinline__ void scan_unit(const Ctx& p, int chain, int rq, LAS unsigned char* lds) {
    const int tid = threadIdx.x, lane = tid & 63, wave = __builtin_amdgcn_readfirstlane(tid >> 6);
    const bool smp = chain >= 32;
    const int cb = smp ? (chain - 32) >> 3 : chain >> 3, h = chain & 7, T = smp ? TS : TP, row0 = smp ? MPR + cb * TS : cb * TP;
    const int nch = T / SCH;
    const bf16_t* ZRW = (const bf16_t*)(p.ws() + WS_ZRW);
    const float* DEC = (const float*)(p.ws() + WS_DEC); const bf16_t* AB = (const bf16_t*)(p.ws() + WS_ABUF);
    bf16_t* ORW = (bf16_t*)(p.ws() + WS_ORW);
    LAS float* B0 = (LAS float*)lds; LAS float* YB = B0 + 2 * SBUF_F;
    __syncthreads();
    if (wave >= 4) {
        const int ht = tid - 256, tt = ht >> 4, cg4 = ht & 15, c0 = h * 64 + 4 * cg4;
        float mur[4], muk[4], muv[4], kkc[4], kac[4];
#pragma unroll
        for (int e = 0; e < 4; ++e) { mur[e] = p.in(17)[c0 + e]; muk[e] = p.in(17)[512 + c0 + e]; kkc[e] = p.in(23)[c0 + e]; kac[e] = p.in(24)[c0 + e]; }
        const int vc0 = h * 64 + 16 * rq + 4 * (cg4 & 3);
#pragma unroll
        for (int e = 0; e < 4; ++e) muv[e] = p.in(17)[1024 + vc0 + e];
        const bool hasv = cg4 < 4;
        struct HReg { u32x2 zr, zrp, zk, zkp, ab, zv, zvp; f32x4 dec; };
        auto issue = [&](HReg& R, int c) {
            const int row = row0 + c * SCH + tt, rp = row > 0 ? row - 1 : 0;
            R.zr = *(const u32x2*)(ZRW + (size_t)row * SHW + c0); R.zrp = *(const u32x2*)(ZRW + (size_t)rp * SHW + c0);
            R.zk = *(const u32x2*)(ZRW + (size_t)row * SHW + 512 + c0); R.zkp = *(const u32x2*)(ZRW + (size_t)rp * SHW + 512 + c0);
            R.ab = *(const u32x2*)(AB + (size_t)row * 512 + c0); R.dec = *(const f32x4*)(DEC + (size_t)row * 512 + c0);
            R.zv = (u32x2){0u, 0u}; R.zvp = (u32x2){0u, 0u};
            if (hasv) { R.zv = *(const u32x2*)(ZRW + (size_t)row * SHW + 1024 + vc0); R.zvp = *(const u32x2*)(ZRW + (size_t)rp * SHW + 1024 + vc0); }
        };
        auto commit = [&](const HReg& R, int c) {
            float zr[4], pr[4], zk[4], pk[4], a[4], zv[4], pv[4];
            unpack4(R.zr, zr); unpack4(R.zrp, pr); unpack4(R.zk, zk); unpack4(R.zkp, pk); unpack4(R.ab, a); unpack4(R.zv, zv); unpack4(R.zvp, pv);
            if (c == 0 && tt == 0) {
#pragma unroll
                for (int e = 0; e < 4; ++e) { pr[e] = 0.f; pk[e] = 0.f; pv[e] = 0.f; }
                if (smp) { const float* s0 = p.in(5) + (size_t)cb * SHW;
#pragma unroll
                    for (int e = 0; e < 4; ++e) { pr[e] = s0[c0 + e]; pk[e] = s0[512 + c0 + e]; pv[e] = s0[1024 + vc0 + e]; } }
            }
            float r[4], k[4], kk[4], n2 = 0.f;
#pragma unroll
            for (int e = 0; e < 4; ++e) { r[e] = zr[e] + (pr[e] - zr[e]) * mur[e]; k[e] = zk[e] + (pk[e] - zk[e]) * muk[e]; kk[e] = k[e] * kkc[e]; n2 += kk[e] * kk[e]; }
            n2 = sum16(n2);
            const float inv = __builtin_amdgcn_rsqf(fmaxf(n2, 1e-24f));
            float ka[4], kp[4];
#pragma unroll
            for (int e = 0; e < 4; ++e) { kk[e] *= inv; ka[e] = kk[e] * a[e]; kp[e] = k[e] * (1.f + (a[e] - 1.f) * kac[e]); }
            LAS float* OP = B0 + (c & 1) * SBUF_F + tt * 320 + 4 * cg4;
            *(LAS f32x4*)(OP) = R.dec;
            *(LAS f32x4*)(OP + 64) = (f32x4){kk[0], kk[1], kk[2], kk[3]};
            *(LAS f32x4*)(OP + 128) = (f32x4){ka[0], ka[1], ka[2], ka[3]};
            *(LAS f32x4*)(OP + 192) = (f32x4){kp[0], kp[1], kp[2], kp[3]};
            *(LAS f32x4*)(OP + 256) = (f32x4){r[0], r[1], r[2], r[3]};
            if (hasv) { LAS float* VW = B0 + (c & 1) * SBUF_F + SCH * 320 + (4 * cg4) * 16 + tt;
#pragma unroll
                for (int e = 0; e < 4; ++e) VW[e * 16] = zv[e] + (pv[e] - zv[e]) * muv[e]; }
        };
        auto yout = [&](int c) {
            const LAS float* Y = YB + (c & 1) * YP_F + (tt * 16 + cg4) * 16;
            const f32x4 y0 = *(const LAS f32x4*)Y, y1 = *(const LAS f32x4*)(Y + 4), y2 = *(const LAS f32x4*)(Y + 8), y3 = *(const LAS f32x4*)(Y + 12);
            const f32x4 ys = (y0 + y1) + (y2 + y3);
            ORW[(size_t)(row0 + c * SCH + tt) * 512 + h * 64 + 16 * rq + cg4] = f2bf((ys[0] + ys[1]) + (ys[2] + ys[3]));
        };
        HReg R0, R1;
        issue(R0, 0); if (nch > 1) issue(R1, 1);
        for (int ci = 0; ci <= nch; ci += 2) {
            if (ci < nch) { commit(R0, ci); if (ci + 2 < nch) issue(R0, ci + 2); }
            __syncthreads();
            if (ci > 0) yout(ci - 1);
            if (ci + 1 <= nch) {
                if (ci + 1 < nch) { commit(R1, ci + 1); if (ci + 3 < nch) issue(R1, ci + 3); }
                __syncthreads();
                yout(ci);
            }
        }
    } else {
        const int rl = lane >> 4, cl = lane & 15, il = 4 * wave + rl;
        f32x4 S;
        float* sg = (smp ? p.out() + O_SS : p.out() + O_SP) + ((size_t)(cb * 8 + h) * 64 + 16 * rq + il) * 64 + 4 * cl;
        if (smp) S = *(const f32x4*)(p.in(4) + ((size_t)(cb * 8 + h) * 64 + 16 * rq + il) * 64 + 4 * cl); else S = (f32x4){0.f, 0.f, 0.f, 0.f};
        for (int ci = 0; ci < nch; ++ci) {
            __syncthreads();
            const LAS float* OP = B0 + (ci & 1) * SBUF_F + 4 * cl;
            const LAS float* VP = B0 + (ci & 1) * SBUF_F + SCH * 320 + il * 16;
            LAS float* Y = YB + (ci & 1) * YP_F + il * 16 + cl;
            ScanOps oa, ob;
            scan_load(oa, OP, VP, 0);
            f32x2 vv = *(const LAS f32x2*)VP;
#pragma unroll 1
            for (int t = 0; t < SCH; t += 2) {
                scan_load(ob, OP, VP, t + 1);
                oa.v = vv[0]; ob.v = vv[1];
                scan_step(S, oa, Y + t * 256);
                scan_load(oa, OP, VP, (t + 2) & (SCH - 1));
                vv = *(const LAS f32x2*)(VP + ((t + 2) & (SCH - 1)));
                scan_step(S, ob, Y + (t + 1) * 256);
            }
        }
        __syncthreads();
        *(f32x4*)sg = S;
    }
}
__device__ __forceinline__ void phase_lnpass(const Ctx& p) {
    const int tid = threadIdx.x, c8 = tid & 7, h = (tid >> 3) & 7, rr = tid >> 6, c = h * 64 + 8 * c8;
    const bf16_t* ZRW = (const bf16_t*)(p.ws() + WS_ZRW); const bf16_t* AB = (const bf16_t*)(p.ws() + WS_ABUF); const bf16_t* GG = (const bf16_t*)(p.ws() + WS_GG);
    bf16_t* ORW = (bf16_t*)(p.ws() + WS_ORW);
    float mur[8], muk[8], muv[8], kac[8], rkc[8], lg[8], lb[8];
#pragma unroll
    for (int e = 0; e < 8; ++e) { mur[e] = p.in(17)[c + e]; muk[e] = p.in(17)[512 + c + e]; muv[e] = p.in(17)[1024 + c + e]; kac[e] = p.in(24)[c + e]; rkc[e] = p.in(25)[c + e]; lg[e] = p.in(26)[c + e]; lb[e] = p.in(27)[c + e]; }
    for (int it = blockIdx.x; it < MR / 8; it += gridDim.x) {
        const int row = it * 8 + rr;
        float r[8], k[8], v[8], a[8], g[8], y[8];
        zshift8(p, ZRW, row, c, mur, r); zshift8(p, ZRW, row, 512 + c, muk, k); zshift8(p, ZRW, row, 1024 + c, muv, v);
        unpack8(*(const u32x4*)(AB + (size_t)row * 512 + c), a); unpack8(*(const u32x4*)(GG + (size_t)row * 512 + c), g); unpack8(*(const u32x4*)(ORW + (size_t)row * 512 + c), y);
        float bon = 0.f, sy = 0.f;
#pragma unroll
        for (int e = 0; e < 8; ++e) { const float kp = k[e] * (1.f + (a[e] - 1.f) * kac[e]); bon += r[e] * kp * rkc[e]; sy += y[e]; }
        bon = sum8(bon);
        const float mu = sum8(sy) * (1.f / 64.f);
        float var = 0.f;
#pragma unroll
        for (int e = 0; e < 8; ++e) { y[e] -= mu; var += y[e] * y[e]; }
        var = sum8(var) * (1.f / 64.f);
        const float rs = 1.f / sqrtf(var + LNX_EPS);
        float o[8];
#pragma unroll
        for (int e = 0; e < 8; ++e) o[e] = (y[e] * rs * lg[e] + lb[e] + bon * v[e]) * g[e];
        u32x4 w; w.x = pk2(o[0], o[1]); w.y = pk2(o[2], o[3]); w.z = pk2(o[4], o[5]); w.w = pk2(o[6], o[7]);
        *(u32x4*)(ORW + (size_t)row * 512 + c) = w;
    }
}

__device__ __forceinline__ void ffn2_weights(const Ctx& p, LAS unsigned char* lds) {
    const int tid = threadIdx.x, lane = tid & 63, wave = __builtin_amdgcn_readfirstlane(tid >> 6);
    unsigned char* ws = p.ws();
    LAS float* scr = (LAS float*)(lds + wave * 16384);
    constexpr int I7 = 16 * 176, I8 = 44 * 32;
    __syncthreads();
    for (int it = ((int)blockIdx.x - 128) * 8 + wave; it < I7 + I8; it += 128 * 8) {
        int r = it;
        if (r < I7) { const int kb = r / 176, nb = r % 176; transpose_item(p.in(33), DM, NFF, (bf16_t*)(ws + WS_W3T), 64 * kb, 32 * nb, map_w1(32 * nb), scr, lane); continue; } r -= I7;
        { const int kb = r / 32, nb = r % 32; transpose_item(p.in(34), DFF, DM, (bf16_t*)(ws + WS_W4T), 64 * kb, 32 * nb, 32 * nb, scr, lane); }
    }
}
__device__ __forceinline__ void phase_mixer(const Ctx& p, LAS unsigned char* lds) {
    if (blockIdx.x < 128) scan_unit(p, blockIdx.x >> 2, blockIdx.x & 3, lds);
    else { const int u0 = (blockIdx.x - 128) * 2; scan_unit(p, 32 + (u0 >> 2), u0 & 3, lds); scan_unit(p, 32 + ((u0 + 1) >> 2), (u0 + 1) & 3, lds); }
    if (blockIdx.x < 128) return;
    unsigned* ctr = (unsigned*)(p.ws() + WS_CTR);
    LAS unsigned* su = (LAS unsigned*)(lds + 140 * 1024);
    for (;;) {
        __syncthreads();
        if (threadIdx.x == 0) su[0] = atomicAdd(ctr, 1u);
        __syncthreads();
        const int u = __builtin_amdgcn_readfirstlane((int)su[0]);
        if (u >= 32) break;
        att_sample_unit(p, u >> 2, u & 3, lds);
    }
    for (;;) {
        __syncthreads();
        if (threadIdx.x == 0) su[0] = atomicAdd(ctr + 1, 1u);
        __syncthreads();
        const int v = __builtin_amdgcn_readfirstlane((int)su[0]);
        if (v >= 512) break;
        att_prompt_unit(p, v & 15, 31 - (v >> 4), lds);
    }
    ffn2_weights(p, lds);
}

constexpr int LDS_BYTES = 147456;
constexpr int NPHASE = 15;
#ifndef SINGLE_LAUNCH
#define SINGLE_LAUNCH 1
#endif

#define XB_TMO      128
#define XB_XCNT(j)  (256  + 64 * (j))
#define XB_XSUB(j)  (1280 + 64 * (j))
#define XB_XGEN(j)  (2304 + 64 * (j))
#define XB_TOP      3328
#define XB_TOPGEN   3392
#define XCD_BAR_WORDS 3456
#define XB_SPIN_CAP (1u << 18)

__device__ __forceinline__ unsigned xb_ld(unsigned* p)              { return __hip_atomic_load(p, __ATOMIC_RELAXED, __HIP_MEMORY_SCOPE_AGENT); }
__device__ __forceinline__ unsigned xb_add(unsigned* p, unsigned v) { return __hip_atomic_fetch_add(p, v, __ATOMIC_RELAXED, __HIP_MEMORY_SCOPE_AGENT); }
__device__ __forceinline__ unsigned xb_xcc_id() { return (unsigned)__builtin_amdgcn_s_getreg((3 << 11) | 20) & 0xFu; }
#define XB_SPIN(cond, bar) do { unsigned _sp = 0; while (cond) { __builtin_amdgcn_s_sleep(1); \
    if ((++_sp & 255u) == 0u) { if (xb_ld(&(bar)[XB_TMO])) break; if (_sp > XB_SPIN_CAP) { atomicAdd(&(bar)[XB_TMO], 1u); break; } } } } while (0)

struct XcdBarrier {
    unsigned* bar; unsigned x;
    volatile LAS unsigned* st;
};

__device__ __forceinline__ XcdBarrier xcd_barrier_post(unsigned* bar, volatile LAS unsigned* st) {
    XcdBarrier b; b.bar = bar; b.x = xb_xcc_id(); b.st = st;
    if (threadIdx.x == 0) (void)xb_add(&bar[XB_XCNT(b.x)], 1u);
    return b;
}
__device__ __forceinline__ void xcd_barrier_complete(unsigned* bar, unsigned x, unsigned& nloc, unsigned& nx) {
    const unsigned G = gridDim.x * gridDim.y * gridDim.z;
    unsigned sum, cnt, mine, sp = 0u;
    for (;;) {
        sum = 0u; cnt = 0u; mine = 0u;
#pragma unroll
        for (unsigned j = 0; j < 16; ++j) { const unsigned c = xb_ld(&bar[XB_XCNT(j)]); sum += c; cnt += (c > 0u) ? 1u : 0u; mine = (j == x) ? c : mine; }
        if (sum == G) break;
        __builtin_amdgcn_s_sleep(1);
        if ((++sp & 255u) == 0u) { if (xb_ld(&bar[XB_TMO])) break; if (sp > XB_SPIN_CAP) { atomicAdd(&bar[XB_TMO], 1u); break; } }
    }
    nloc = mine > 0u ? mine : 1u; nx = cnt > 0u ? cnt : 1u;
}

__device__ __forceinline__ void xcd_barrier(const XcdBarrier& b) {
    asm volatile("s_waitcnt vmcnt(0)" ::: "memory");
    __syncthreads();
    if (threadIdx.x == 0) {
        unsigned* bar = b.bar;
        __builtin_amdgcn_s_waitcnt(0);
        unsigned nloc = b.st[0], nx = b.st[1];
        if (nloc == 0u) { xcd_barrier_complete(bar, b.x, nloc, nx); b.st[0] = nloc; b.st[1] = nx; }
        const unsigned old = xb_add(&bar[XB_XSUB(b.x)], 1u);
        const unsigned gen = old / nloc;
        if (old + 1u == (gen + 1u) * nloc) {
            __builtin_amdgcn_fence(__ATOMIC_RELEASE, "agent");
            asm volatile("s_waitcnt vmcnt(0)" ::: "memory");
            const unsigned og = xb_add(&bar[XB_TOP], 1u);
            const unsigned tg = og / nx;
            if (og + 1u == (tg + 1u) * nx) xb_add(&bar[XB_TOPGEN], 1u);
            else XB_SPIN(xb_ld(&bar[XB_TOPGEN]) == tg, bar);
            __builtin_amdgcn_fence(__ATOMIC_ACQUIRE, "agent");
            xb_add(&bar[XB_XGEN(b.x)], 1u);
            asm volatile("s_waitcnt vmcnt(0)" ::: "memory");
        } else {
            XB_SPIN(xb_ld(&bar[XB_XGEN(b.x)]) == gen, bar);
            __builtin_amdgcn_fence(__ATOMIC_ACQUIRE, "agent");
            asm volatile("s_waitcnt vmcnt(0)" ::: "memory");
        }
    }
    __syncthreads();
}

__device__ __forceinline__ void grid_bar(const Ctx& p, unsigned k) {
    asm volatile("s_waitcnt vmcnt(0)" ::: "memory");
    __syncthreads();
    if (threadIdx.x == 0) {
        unsigned* ctr = (unsigned*)(p.ws() + WS_CTR) + 64;
        __builtin_amdgcn_fence(__ATOMIC_RELEASE, "agent");
        asm volatile("s_waitcnt vmcnt(0)" ::: "memory");
        __hip_atomic_fetch_add(ctr, 1u, __ATOMIC_RELAXED, __HIP_MEMORY_SCOPE_AGENT);
        const unsigned target = k * gridDim.x;
        while (__hip_atomic_load(ctr, __ATOMIC_RELAXED, __HIP_MEMORY_SCOPE_AGENT) < target) __builtin_amdgcn_s_sleep(1);
        __builtin_amdgcn_fence(__ATOMIC_ACQUIRE, "agent");
        asm volatile("s_waitcnt vmcnt(0)" ::: "memory");
    }
    __syncthreads();
}
__device__ __forceinline__ void sub_barrier(const Ctx& p, unsigned n) {
    asm volatile("s_waitcnt vmcnt(0)" ::: "memory");
    __syncthreads();
    if (threadIdx.x == 0) {
        unsigned* c = (unsigned*)(p.ws() + WS_CTR) + 128;
        __builtin_amdgcn_fence(__ATOMIC_RELEASE, "agent");
        asm volatile("s_waitcnt vmcnt(0)" ::: "memory");
        __hip_atomic_fetch_add(c, 1u, __ATOMIC_RELAXED, __HIP_MEMORY_SCOPE_AGENT);
        while (__hip_atomic_load(c, __ATOMIC_RELAXED, __HIP_MEMORY_SCOPE_AGENT) < n) __builtin_amdgcn_s_sleep(2);
        __builtin_amdgcn_fence(__ATOMIC_ACQUIRE, "agent");
        asm volatile("s_waitcnt vmcnt(0)" ::: "memory");
    }
    __syncthreads();
}
template <class Epi> __device__ __forceinline__ void run_gemm(LAS unsigned char* lds, const bf16_t* A, const bf16_t* Bt, int N, int K, const Epi& E, int M = MP) {
    pg8::Gemm g{A, Bt, M, N, K, K}; pg8::StaticOrder S; S.init(M, N, (int)gridDim.x, (int)blockIdx.x);
    pg8::gemm_phase<Epi, pg8::StaticOrder, true, true>(lds, g, S, E);
}
struct OneUnit { int pn; bool on;
    __device__ __forceinline__ bool next(int i, pg8::Unit& u) const { if (i > 0 || !on) return false; u.pm = 0; u.pn = pn; return true; }
    __device__ __forceinline__ void a_ready(const pg8::Unit&) const {}
    __device__ __forceinline__ void done(const pg8::Unit&) const {} };
struct EpiPart {
    static constexpr bool PERM = false, AFTER_DRAIN = false;
    float* O;
    __device__ __forceinline__ void operator()(const f32x4 (&acc)[2][2][4][2], const Unit& u, int wr, int wc, int fr, int fq) const {
        const int col0 = u.pn * 256 + wc * 32 + 4 * fq;
#pragma unroll
        for (int m = 0; m < 4; ++m) {
            const int row = wr * 64 + m * 16 + fr;
#pragma unroll
            for (int bj = 0; bj < 2; ++bj)
#pragma unroll
                for (int n = 0; n < 2; ++n) *(f32x4*)(O + (size_t)row * DM + col0 + bj * 128 + n * 16) = acc[0][bj][m][n];
            asm volatile("" ::: "memory");
        }
    }
};
constexpr size_t WS_PART = 240 * MiB;
constexpr int KSL = 256;
__device__ __forceinline__ void run_gemm_sample(LAS unsigned char* lds, const bf16_t* A, const bf16_t* Bt, int K, float* PART) {
    const int c = (int)blockIdx.x, ns = K / KSL, ks = c >> 2;
    OneUnit S{c & 3, c < 4 * ns};
    pg8::Gemm g{A + (size_t)MPR * K + (size_t)ks * KSL, Bt + (size_t)ks * KSL, 256, DM, KSL, K};
    EpiPart E{PART + (size_t)ks * 128 * DM};
    pg8::gemm_phase<EpiPart, OneUnit, false, true>(lds, g, S, E);
}

__global__ void __launch_bounds__(512) fwd_kernel(Params prm) {
    extern __shared__ __attribute__((aligned(16))) unsigned char lds_raw[];
    LAS unsigned char* lds = (LAS unsigned char*)lds_raw;
    cg::grid_group grid = cg::this_grid();
    const int lo = prm.ph_lo, hi = prm.ph_hi;
    {   LAS unsigned long long* tab = (LAS unsigned long long*)(lds + 141 * 1024);
        if (threadIdx.x < 36) tab[threadIdx.x] = (unsigned long long)prm.in[threadIdx.x];
        if (threadIdx.x == 36) tab[36] = (unsigned long long)prm.out;
        if (threadIdx.x == 37) tab[37] = (unsigned long long)prm.ws;
        __syncthreads(); }
    Ctx p{(const LAS unsigned*)(lds + 141 * 1024)};
volatile LAS unsigned* bst = (volatile LAS unsigned*)(lds + 142 * 1024);
    if (threadIdx.x < 2) bst[threadIdx.x] = 0u;
    __syncthreads();
    XcdBarrier bar = xcd_barrier_post((unsigned*)(p.ws() + WS_CTR) + 1024, bst);
#define ws (p.ws())
#define IN(k) (lo <= (k) && (k) < hi)
#define SEAM(k) do { if (IN(k) && IN((k) + 1)) xcd_barrier(bar); } while (0)
    unsigned nbar = 0;
    if (IN(0)) { phase_prologue(p, lds); } if (IN(0) && IN(1)) grid.sync();
    if (IN(1)) { EpiSwiglu E{(bf16_t*)(ws + WS_G)}; run_gemm(lds, (const bf16_t*)(ws + WS_XN), (const bf16_t*)(ws + WS_W1T), NFF, DM, E);
        { constexpr int NFULL = (MP / 256) * (NFF / 256) - 5 * 256;
          if ((int)blockIdx.x >= NFULL) prologue_part2(p, lds, (int)blockIdx.x - NFULL, 256 - NFULL); } } SEAM(1);
    if (IN(2)) { EpiF32 E{(float*)(ws + WS_F)}; run_gemm(lds, (const bf16_t*)(ws + WS_G), (const bf16_t*)(ws + WS_W2T), DM, DFF, E, MPR); run_gemm_sample(lds, (const bf16_t*)(ws + WS_G), (const bf16_t*)(ws + WS_W2T), DFF, (float*)(ws + WS_PART)); } SEAM(2);
    if (IN(3)) { phase_rowpass(p, (const float*)(ws + WS_F), 1, 0.5f, p.in(9), p.in(10), (bf16_t*)(ws + WS_XN), (const float*)(ws + WS_PART), DFF / KSL); } SEAM(3);
    if (IN(4)) { EpiZ E{p.out(), (bf16_t*)(ws + WS_QB), (bf16_t*)(ws + WS_KB), (bf16_t*)(ws + WS_VT), (bf16_t*)(ws + WS_ZRW), (bf16_t*)(ws + WS_GATE), (const f32x2*)(ws + WS_TAB)};
        run_gemm(lds, (const bf16_t*)(ws + WS_XN), (const bf16_t*)(ws + WS_WINT), INW, DM, E); } SEAM(4);
    if (IN(5)) { phase_lora(p, lds); } SEAM(5);
    if (IN(6)) { phase_mixer(p, lds);
        if (blockIdx.x >= 128) {
            sub_barrier(p, 128u);
            EpiGate1 E{(bf16_t*)(ws + WS_KB), (const bf16_t*)(ws + WS_GATE)};
            pg8::Gemm g{(const bf16_t*)(ws + WS_QB), (const bf16_t*)(ws + WS_WAT), MP, DM, 512, 512}; pg8::StaticOrder S; S.init(MP, DM, 128, (int)blockIdx.x - 128);
            pg8::gemm_phase<EpiGate1, pg8::StaticOrder, true, true>(lds, g, S, E);
        } } SEAM(6);
    if (IN(14)) { phase_lnpass(p); } if (IN(14) && IN(7)) xcd_barrier(bar);
    if (IN(8)) { EpiGate2 E{(const bf16_t*)(ws + WS_KB), (const bf16_t*)(ws + WS_GATE), (bf16_t*)(ws + WS_MG)}; run_gemm(lds, (const bf16_t*)(ws + WS_ORW), (const bf16_t*)(ws + WS_WRT), DM, 512, E); } SEAM(8);
    if (IN(9)) { EpiF32 E{(float*)(ws + WS_T)}; run_gemm(lds, (const bf16_t*)(ws + WS_MG), (const bf16_t*)(ws + WS_WOT), DM, DM, E, MPR); run_gemm_sample(lds, (const bf16_t*)(ws + WS_MG), (const bf16_t*)(ws + WS_WOT), DM, (float*)(ws + WS_PART)); } SEAM(9);
    if (IN(10)) { phase_rowpass(p, (const float*)(ws + WS_T), 0, 1.0f, p.in(31), p.in(32), (bf16_t*)(ws + WS_XN), (const float*)(ws + WS_PART), DM / KSL); } SEAM(10);
    if (IN(11)) { EpiSwiglu E{(bf16_t*)(ws + WS_G)}; run_gemm(lds, (const bf16_t*)(ws + WS_XN), (const bf16_t*)(ws + WS_W3T), NFF, DM, E); } SEAM(11);
    if (IN(12)) { EpiF32 E{(float*)(ws + WS_F)}; run_gemm(lds, (const bf16_t*)(ws + WS_G), (const bf16_t*)(ws + WS_W4T), DM, DFF, E, MPR); run_gemm_sample(lds, (const bf16_t*)(ws + WS_G), (const bf16_t*)(ws + WS_W4T), DFF, (float*)(ws + WS_PART)); } SEAM(12);
    if (IN(13)) { phase_rowpass(p, (const float*)(ws + WS_F), 0, 0.5f, p.in(35), nullptr, nullptr, (const float*)(ws + WS_PART), DFF / KSL); }
#undef IN
#undef SEAM
#undef ws
}

extern "C" void kernel_launch(void* const* d_in, const int* in_sizes, int n_in, void* d_out, int out_size, void* d_ws, size_t ws_size, hipStream_t stream) {
    static int grid = 0;
    if (grid == 0) {
        int dev = 0, cus = 0, per_cu = 0;
        (void)hipGetDevice(&dev);
        (void)hipDeviceGetAttribute(&cus, hipDeviceAttributeMultiprocessorCount, dev);
        (void)hipFuncSetAttribute((const void*)fwd_kernel, hipFuncAttributeMaxDynamicSharedMemorySize, LDS_BYTES);
        if (hipOccupancyMaxActiveBlocksPerMultiprocessor(&per_cu, (const void*)fwd_kernel, 512, LDS_BYTES) != hipSuccess || per_cu < 1) per_cu = 1;
        (void)hipGetLastError();
        grid = cus * per_cu;
        if (grid <= 0) grid = 256;
        if (n_in != 36 || (size_t)out_size != O_END || ws_size < WS_NEED) { fprintf(stderr, "kernel_launch: unexpected sizes n_in %d out %d ws %zu (need %zu)\n", n_in, out_size, ws_size, (size_t)WS_NEED); grid = -1; }
    }
    if (grid < 0) return;
    Params p{};
    for (int i = 0; i < 36; ++i) p.in[i] = (const float*)d_in[i];
    p.out = (float*)d_out; p.ws = (unsigned char*)d_ws;
    (void)hipMemsetAsync((unsigned char*)d_ws + WS_CTR, 0, 4096 + 3456 * 4, stream);
#if SINGLE_LAUNCH
    p.ph_lo = 0; p.ph_hi = NPHASE;
    void* args[] = {&p};
    hipError_t e = hipLaunchCooperativeKernel((const void*)fwd_kernel, dim3(grid), dim3(512), args, LDS_BYTES, stream);
    if (e != hipSuccess) fprintf(stderr, "cooperative launch failed: %s (grid %d)\n", hipGetErrorString(e), grid);
#else
    for (int ph = 0; ph < NPHASE; ++ph) { p.ph_lo = ph; p.ph_hi = ph + 1; hipLaunchKernelGGL(fwd_kernel, dim3(grid), dim3(512), LDS_BYTES, stream, p); }
#endif
}
```

```cpp
#include <hip/hip_runtime.h>
#include <hip/hip_cooperative_groups.h>
#include <cstdio>
#include <cstdint>
namespace cg = cooperative_groups;
namespace pg8 {
#define PG8_LAS __attribute__((address_space(3)))
typedef unsigned short bf16_t;
typedef short bf16x8 __attribute__((ext_vector_type(8)));
typedef float f32x4 __attribute__((ext_vector_type(4)));
typedef unsigned u32x4 __attribute__((ext_vector_type(4)));
constexpr int BM = 256, BK = 64, HALF = 128, HTB = HALF * BK * 2  , STAGE_BYTES = 8 * HTB, NXCD = 8, WGM = 8;

__host__ __device__ __forceinline__ int lds_byte(int r, int c) { const int st = (r >> 4) * 2 + (c >> 5), rr = r & 15, cc = c & 31, ob = rr * 64 + cc * 2; return st * 1024 + (ob ^ (((ob >> 9) & 1) << 5)); }
__host__ __device__ __forceinline__ void stage_rc(int b, int& R, int& C) { const int st = b / 1024, sb = b % 1024, swz = sb ^ (((sb >> 9) & 1) << 5); R = (st >> 1) * 16 + swz / 64; C = (st & 1) * 32 + (swz % 64) / 2; }
__host__ __device__ __forceinline__ int perm32(int rho) { const int n = rho >> 4, i = rho & 15; return 8 * (i >> 2) + 4 * n + (i & 3); }

struct Unit { int pm, pn; };
struct Gemm { const bf16_t* A; const bf16_t* Bt; int M, N, K, ld; };

struct StaticOrder {
    int nM, nN, nwg, G, c;
    __host__ __device__ void init(int M, int N, int G_, int c_) { nM = M / BM; nN = N / BM; nwg = nM * nN; G = G_; c = c_; }
    __host__ __device__ bool next(int i, Unit& u) const {
        const long L = (long)i * G + c; if (L >= nwg) return false;
        int wgid = (int)L; { const int q = nwg / NXCD, r = nwg % NXCD, xcd = wgid % NXCD, off = wgid / NXCD; wgid = (xcd < r ? xcd * (q + 1) : r * (q + 1) + (xcd - r) * q) + off; }
        const int nig = WGM * nN, gid = wgid / nig, fm = gid * WGM, gsz = (nM - fm) < WGM ? (nM - fm) : WGM;
        u.pm = fm + ((wgid % nig) % gsz); u.pn = (wgid % nig) / gsz; return true;
    }
    __device__ __forceinline__ void a_ready(const Unit&) const {}
    __device__ __forceinline__ void done(const Unit&) const {}
};

__device__ __forceinline__ unsigned cvt_pk_bf16(float lo, float hi) { unsigned r; asm volatile("v_cvt_pk_bf16_f32 %0, %1, %2" : "=v"(r) : "v"(lo), "v"(hi)); return r; }
typedef float f32x2 __attribute__((ext_vector_type(2)));
template <class Epi, class Sched, bool ALIGN_EPI = false, bool SP2 = false>
__device__ __forceinline__ void gemm_phase(PG8_LAS unsigned char* lds, const Gemm g, const Sched& S, const Epi& E) {
    const int tid = threadIdx.x, wid = __builtin_amdgcn_readfirstlane(tid >> 6), lane = tid & 63, wr = wid >> 2, wc = wid & 3, fr = lane & 15, fq = lane >> 4;
    const int K = g.K, nt = K / BK;
    unsigned voffA[2], voffB[2];
#pragma unroll
    for (int i = 0; i < 2; ++i) { int R, C; stage_rc(tid * 16 + i * 8192, R, C); const int Rb = Epi::PERM ? ((R & ~31) + perm32(R & 31)) : R;
        voffA[i] = (unsigned)(R * g.ld + C) * 2u; voffB[i] = (unsigned)(Rb * g.ld + C) * 2u; }
    const size_t kstep = (size_t)(BK * 2);
    const size_t hstep = (size_t)HALF * g.ld * 2;
    const size_t tstep = 2 * hstep;
    const unsigned ldsw = (unsigned)wid * 1024u;
    const int aoff = lds_byte(wr * 64 + fr, fq * 8), boff = lds_byte(wc * 32 + fr, fq * 8);
#define PG8_SA(b, h) (((b) * 2 + (h)) * HTB)
#define PG8_SB(b, h) ((4 + (b) * 2 + (h)) * HTB)
#define PG8_STAGE(bufoff, gbase, voff) do { _Pragma("unroll") for (int _i = 0; _i < 2; ++_i) \
        __builtin_amdgcn_global_load_lds((const unsigned*)((const char*)(gbase) + (voff)[_i]), (PG8_LAS unsigned*)(lds + (bufoff) + ldsw + _i * 8192), 16, 0, 0); } while (0)
#define PG8_LDA(dst, b, h) do { _Pragma("unroll") for (int m = 0; m < 4; ++m) _Pragma("unroll") for (int k = 0; k < 2; ++k) dst[m][k] = *(const PG8_LAS bf16x8*)(lds + PG8_SA(b, h) + aoff + m * 2048 + k * 1024); } while (0)
#define PG8_LDB(dst, b, h) do { _Pragma("unroll") for (int n = 0; n < 2; ++n) _Pragma("unroll") for (int k = 0; k < 2; ++k) dst[n][k] = *(const PG8_LAS bf16x8*)(lds + PG8_SB(b, h) + boff + n * 2048 + k * 1024); } while (0)
#define PG8_MMA(ai, bj, At, Bt) do { __builtin_amdgcn_s_setprio(1); _Pragma("unroll") for (int m = 0; m < 4; ++m) _Pragma("unroll") for (int n = 0; n < 2; ++n) _Pragma("unroll") for (int k = 0; k < 2; ++k) \
        acc[ai][bj][m][n] = __builtin_amdgcn_mfma_f32_16x16x32_bf16(Bt[n][k], At[m][k], acc[ai][bj][m][n], 0, 0, 0); __builtin_amdgcn_s_setprio(0); } while (0)
#define PG8_WAIT_V(n) asm volatile("s_waitcnt vmcnt(" #n ")" ::: "memory")
#define PG8_WAIT_L(n) asm volatile("s_waitcnt lgkmcnt(" #n ")" ::: "memory")
#define PG8_BAR __builtin_amdgcn_s_barrier()
#define PG8_SCHED __builtin_amdgcn_sched_barrier(0)
    Unit cur, nxt; int ui = 0;
    if (!S.next(0, cur)) return;
    f32x4 acc[2][2][4][2];
#pragma unroll
    for (int a = 0; a < 2; ++a)
#pragma unroll
        for (int b = 0; b < 2; ++b)
#pragma unroll
            for (int m = 0; m < 4; ++m)
#pragma unroll
                for (int n = 0; n < 2; ++n) acc[a][b][m][n] = (f32x4){0.f, 0.f, 0.f, 0.f};
    bf16x8 At[4][2], B0[2][2], B1[2][2];
    const char* cA = (const char*)g.A + (size_t)cur.pm * tstep; const char* cB = (const char*)g.Bt + (size_t)cur.pn * tstep;
    S.a_ready(cur);
    if constexpr (SP2) {
        PG8_STAGE(PG8_SB(0, 0), cB, voffB); PG8_STAGE(PG8_SB(0, 1), cB + hstep, voffB); PG8_STAGE(PG8_SA(0, 0), cA, voffA); PG8_STAGE(PG8_SA(0, 1), cA + hstep, voffA);
        if (wr == 1) PG8_BAR;
        PG8_WAIT_V(2); PG8_BAR;
        PG8_STAGE(PG8_SB(1, 0), cB + kstep, voffB); PG8_STAGE(PG8_SA(1, 0), cA + kstep, voffA); PG8_STAGE(PG8_SB(1, 1), cB + hstep + kstep, voffB);
        PG8_WAIT_V(6); PG8_BAR;
    } else {
        PG8_STAGE(PG8_SB(0, 0), cB, voffB); PG8_STAGE(PG8_SA(0, 0), cA, voffA); PG8_STAGE(PG8_SB(0, 1), cB + hstep, voffB); PG8_STAGE(PG8_SA(0, 1), cA + hstep, voffA);
        if (wr == 1) PG8_BAR;
        PG8_WAIT_V(4); PG8_BAR;
        PG8_STAGE(PG8_SB(1, 0), cB + kstep, voffB); PG8_STAGE(PG8_SA(1, 0), cA + kstep, voffA); PG8_STAGE(PG8_SB(1, 1), cB + hstep + kstep, voffB);
        PG8_WAIT_V(6); PG8_BAR;
    }
    for (;;) {
        const bool has_next = S.next(ui + 1, nxt);
        const char* nA = has_next ? (const char*)g.A + (size_t)nxt.pm * tstep : cA; const char* nB = has_next ? (const char*)g.Bt + (size_t)nxt.pn * tstep : cB;
        for (int t = 0; t < nt; t += 2) {
            const bool last = (t == nt - 2);
            const char* a1 = cA + (size_t)(t + 1) * kstep;
            const char* a2 = last ? nA : cA + (size_t)(t + 2) * kstep; const char* b2 = last ? nB : cB + (size_t)(t + 2) * kstep;
            const char* a3 = a2 + kstep; const char* b3 = b2 + kstep;
            if (last && has_next) S.a_ready(nxt);
            if constexpr (SP2) {
            PG8_LDB(B0, 0, 0); PG8_LDB(B1, 0, 1); PG8_SCHED; PG8_LDA(At, 0, 0); PG8_STAGE(PG8_SA(1, 1), a1 + hstep, voffA);
            PG8_WAIT_V(8); PG8_WAIT_L(0); PG8_BAR; PG8_MMA(0, 0, At, B0); PG8_MMA(0, 1, At, B1); PG8_BAR; PG8_SCHED;
            PG8_LDA(At, 0, 1); PG8_STAGE(PG8_SB(0, 0), b2, voffB); PG8_STAGE(PG8_SB(0, 1), b2 + hstep, voffB); PG8_STAGE(PG8_SA(0, 0), a2, voffA);
            PG8_WAIT_V(8); PG8_WAIT_L(0); PG8_BAR; PG8_MMA(1, 0, At, B0); PG8_MMA(1, 1, At, B1); PG8_BAR; PG8_SCHED;
            PG8_LDB(B0, 1, 0); PG8_LDB(B1, 1, 1); PG8_SCHED; PG8_LDA(At, 1, 0); PG8_STAGE(PG8_SA(0, 1), a2 + hstep, voffA);
            PG8_WAIT_V(8); PG8_WAIT_L(0); PG8_BAR; PG8_MMA(0, 0, At, B0); PG8_MMA(0, 1, At, B1); PG8_BAR; PG8_SCHED;
            PG8_LDA(At, 1, 1); PG8_STAGE(PG8_SB(1, 0), b3, voffB); PG8_STAGE(PG8_SB(1, 1), b3 + hstep, voffB); PG8_STAGE(PG8_SA(1, 0), a3, voffA);
            PG8_WAIT_V(8); PG8_WAIT_L(0); PG8_BAR; PG8_MMA(1, 0, At, B0); PG8_MMA(1, 1, At, B1); PG8_BAR; PG8_SCHED;
            } else {
            PG8_LDB(B0, 0, 0); PG8_SCHED; PG8_LDA(At, 0, 0); PG8_STAGE(PG8_SA(1, 1), a1 + hstep, voffA);
            PG8_WAIT_L(8); PG8_BAR; PG8_WAIT_L(0); PG8_MMA(0, 0, At, B0); PG8_BAR; PG8_SCHED;
            PG8_LDB(B1, 0, 1); PG8_STAGE(PG8_SB(0, 0), b2, voffB);
            PG8_BAR; PG8_WAIT_L(0); PG8_MMA(0, 1, At, B1); PG8_BAR;
            PG8_LDA(At, 0, 1); PG8_STAGE(PG8_SA(0, 0), a2, voffA);
            PG8_BAR; PG8_WAIT_L(0); PG8_MMA(1, 0, At, B0); PG8_BAR; PG8_SCHED;
            PG8_STAGE(PG8_SB(0, 1), b2 + hstep, voffB);
            PG8_WAIT_V(6); PG8_BAR; PG8_MMA(1, 1, At, B1); PG8_BAR;
            PG8_LDB(B0, 1, 0); PG8_SCHED; PG8_LDA(At, 1, 0); PG8_STAGE(PG8_SA(0, 1), a2 + hstep, voffA);
            PG8_WAIT_L(8); PG8_BAR; PG8_WAIT_L(0); PG8_MMA(0, 0, At, B0); PG8_BAR; PG8_SCHED;
            PG8_LDB(B1, 1, 1); PG8_STAGE(PG8_SB(1, 0), b3, voffB);
            PG8_BAR; PG8_WAIT_L(0); PG8_MMA(0, 1, At, B1); PG8_BAR;
            PG8_LDA(At, 1, 1); PG8_STAGE(PG8_SA(1, 0), a3, voffA);
            PG8_BAR; PG8_WAIT_L(0); PG8_MMA(1, 0, At, B0); PG8_BAR; PG8_SCHED;
            PG8_STAGE(PG8_SB(1, 1), b3 + hstep, voffB);
            PG8_WAIT_V(6); PG8_BAR; PG8_MMA(1, 1, At, B1); PG8_BAR;
            }
        }
        if constexpr (ALIGN_EPI) { if (wr == 0) PG8_BAR; }
        if constexpr (!Epi::AFTER_DRAIN) { E(acc, cur, wr, wc, fr, fq); S.done(cur); }
        if (!has_next) break;
#pragma unroll
        for (int a = 0; a < 2; ++a)
#pragma unroll
            for (int b = 0; b < 2; ++b)
#pragma unroll
                for (int m = 0; m < 4; ++m)
#pragma unroll
                    for (int n = 0; n < 2; ++n) acc[a][b][m][n] = (f32x4){0.f, 0.f, 0.f, 0.f};
        cur = nxt; cA = nA; cB = nB; ++ui;
        if constexpr (ALIGN_EPI) { if (wr == 1) PG8_BAR; }
    }
    PG8_WAIT_V(0);
    if constexpr (!ALIGN_EPI) { if (wr == 0) PG8_BAR; }
    PG8_BAR;
    if constexpr (Epi::AFTER_DRAIN) { E.fused(acc, cur, wr, wc, fr, fq, lds, wid, lane); S.done(cur); }
#undef PG8_SA
#undef PG8_SB
#undef PG8_STAGE
#undef PG8_LDA
#undef PG8_LDB
#undef PG8_MMA
#undef PG8_WAIT_V
#undef PG8_WAIT_L
#undef PG8_BAR
#undef PG8_SCHED
}
}

constexpr int DM = 1024, TP = 4096, BP = 4, MPR = BP * TP, BS = 8, TS = 16, MR = MPR + BS * TS, MP = 16640;
constexpr int DFF = 2816, NFF = 2 * DFF, INW = 5376, SHW = 1792, PAST = 4096, NPOS = PAST + TS;
constexpr float EPS = 1e-6f, LNX_EPS = 64e-5f;
constexpr float QSCALE = 0.125f * 1.4426950408889634f;
constexpr size_t O_Y = 0, O_KP = (size_t)MR * DM, O_VP = O_KP + (size_t)MPR * 512, O_SP = O_VP + (size_t)MPR * 512, O_SHP = O_SP + 131072,
                 O_KS = O_SHP + 7168, O_VS = O_KS + 65536, O_SS = O_VS + 65536, O_SHS = O_SS + 262144, O_END = O_SHS + 14336;
constexpr size_t KiB = 1024, MiB = 1u << 20;
constexpr size_t WS_W1T = 0, WS_W2T = 11 * MiB, WS_WINT = 16 * MiB + 512 * KiB, WS_WAT = 27 * MiB, WS_WRT = 28 * MiB, WS_WOT = 29 * MiB, WS_W3T = 31 * MiB, WS_W4T = 42 * MiB,
                 WS_TAB = 48 * MiB, WS_CTR = 49 * MiB + 512 * KiB, WS_ORW = 0,
                 WS_XN = 50 * MiB, WS_ABUF = 50 * MiB, WS_GG = 66 * MiB + 256 * KiB, WS_MG = 50 * MiB,
                 WS_G = 82 * MiB + 512 * KiB, WS_QB = WS_G, WS_KB = 98 * MiB + 768 * KiB, WS_VT = 115 * MiB, WS_ZRW = 131 * MiB + 256 * KiB,
                 WS_GATE = 188 * MiB + 128 * KiB, WS_DEC = 253 * MiB + 128 * KiB, WS_T = WS_KB, WS_F = 171 * MiB + 896 * KiB, WS_NEED = 286 * MiB;
constexpr size_t WS_LW = 49 * MiB + 64 * KiB;
static_assert(WS_ZRW + (size_t)MP * SHW * 2 <= WS_GATE && WS_GATE + (size_t)MP * 2048 * 2 <= WS_DEC && WS_DEC + (size_t)MP * 512 * 4 <= WS_NEED, "ws map");
static_assert(WS_G + (size_t)MP * DFF * 2 <= WS_F && WS_F + (size_t)MP * DM * 4 <= WS_NEED && WS_T + (size_t)MP * DM * 4 <= WS_F, "ws map 2");
static_assert(WS_XN + (size_t)MP * DM * 2 <= WS_G && WS_ORW + (size_t)MP * 512 * 2 <= WS_WINT && WS_VT + (size_t)MP * 512 * 2 <= WS_ZRW, "ws map 3");

#define LAS __attribute__((address_space(3)))
typedef unsigned short bf16_t;
typedef short bf16x8 __attribute__((ext_vector_type(8)));
typedef float f32x4 __attribute__((ext_vector_type(4)));
typedef float f32x2 __attribute__((ext_vector_type(2)));
typedef unsigned u32x4 __attribute__((ext_vector_type(4)));
typedef unsigned u32x2 __attribute__((ext_vector_type(2)));
typedef __bf16 bf16x2_t __attribute__((ext_vector_type(2)));
using pg8::Unit;

__device__ __forceinline__ unsigned pk2(float lo, float hi) { f32x2 v = {lo, hi}; bf16x2_t b = __builtin_convertvector(v, bf16x2_t); return __builtin_bit_cast(unsigned, b); }
__device__ __forceinline__ bf16_t f2bf(float f) { return (bf16_t)(pk2(f, 0.f) & 0xffffu); }
__device__ __forceinline__ float bf2f(bf16_t h) { return __uint_as_float((unsigned)h << 16); }
__device__ __forceinline__ float bflo(unsigned w) { return __uint_as_float(w << 16); }
__device__ __forceinline__ float bfhi(unsigned w) { return __uint_as_float(w & 0xffff0000u); }
__device__ __forceinline__ float fexp2(float x) { return __builtin_amdgcn_exp2f(x); }
__device__ __forceinline__ float frcp(float x) { return __builtin_amdgcn_rcpf(x); }
__device__ __forceinline__ float sigmoidf_(float x) { return frcp(1.f + fexp2(-1.4426950408889634f * x)); }
template <int CTRL> __device__ __forceinline__ float dpp_add_(float x) {
    return x + __builtin_bit_cast(float, __builtin_amdgcn_update_dpp(0, __builtin_bit_cast(int, x), CTRL, 0xf, 0xf, true));
}
__device__ __forceinline__ float wave_sum_fast(float x) {
    x = dpp_add_<0xB1>(x); x = dpp_add_<0x4E>(x); x = dpp_add_<0x141>(x); x = dpp_add_<0x140>(x);
    { auto rr = __builtin_amdgcn_permlane16_swap(__float_as_uint(x), __float_as_uint(x), false, false); x = __uint_as_float(rr[0]) + __uint_as_float(rr[1]); }
    { auto rr = __builtin_amdgcn_permlane32_swap(__float_as_uint(x), __float_as_uint(x), false, false); x = __uint_as_float(rr[0]) + __uint_as_float(rr[1]); }
    return x;
}
__device__ __forceinline__ float wave_sum(float v) { return wave_sum_fast(v); }
__device__ __forceinline__ float half_sum(float v) {
#pragma unroll
    for (int o = 1; o < 32; o <<= 1) v += __shfl_xor(v, o);
    return v;
}

struct Params {
    const float* in[36];
    float* out;
    unsigned char* ws;
    int ph_lo, ph_hi;
};
struct Ctx {
    const LAS unsigned* tab;
    __device__ __forceinline__ const void* ptr(int i) const {
        const unsigned lo = __builtin_amdgcn_readfirstlane(tab[2 * i]), hi = __builtin_amdgcn_readfirstlane(tab[2 * i + 1]);
        return (const void*)(const __attribute__((address_space(1))) void*)(((unsigned long long)hi << 32) | lo);
    }
    __device__ __forceinline__ const float* in(int i) const { return (const float*)ptr(i); }
    __device__ __forceinline__ float* out() const { return (float*)ptr(36); }
    __device__ __forceinline__ unsigned char* ws() const { return (unsigned char*)ptr(37); }
};

struct EpiSwiglu {
    static constexpr bool PERM = true, AFTER_DRAIN = false;
    bf16_t* O;
    __device__ __forceinline__ void operator()(const f32x4 (&acc)[2][2][4][2], const Unit& u, int wr, int wc, int fr, int fq) const {
        const int col0 = u.pn * 128 + wc * 32 + 8 * fq;
#pragma unroll
        for (int ai = 0; ai < 2; ++ai)
#pragma unroll
            for (int m = 0; m < 4; ++m) {
                const int row = u.pm * 256 + ai * 128 + wr * 64 + m * 16 + fr;
                float v[8];
#pragma unroll
                for (int n = 0; n < 2; ++n)
#pragma unroll
                    for (int i = 0; i < 4; ++i) { const float g = acc[ai][0][m][n][i], up = acc[ai][1][m][n][i]; v[n * 4 + i] = g * sigmoidf_(g) * up; }
                u32x4 w; w.x = pk2(v[0], v[1]); w.y = pk2(v[2], v[3]); w.z = pk2(v[4], v[5]); w.w = pk2(v[6], v[7]);
                if (row < MR) *(u32x4*)(O + (size_t)row * DFF + col0) = w;
                asm volatile("" ::: "memory");
            }
    }
};
struct EpiF32 {
    static constexpr bool PERM = false, AFTER_DRAIN = false;
    float* O;
    __device__ __forceinline__ void operator()(const f32x4 (&acc)[2][2][4][2], const Unit& u, int wr, int wc, int fr, int fq) const {
        const int col0 = u.pn * 256 + wc * 32 + 4 * fq;
#pragma unroll
        for (int ai = 0; ai < 2; ++ai)
#pragma unroll
            for (int m = 0; m < 4; ++m) {
                const int row = u.pm * 256 + ai * 128 + wr * 64 + m * 16 + fr;
                if (row < MR) {
#pragma unroll
                    for (int bj = 0; bj < 2; ++bj)
#pragma unroll
                        for (int n = 0; n < 2; ++n) *(f32x4*)(O + (size_t)row * DM + col0 + bj * 128 + n * 16) = acc[ai][bj][m][n];
                }
                asm volatile("" ::: "memory");
            }
    }
};
struct EpiGate1 {
    static constexpr bool PERM = true, AFTER_DRAIN = false;
    bf16_t* T; const bf16_t* GATE;
    __device__ __forceinline__ void operator()(const f32x4 (&acc)[2][2][4][2], const Unit& u, int wr, int wc, int fr, int fq) const {
        const int col0 = u.pn * 256 + wc * 32 + 8 * fq;
#pragma unroll
        for (int ai = 0; ai < 2; ++ai)
#pragma unroll
            for (int m = 0; m < 4; ++m) {
                const int row = u.pm * 256 + ai * 128 + wr * 64 + m * 16 + fr;
                if (row < MR) {
#pragma unroll
                    for (int bj = 0; bj < 2; ++bj) {
                        const u32x4 gv = *(const u32x4*)(GATE + (size_t)row * 2048 + col0 + bj * 128);
                        f32x4 a = acc[ai][bj][m][0], b = acc[ai][bj][m][1];
                        a[0] *= bflo(gv.x); a[1] *= bfhi(gv.x); a[2] *= bflo(gv.y); a[3] *= bfhi(gv.y);
                        b[0] *= bflo(gv.z); b[1] *= bfhi(gv.z); b[2] *= bflo(gv.w); b[3] *= bfhi(gv.w);
                        u32x4 w; w.x = pk2(a[0], a[1]); w.y = pk2(a[2], a[3]); w.z = pk2(b[0], b[1]); w.w = pk2(b[2], b[3]);
                        *(u32x4*)(T + (size_t)row * DM + col0 + bj * 128) = w;
                    }
                }
                asm volatile("" ::: "memory");
            }
    }
};
struct EpiGate2 {
    static constexpr bool PERM = true, AFTER_DRAIN = false;
    const bf16_t* T; const bf16_t* GATE; bf16_t* MG;
    __device__ __forceinline__ void operator()(const f32x4 (&acc)[2][2][4][2], const Unit& u, int wr, int wc, int fr, int fq) const {
        const int col0 = u.pn * 256 + wc * 32 + 8 * fq;
#pragma unroll
        for (int ai = 0; ai < 2; ++ai)
#pragma unroll
            for (int m = 0; m < 4; ++m) {
                const int row = u.pm * 256 + ai * 128 + wr * 64 + m * 16 + fr;
                if (row < MR) {
#pragma unroll
                    for (int bj = 0; bj < 2; ++bj) {
                        const u32x4 gv = *(const u32x4*)(GATE + (size_t)row * 2048 + 1024 + col0 + bj * 128);
                        const u32x4 tv = *(const u32x4*)(T + (size_t)row * DM + col0 + bj * 128);
                        f32x4 a = (f32x4){bflo(tv.x), bfhi(tv.x), bflo(tv.y), bfhi(tv.y)}, b = (f32x4){bflo(tv.z), bfhi(tv.z), bflo(tv.w), bfhi(tv.w)};
                        const f32x4 x = acc[ai][bj][m][0], y = acc[ai][bj][m][1];
                        a[0] += x[0] * bflo(gv.x); a[1] += x[1] * bfhi(gv.x); a[2] += x[2] * bflo(gv.y); a[3] += x[3] * bfhi(gv.y);
                        b[0] += y[0] * bflo(gv.z); b[1] += y[1] * bfhi(gv.z); b[2] += y[2] * bflo(gv.w); b[3] += y[3] * bfhi(gv.w);
                        u32x4 w; w.x = pk2(a[0], a[1]); w.y = pk2(a[2], a[3]); w.z = pk2(b[0], b[1]); w.w = pk2(b[2], b[3]);
                        *(u32x4*)(MG + (size_t)row * DM + col0 + bj * 128) = w;
                    }
                }
                asm volatile("" ::: "memory");
            }
    }
};
struct EpiZ {
    static constexpr bool PERM = true, AFTER_DRAIN = false;
    float* out; bf16_t *QB, *KB, *VT, *ZRW, *GATE; const f32x2* TAB;
    __device__ __forceinline__ void operator()(const f32x4 (&acc)[2][2][4][2], const Unit& u, int wr, int wc, int fr, int fq) const {
        const int pn = u.pn;
#pragma unroll
        for (int ai = 0; ai < 2; ++ai)
#pragma unroll
            for (int m = 0; m < 4; ++m) {
                const int row = u.pm * 256 + ai * 128 + wr * 64 + m * 16 + fr;
                asm volatile("" ::: "memory");
                if (row >= MR) continue;
                const bool smp = row >= MPR;
                if (pn < 4) {
                    const int pos = smp ? PAST + ((row - MPR) & 15) : (row & (TP - 1));
                    const int d0 = 8 * fq;
                    float o1[8], o2[8];
#pragma unroll
                    for (int n = 0; n < 2; ++n)
#pragma unroll
                        for (int i = 0; i < 4; ++i) {
                            const f32x2 cs = TAB[pos * 32 + d0 + n * 4 + i];
                            const float x1 = acc[ai][0][m][n][i], x2 = acc[ai][1][m][n][i];
                            o1[n * 4 + i] = x1 * cs.x - x2 * cs.y; o2[n * 4 + i] = x1 * cs.y + x2 * cs.x;
                        }
                    const int cb = (pn & 1) * 256 + 64 * wc + d0;
                    if (pn < 2) {
                        u32x4 w1, w2;
                        w1.x = pk2(o1[0] * QSCALE, o1[1] * QSCALE); w1.y = pk2(o1[2] * QSCALE, o1[3] * QSCALE); w1.z = pk2(o1[4] * QSCALE, o1[5] * QSCALE); w1.w = pk2(o1[6] * QSCALE, o1[7] * QSCALE);
                        w2.x = pk2(o2[0] * QSCALE, o2[1] * QSCALE); w2.y = pk2(o2[2] * QSCALE, o2[3] * QSCALE); w2.z = pk2(o2[4] * QSCALE, o2[5] * QSCALE); w2.w = pk2(o2[6] * QSCALE, o2[7] * QSCALE);
                        *(u32x4*)(QB + (size_t)row * 512 + cb) = w1; *(u32x4*)(QB + (size_t)row * 512 + cb + 32) = w2;
                    } else {
                        float* ko = smp ? out + O_KS + (size_t)(row - MPR) * 512 + cb : out + O_KP + (size_t)row * 512 + cb;
                        *(f32x4*)ko = (f32x4){o1[0], o1[1], o1[2], o1[3]}; *(f32x4*)(ko + 4) = (f32x4){o1[4], o1[5], o1[6], o1[7]};
                        *(f32x4*)(ko + 32) = (f32x4){o2[0], o2[1], o2[2], o2[3]}; *(f32x4*)(ko + 36) = (f32x4){o2[4], o2[5], o2[6], o2[7]};
                        u32x4 w1, w2;
                        w1.x = pk2(o1[0], o1[1]); w1.y = pk2(o1[2], o1[3]); w1.z = pk2(o1[4], o1[5]); w1.w = pk2(o1[6], o1[7]);
                        w2.x = pk2(o2[0], o2[1]); w2.y = pk2(o2[2], o2[3]); w2.z = pk2(o2[4], o2[5]); w2.w = pk2(o2[6], o2[7]);
                        *(u32x4*)(KB + (size_t)row * 512 + cb) = w1; *(u32x4*)(KB + (size_t)row * 512 + cb + 32) = w2;
                    }
                } else {
#pragma unroll
                    for (int bj = 0; bj < 2; ++bj) {
                        const int c = pn * 256 + bj * 128 + wc * 32 + 8 * fq;
                        const f32x4 a = acc[ai][bj][m][0], b = acc[ai][bj][m][1];
                        if (pn < 6) {
                            const int vc = c - 1024;
                            float* vo = smp ? out + O_VS + (size_t)(row - MPR) * 512 + vc : out + O_VP + (size_t)row * 512 + vc;
                            *(f32x4*)vo = a; *(f32x4*)(vo + 4) = b;
                            if (!smp) {
                                const int bb = row >> 12, t = row & (TP - 1), hh = vc >> 7, dd = vc & 127;
                                bf16_t* vt = VT + ((size_t)(bb * 4 + hh) * 128 + dd) * TP + t;
                                vt[0] = f2bf(a[0]); vt[TP] = f2bf(a[1]); vt[2 * TP] = f2bf(a[2]); vt[3 * TP] = f2bf(a[3]);
                                vt[4 * TP] = f2bf(b[0]); vt[5 * TP] = f2bf(b[1]); vt[6 * TP] = f2bf(b[2]); vt[7 * TP] = f2bf(b[3]);
                            }
                        } else if (pn < 13) {
                            const int zc = c - 1536;
                            u32x4 w; w.x = pk2(a[0], a[1]); w.y = pk2(a[2], a[3]); w.z = pk2(b[0], b[1]); w.w = pk2(b[2], b[3]);
                            *(u32x4*)(ZRW + (size_t)row * SHW + zc) = w;
                            const bool last = smp ? (((row - MPR) & 15) == 15) : ((row & (TP - 1)) == TP - 1);
                            if (last) { float* so = smp ? out + O_SHS + (size_t)((row - MPR) >> 4) * SHW + zc : out + O_SHP + (size_t)(row >> 12) * SHW + zc;
                                *(f32x4*)so = a; *(f32x4*)(so + 4) = b; }
                        } else {
                            const int gc = c - 3328;
                            u32x4 w; w.x = pk2(sigmoidf_(a[0]), sigmoidf_(a[1])); w.y = pk2(sigmoidf_(a[2]), sigmoidf_(a[3])); w.z = pk2(sigmoidf_(b[0]), sigmoidf_(b[1])); w.w = pk2(sigmoidf_(b[2]), sigmoidf_(b[3]));
                            *(u32x4*)(GATE + (size_t)row * 2048 + gc) = w;
                        }
                    }
                }
            }
    }
};

__device__ __forceinline__ void transpose_item(const float* W, int K, int N, bf16_t* WT, int k0, int n0, int drow0, LAS float* scr, int lane) {
#pragma unroll 8
    for (int i = 0; i < 32; ++i) { const int kk = 2 * i + (lane >> 5); scr[kk * 33 + (lane & 31)] = W[(size_t)(k0 + kk) * N + n0 + (lane & 31)]; }
    asm volatile("s_waitcnt lgkmcnt(0)" ::: "memory");
    const int c = lane & 7;
#pragma unroll
    for (int j = 0; j < 4; ++j) { const int n = (lane >> 3) + 8 * j; const LAS float* s = scr + (8 * c) * 33 + n;
        u32x4 o; o.x = pk2(s[0 * 33], s[1 * 33]); o.y = pk2(s[2 * 33], s[3 * 33]); o.z = pk2(s[4 * 33], s[5 * 33]); o.w = pk2(s[6 * 33], s[7 * 33]);
        *(u32x4*)(WT + (size_t)(drow0 + n) * K + k0 + 8 * c) = o; }
    asm volatile("s_waitcnt lgkmcnt(0)" ::: "memory");
}
__device__ __forceinline__ int map_w1(int n) { return n < DFF ? 256 * (n >> 7) + (n & 127) : 256 * ((n - DFF) >> 7) + 128 + ((n - DFF) & 127); }
__device__ __forceinline__ int map_win(int n) { return n < 1024 ? (n & ~255) + 128 * ((n >> 5) & 1) + 32 * ((n >> 6) & 3) + (n & 31) : n; }

__device__ __forceinline__ void sincos_d(double ang, float& c, float& s) {
    const double TWO_PI = 6.283185307179586476925286766559, HALF_PI = 1.5707963267948966192313216916398;
    double r = ang - TWO_PI * __builtin_rint(ang / TWO_PI);
    const double qd = __builtin_rint(r / HALF_PI); const int q = (int)qd; r -= qd * HALF_PI;
    const double r2 = r * r;
    double sp = r * (1.0 + r2 * (-1.0 / 6 + r2 * (1.0 / 120 + r2 * (-1.0 / 5040 + r2 * (1.0 / 362880 + r2 * (-1.0 / 39916800 + r2 * (1.0 / 6227020800.0)))))));
    double cp = 1.0 + r2 * (-0.5 + r2 * (1.0 / 24 + r2 * (-1.0 / 720 + r2 * (1.0 / 40320 + r2 * (-1.0 / 3628800 + r2 * (1.0 / 479001600.0 + r2 * (-1.0 / 87178291200.0)))))));
    double cc, ss;
    switch (q & 3) { case 0: cc = cp; ss = sp; break; case 1: cc = -sp; ss = cp; break; case 2: cc = -cp; ss = -sp; break; default: cc = sp; ss = -cp; break; }
    c = (float)cc; s = (float)ss;
}
__device__ __forceinline__ void rms_row_to_bf16(const float* xrow, const float* g, bf16_t* orow, int lane) {
    const f32x4* xr = (const f32x4*)xrow + lane; const f32x4* gr = (const f32x4*)g + lane;
    f32x4 v[4]; float s = 0.f;
#pragma unroll
    for (int j = 0; j < 4; ++j) { v[j] = xr[64 * j]; s += (v[j].x * v[j].x + v[j].y * v[j].y) + (v[j].z * v[j].z + v[j].w * v[j].w); }
    const float rs = 1.f / sqrtf(wave_sum(s) * (1.f / DM) + EPS);
    u32x2* o8 = (u32x2*)orow + lane;
#pragma unroll
    for (int j = 0; j < 4; ++j) { const f32x4 gg = gr[64 * j]; u32x2 w; w.x = pk2(v[j].x * rs * gg.x, v[j].y * rs * gg.y); w.y = pk2(v[j].z * rs * gg.z, v[j].w * rs * gg.w); o8[64 * j] = w; }
}
__device__ __forceinline__ const float* xrow_ptr(const Ctx& p, int row) { return row < MPR ? p.in(0) + (size_t)row * DM : p.in(1) + (size_t)(row - MPR) * DM; }

__device__ __forceinline__ void prologue_part2(const Ctx& p, LAS unsigned char* lds, int bidx, int nblk) {
    const int tid = threadIdx.x, lane = tid & 63, wave = __builtin_amdgcn_readfirstlane(tid >> 6);
    const int gw = bidx * 8 + wave, NGW = nblk * 8;
    unsigned char* ws = p.ws();
    LAS float* scr = (LAS float*)(lds + wave * 16384);
    constexpr int I2 = 44 * 32, I3 = 16 * 168, I4 = 8 * 32, I5 = 8 * 32, I6 = 16 * 32;
    __syncthreads();
    for (int it = gw; it < I2 + I3 + I4 + I5 + I6; it += NGW) {
        int r = it;
        if (r < I2) { const int kb = r / 32, nb = r % 32; transpose_item(p.in(8), DFF, DM, (bf16_t*)(ws + WS_W2T), 64 * kb, 32 * nb, 32 * nb, scr, lane); continue; } r -= I2;
        if (r < I3) { const int kb = r / 168, nb = r % 168; transpose_item(p.in(11), DM, INW, (bf16_t*)(ws + WS_WINT), 64 * kb, 32 * nb, map_win(32 * nb), scr, lane); continue; } r -= I3;
        if (r < I4) { const int kb = r / 32, nb = r % 32; transpose_item(p.in(28), 512, DM, (bf16_t*)(ws + WS_WAT), 64 * kb, 32 * nb, 32 * nb, scr, lane); continue; } r -= I4;
        if (r < I5) { const int kb = r / 32, nb = r % 32; transpose_item(p.in(29), 512, DM, (bf16_t*)(ws + WS_WRT), 64 * kb, 32 * nb, 32 * nb, scr, lane); continue; } r -= I5;
        { const int kb = r / 32, nb = r % 32; transpose_item(p.in(30), DM, DM, (bf16_t*)(ws + WS_WOT), 64 * kb, 32 * nb, 32 * nb, scr, lane); }
    }
    {   bf16_t* LW = (bf16_t*)(ws + WS_LW);
        for (int e = bidx * 512 + tid; e < 512 * 256; e += nblk * 512) {
            const int n = e & 511, k = e >> 9;
            if (k < 64) LW[n * 64 + k] = f2bf(p.in(19)[k * 512 + n]);
            else if (k < 128) LW[512 * 64 + n * 64 + (k - 64)] = f2bf(p.in(21)[(k - 64) * 512 + n]);
            else LW[2 * 512 * 64 + n * 128 + (k - 128)] = f2bf(p.in(22)[(k - 128) * 512 + n]);
        } }
    for (int e = bidx * 512 + tid; e < NPOS * 32; e += nblk * 512) {
        const int pos = e >> 5, d = e & 31;
        const double inv = exp(-(double)d * (9.210340371976182736071965818737 / 32.0));
        float c, s; sincos_d((double)pos * inv, c, s);
        ((f32x2*)(ws + WS_TAB))[e] = (f32x2){c, s};
    }
}
__device__ __forceinline__ void phase_prologue(const Ctx& p, LAS unsigned char* lds) {
    const int tid = threadIdx.x, lane = tid & 63, wave = __builtin_amdgcn_readfirstlane(tid >> 6);
    const int gw = blockIdx.x * 8 + wave, NGW = gridDim.x * 8;
    unsigned char* ws = p.ws();
    LAS float* scr = (LAS float*)(lds + wave * 16384);
    constexpr int I1 = 16 * 176;
    for (int it = gw; it < I1; it += NGW) { const int kb = it / 176, nb = it % 176; transpose_item(p.in(7), DM, NFF, (bf16_t*)(ws + WS_W1T), 64 * kb, 32 * nb, map_w1(32 * nb), scr, lane); }
    bf16_t* XN = (bf16_t*)(ws + WS_XN);
    {   f32x4 g4[4], v[4], v2[4];
#pragma unroll
        for (int j = 0; j < 4; ++j) g4[j] = ((const f32x4*)p.in(6))[lane + 64 * j];
        if (gw < MR) {
#pragma unroll
            for (int j = 0; j < 4; ++j) v[j] = ((const f32x4*)xrow_ptr(p, gw))[lane + 64 * j]; }
        for (int m = gw; m < MP; m += NGW) {
            const int mn = m + NGW;
            if (mn < MR) {
#pragma unroll
                for (int j = 0; j < 4; ++j) v2[j] = ((const f32x4*)xrow_ptr(p, mn))[lane + 64 * j]; }
            u32x2* o8 = (u32x2*)(XN + (size_t)m * DM) + lane;
            if (m < MR) {
                float sq = 0.f;
#pragma unroll
                for (int j = 0; j < 4; ++j) sq += (v[j].x * v[j].x + v[j].y * v[j].y) + (v[j].z * v[j].z + v[j].w * v[j].w);
                const float rs = 1.f / sqrtf(wave_sum(sq) * (1.f / DM) + EPS);
#pragma unroll
                for (int j = 0; j < 4; ++j) { u32x2 w; w.x = pk2(v[j].x * rs * g4[j].x, v[j].y * rs * g4[j].y); w.y = pk2(v[j].z * rs * g4[j].z, v[j].w * rs * g4[j].w); o8[64 * j] = w; }
            } else {
#pragma unroll
                for (int j = 0; j < 4; ++j) o8[64 * j] = (u32x2){0u, 0u}; }
#pragma unroll
            for (int j = 0; j < 4; ++j) v[j] = v2[j];
        }
    }
}

__device__ __forceinline__ void phase_rowpass(const Ctx& p, const float* F, int base_is_x, float alpha, const float* gpost, const float* gnext, bf16_t* XN, const float* PART, int nsplit) {
    const int tid = threadIdx.x, lane = tid & 63, wave = __builtin_amdgcn_readfirstlane(tid >> 6);
    const int gw = blockIdx.x * 8 + wave, NGW = gridDim.x * 8;
    float* H = p.out() + O_Y;
    auto loadrow = [&](int m, f32x4 (&f)[4], f32x4 (&b)[4]) {
        const f32x4* fr = (const f32x4*)(F + (size_t)m * DM) + lane;
        const f32x4* br = (const f32x4*)(base_is_x ? xrow_ptr(p, m) : H + (size_t)m * DM) + lane;
#pragma unroll
        for (int j = 0; j < 4; ++j) { b[j] = br[64 * j];
            if (m < MPR) f[j] = fr[64 * j];
            else { f[j] = (f32x4){0.f, 0.f, 0.f, 0.f};
                for (int ks = 0; ks < nsplit; ++ks) f[j] = f[j] + ((const f32x4*)(PART + ((size_t)ks * 128 + (m - MPR)) * DM))[lane + 64 * j]; } }
    };
    f32x4 gp[4], gn[4];
#pragma unroll
    for (int j = 0; j < 4; ++j) { gp[j] = ((const f32x4*)gpost)[lane + 64 * j]; gn[j] = gnext ? ((const f32x4*)gnext)[lane + 64 * j] : (f32x4){0.f, 0.f, 0.f, 0.f}; }
    f32x4 f[4], b[4], f2[4], b2[4];
    if (gw < MR) loadrow(gw, f, b);
    for (int m = gw; m < MR; m += NGW) {
        const bool more = m + NGW < MR;
        if (more) loadrow(m + NGW, f2, b2);
        float s = 0.f;
#pragma unroll
        for (int j = 0; j < 4; ++j) s += (f[j].x * f[j].x + f[j].y * f[j].y) + (f[j].z * f[j].z + f[j].w * f[j].w);
        const float rs = alpha / sqrtf(wave_sum_fast(s) * (1.f / DM) + EPS);
        float s2 = 0.f;
#pragma unroll
        for (int j = 0; j < 4; ++j) { b[j] = b[j] + f[j] * rs * gp[j]; s2 += (b[j].x * b[j].x + b[j].y * b[j].y) + (b[j].z * b[j].z + b[j].w * b[j].w);
            ((f32x4*)(H + (size_t)m * DM))[lane + 64 * j] = b[j]; }
        if (gnext) {
            const float r2 = 1.f / sqrtf(wave_sum_fast(s2) * (1.f / DM) + EPS);
            u32x2* o8 = (u32x2*)(XN + (size_t)m * DM) + lane;
#pragma unroll
            for (int j = 0; j < 4; ++j) { u32x2 w; w.x = pk2(b[j].x * r2 * gn[j].x, b[j].y * r2 * gn[j].y); w.y = pk2(b[j].z * r2 * gn[j].z, b[j].w * r2 * gn[j].w); o8[64 * j] = w; }
        }
        if (more) {
#pragma unroll
            for (int j = 0; j < 4; ++j) { f[j] = f2[j]; b[j] = b2[j]; } }
    }
}

__device__ __forceinline__ float zshift(const Ctx& p, const bf16_t* ZRW, int row, int c) {
    const float z = bf2f(ZRW[(size_t)row * SHW + c]);
    float prev;
    if (row < MPR) prev = (row & (TP - 1)) ? bf2f(ZRW[(size_t)(row - 1) * SHW + c]) : 0.f;
    else { const int r = row - MPR; prev = (r & 15) ? bf2f(ZRW[(size_t)(row - 1) * SHW + c]) : p.in(5)[(size_t)(r >> 4) * SHW + c]; }
    return z + (prev - z) * p.in(17)[c];
}
__device__ __forceinline__ void unpack8(const u32x4 w, float (&f)[8]) { f[0] = bflo(w.x); f[1] = bfhi(w.x); f[2] = bflo(w.y); f[3] = bfhi(w.y); f[4] = bflo(w.z); f[5] = bfhi(w.z); f[6] = bflo(w.w); f[7] = bfhi(w.w); }
__device__ __forceinline__ void zshift8(const Ctx& p, const bf16_t* ZRW, int row, int c, const float (&mu)[8], float (&o)[8]) {
    float z[8], pv[8];
    unpack8(*(const u32x4*)(ZRW + (size_t)row * SHW + c), z);
    bool first; int bsmp = 0;
    if (row < MPR) first = (row & (TP - 1)) == 0; else { first = ((row - MPR) & 15) == 0; bsmp = (row - MPR) >> 4; }
    if (!first) unpack8(*(const u32x4*)(ZRW + (size_t)(row - 1) * SHW + c), pv);
    else if (row < MPR) {
#pragma unroll
        for (int e = 0; e < 8; ++e) pv[e] = 0.f;
    } else { const float* s0 = p.in(5) + (size_t)bsmp * SHW + c;
#pragma unroll
        for (int e = 0; e < 8; ++e) pv[e] = s0[e]; }
#pragma unroll
    for (int e = 0; e < 8; ++e) o[e] = z[e] + (pv[e] - z[e]) * mu[e];
}
__device__ __forceinline__ void phase_lora(const Ctx& p, LAS unsigned char* lds) {
    const int tid = threadIdx.x, lane = tid & 63, wave = __builtin_amdgcn_readfirstlane(tid >> 6), q = lane & 15, g = lane >> 4;
    const bf16_t* ZRW = (const bf16_t*)(p.ws() + WS_ZRW);
    float* DEC = (float*)(p.ws() + WS_DEC); bf16_t* AB = (bf16_t*)(p.ws() + WS_ABUF); bf16_t* GG = (bf16_t*)(p.ws() + WS_GG);
    const bf16_t* w2T = (const bf16_t*)(p.ws() + WS_LW); const bf16_t* a2T = w2T + 512 * 64; const bf16_t* g2T = a2T + 512 * 64;
    LAS bf16_t* X = (LAS bf16_t*)(lds + wave * 16 * 264 * 2);
    const float* mu = p.in(17) + 1536;
    for (int it = blockIdx.x + gridDim.x * wave; it < MR / 16; it += gridDim.x * 8) {
        const int r0 = it * 16;
        {
            const int tt = lane >> 2, cq = lane & 3, row = r0 + tt;
#pragma unroll
            for (int j = 0; j < 8; ++j) {
                const int c = cq * 64 + j * 8;
                float m8[8], z[8];
#pragma unroll
                for (int e = 0; e < 8; ++e) m8[e] = mu[c + e];
                zshift8(p, ZRW, row, 1536 + c, m8, z);
#pragma unroll
                for (int e = 0; e < 8; ++e) z[e] = cq == 0 ? tanhf(z[e]) : (cq == 1 ? z[e] : sigmoidf_(z[e]));
                u32x4 w; w.x = pk2(z[0], z[1]); w.y = pk2(z[2], z[3]); w.z = pk2(z[4], z[5]); w.w = pk2(z[6], z[7]);
                *(LAS u32x4*)(X + tt * 264 + c) = w;
            }
        }
        asm volatile("s_waitcnt lgkmcnt(0)" ::: "memory");
        bf16x8 bx[8];
#pragma unroll
        for (int ks = 0; ks < 8; ++ks) bx[ks] = *(const LAS bf16x8*)(X + q * 264 + ks * 32 + 8 * g);
        const int row = r0 + q;
        struct WF { bf16x8 w[2], a[2], gq[4]; f32x4 w0, a0; };
        auto ldw = [&](WF& f, int nt) {
            const int n = nt * 16 + q, c = nt * 16 + 4 * g;
#pragma unroll
            for (int ks = 0; ks < 2; ++ks) { f.w[ks] = *(const bf16x8*)(w2T + n * 64 + ks * 32 + 8 * g); f.a[ks] = *(const bf16x8*)(a2T + n * 64 + ks * 32 + 8 * g); }
#pragma unroll
            for (int ks = 0; ks < 4; ++ks) f.gq[ks] = *(const bf16x8*)(g2T + n * 128 + ks * 32 + 8 * g);
            f.w0 = *(const f32x4*)(p.in(18) + c); f.a0 = *(const f32x4*)(p.in(20) + c);
        };
        auto tile = [&](const WF& f, int nt) {
            f32x4 aw = (f32x4){0.f, 0.f, 0.f, 0.f}, aa = aw, ag = aw;
#pragma unroll
            for (int ks = 0; ks < 2; ++ks) { aw = __builtin_amdgcn_mfma_f32_16x16x32_bf16(f.w[ks], bx[ks], aw, 0, 0, 0); aa = __builtin_amdgcn_mfma_f32_16x16x32_bf16(f.a[ks], bx[2 + ks], aa, 0, 0, 0); }
#pragma unroll
            for (int ks = 0; ks < 4; ++ks) ag = __builtin_amdgcn_mfma_f32_16x16x32_bf16(f.gq[ks], bx[4 + ks], ag, 0, 0, 0);
            const int c = nt * 16 + 4 * g;
            f32x4 dec; float av[4];
#pragma unroll
            for (int e = 0; e < 4; ++e) {
                const float x = f.w0[e] + aw[e];
                const float sp = fmaxf(-x, 0.f) + log1pf(expf(-fabsf(x)));
                dec[e] = expf(-expf(-sp - 0.5f));
                av[e] = sigmoidf_(f.a0[e] + aa[e]);
            }
            *(f32x4*)(DEC + (size_t)row * 512 + c) = dec;
            *(u32x2*)(AB + (size_t)row * 512 + c) = (u32x2){pk2(av[0], av[1]), pk2(av[2], av[3])};
            *(u32x2*)(GG + (size_t)row * 512 + c) = (u32x2){pk2(ag[0], ag[1]), pk2(ag[2], ag[3])};
        };
        WF fa, fb;
        ldw(fa, 0);
#pragma unroll 1
        for (int nt = 0; nt < 32; nt += 2) {
            ldw(fb, nt + 1);
            tile(fa, nt);
            ldw(fa, (nt + 2) & 31);
            tile(fb, nt + 1);
        }
        asm volatile("s_waitcnt lgkmcnt(0)" ::: "memory");
    }
}

#define MFMA16(a, b, c) __builtin_amdgcn_mfma_f32_16x16x32_bf16((a), (b), (c), 0, 0, 0)
struct AttAcc { f32x4 O[2][8]; float m[2], l[2]; };
__device__ __forceinline__ void att_init(AttAcc& A) {
#pragma unroll
    for (int mm = 0; mm < 2; ++mm) { A.m[mm] = -1e30f; A.l[mm] = 0.f;
#pragma unroll
        for (int d = 0; d < 8; ++d) A.O[mm][d] = (f32x4){0.f, 0.f, 0.f, 0.f}; }
}
template <class LK> __device__ __forceinline__ void att_qk(AttAcc& A, const LK& lk, const bf16x8 (&bq)[2][2], int nvalid, int g, bf16x8 (&bP)[2][2]) {
#pragma unroll
    for (int mm = 0; mm < 2; ++mm) {
        f32x4 s[4];
#pragma unroll
        for (int t = 0; t < 4; ++t) { s[t] = (f32x4){0.f, 0.f, 0.f, 0.f};
#pragma unroll
            for (int ks = 0; ks < 2; ++ks) s[t] = MFMA16(lk(mm, ks, t), bq[mm][ks], s[t]); }
        if (nvalid < 64) {
#pragma unroll
            for (int t = 0; t < 4; ++t)
#pragma unroll
                for (int r = 0; r < 4; ++r) if (16 * t + 4 * g + r >= nvalid) s[t][r] = -1e30f;
        }
        float mx = s[0][0];
#pragma unroll
        for (int t = 0; t < 4; ++t)
#pragma unroll
            for (int r = 0; r < 4; ++r) mx = fmaxf(mx, s[t][r]);
        { auto rr = __builtin_amdgcn_permlane16_swap(__float_as_uint(mx), __float_as_uint(mx), false, false); mx = fmaxf(__uint_as_float(rr[0]), __uint_as_float(rr[1])); }
        { auto rr = __builtin_amdgcn_permlane32_swap(__float_as_uint(mx), __float_as_uint(mx), false, false); mx = fmaxf(__uint_as_float(rr[0]), __uint_as_float(rr[1])); }
        const float mnew = fmaxf(A.m[mm], mx), alpha = fexp2(A.m[mm] - mnew);
        const bool grew = __builtin_amdgcn_ballot_w64(mnew > A.m[mm]) != 0ull;
        A.m[mm] = mnew;
        float ls = 0.f;
#pragma unroll
        for (int t = 0; t < 4; ++t)
#pragma unroll
            for (int r = 0; r < 4; ++r) { s[t][r] = fexp2(s[t][r] - mnew); ls += s[t][r]; }
        A.l[mm] = A.l[mm] * alpha + ls;
        if (grew) {
#pragma unroll
            for (int d = 0; d < 8; ++d) A.O[mm][d] = A.O[mm][d] * alpha;
        }
#pragma unroll
        for (int k2 = 0; k2 < 2; ++k2) {
            u32x4 w; w.x = pk2(s[2 * k2][0], s[2 * k2][1]); w.y = pk2(s[2 * k2][2], s[2 * k2][3]); w.z = pk2(s[2 * k2 + 1][0], s[2 * k2 + 1][1]); w.w = pk2(s[2 * k2 + 1][2], s[2 * k2 + 1][3]);
            bP[mm][k2] = __builtin_bit_cast(bf16x8, w);
        }
        asm volatile("" ::: "memory");
    }
}
__device__ __forceinline__ void att_final(const AttAcc& A, float l0, float l1, float lam, const float* subg, bf16_t* orow, int g) {
    const float i0 = 1.f / l0, i1 = lam / l1;
    f32x4 o[8]; float ss = 0.f;
#pragma unroll
    for (int d = 0; d < 8; ++d) { o[d] = A.O[0][d] * i0 - A.O[1][d] * i1; ss += (o[d][0] * o[d][0] + o[d][1] * o[d][1]) + (o[d][2] * o[d][2] + o[d][3] * o[d][3]); }
    ss += __shfl_xor(ss, 16); ss += __shfl_xor(ss, 32);
    const float rs = 0.8f / sqrtf(ss * (1.f / 128.f) + EPS);
#pragma unroll
    for (int d = 0; d < 8; ++d) { const f32x4 gg = *(const f32x4*)(subg + 16 * d + 4 * g);
        u32x2 w; w.x = pk2(o[d][0] * rs * gg[0], o[d][1] * rs * gg[1]); w.y = pk2(o[d][2] * rs * gg[2], o[d][3] * rs * gg[3]);
        *(u32x2*)(orow + 16 * d + 4 * g) = w; }
}
__device__ __forceinline__ float att_lambda(const Ctx& p, int lane) {
    const float a = wave_sum(p.in(12)[lane] * p.in(13)[lane]), b = wave_sum(p.in(14)[lane] * p.in(15)[lane]);
    return expf(a) - expf(b) + 0.2f;
}
constexpr int KS_STRIDE = 136, VS_STRIDE = 72, ATT_BUF = 64 * KS_STRIDE + 128 * VS_STRIDE;
__device__ __forceinline__ void att_prompt_unit(const Ctx& p, int bh, int qb, LAS unsigned char* lds) {
    const int tid = threadIdx.x, lane = tid & 63, wave = __builtin_amdgcn_readfirstlane(tid >> 6), q = lane & 15, g = lane >> 4;
    const int b = bh >> 2, h = bh & 3;
    bf16_t* QB = (bf16_t*)(p.ws() + WS_QB); const bf16_t* KB = (const bf16_t*)(p.ws() + WS_KB); const bf16_t* VT = (const bf16_t*)(p.ws() + WS_VT);
    const int row = b * TP + qb * 128 + wave * 16 + q;
    bf16_t* qrow = QB + (size_t)row * 512 + h * 128;
    bf16x8 bq[2][2];
#pragma unroll
    for (int mm = 0; mm < 2; ++mm)
#pragma unroll
        for (int ks = 0; ks < 2; ++ks) bq[mm][ks] = *(const bf16x8*)(qrow + mm * 64 + ks * 32 + 8 * g);
    AttAcc A; att_init(A);
    const int nkb = 2 * qb + 2, nkt = 2 * qb + 1 + (wave >> 2);
    const bf16_t* kg = KB + (size_t)(b * TP + (tid >> 4)) * 512 + h * 128 + (tid & 15) * 8;
    const bf16_t* vg = VT + ((size_t)bh * 128 + (tid >> 3)) * TP + (tid & 7) * 8;
    LAS bf16_t* L = (LAS bf16_t*)lds;
    const int kso = (tid >> 4) * KS_STRIDE + (tid & 15) * 8, vsb = 64 * KS_STRIDE + (tid >> 3) * VS_STRIDE + ((tid & 7) >> 2) * 32;
    const int kb_ = (tid & 3) * 8, vso = vsb + 8 * ((kb_ & 15) >> 2) + 4 * (kb_ >> 4), vso2 = vsb + 8 * (((kb_ + 4) & 15) >> 2) + 4 * ((kb_ + 4) >> 4);
    u32x4 k0 = *(const u32x4*)kg, k1 = *(const u32x4*)(kg + 32 * 512), v0 = *(const u32x4*)vg, v1 = *(const u32x4*)(vg + (size_t)64 * TP);
    __syncthreads();
    *(LAS u32x4*)(L + kso) = k0; *(LAS u32x4*)(L + kso + 32 * KS_STRIDE) = k1; *(LAS u32x2*)(L + vso) = (u32x2){v0.x, v0.y}; *(LAS u32x2*)(L + vso2) = (u32x2){v0.z, v0.w}; *(LAS u32x2*)(L + vso + 64 * VS_STRIDE) = (u32x2){v1.x, v1.y}; *(LAS u32x2*)(L + vso2 + 64 * VS_STRIDE) = (u32x2){v1.z, v1.w};
    __syncthreads();
    for (int kt = 0; kt < nkb; ++kt) {
        const LAS bf16_t* Lc = L + (kt & 1) * ATT_BUF;
        LAS bf16_t* Ln = L + ((kt + 1) & 1) * ATT_BUF;
        const bool more = kt + 1 < nkb;
        if (more) { const bf16_t* kn = kg + (size_t)(kt + 1) * 64 * 512; const bf16_t* vn = vg + (kt + 1) * 64;
            k0 = *(const u32x4*)kn; k1 = *(const u32x4*)(kn + 32 * 512); v0 = *(const u32x4*)vn; v1 = *(const u32x4*)(vn + (size_t)64 * TP); }
        if (kt < nkt) {
            bf16x8 bP[2][2];
            const LAS bf16_t* kl = Lc + q * KS_STRIDE + 8 * g;
            att_qk(A, [&](int mm, int ks, int t) { return *(const LAS bf16x8*)(kl + t * 16 * KS_STRIDE + mm * 64 + ks * 32); }, bq, 64, g, bP);
            const LAS bf16_t* vl = Lc + 64 * KS_STRIDE + q * VS_STRIDE + 8 * g;
#pragma unroll
            for (int d = 0; d < 8; ++d)
#pragma unroll
                for (int k2 = 0; k2 < 2; ++k2) {
                    const bf16x8 vf = *(const LAS bf16x8*)(vl + d * 16 * VS_STRIDE + 32 * k2);
                    A.O[0][d] = MFMA16(vf, bP[0][k2], A.O[0][d]); A.O[1][d] = MFMA16(vf, bP[1][k2], A.O[1][d]);
                }
        }
        if (more) { *(LAS u32x4*)(Ln + kso) = k0; *(LAS u32x4*)(Ln + kso + 32 * KS_STRIDE) = k1; *(LAS u32x2*)(Ln + vso) = (u32x2){v0.x, v0.y}; *(LAS u32x2*)(Ln + vso2) = (u32x2){v0.z, v0.w}; *(LAS u32x2*)(Ln + vso + 64 * VS_STRIDE) = (u32x2){v1.x, v1.y}; *(LAS u32x2*)(Ln + vso2 + 64 * VS_STRIDE) = (u32x2){v1.z, v1.w}; }
        __syncthreads();
    }
    float l0 = A.l[0], l1 = A.l[1];
    l0 += __shfl_xor(l0, 16); l0 += __shfl_xor(l0, 32); l1 += __shfl_xor(l1, 16); l1 += __shfl_xor(l1, 32);
    const float lam = att_lambda(p, lane);
    att_final(A, l0, l1, lam, p.in(16), qrow, g);
}
__device__ __forceinline__ bf16x8 cvt8(const float* s) {
    const f32x4 a = *(const f32x4*)s, b = *(const f32x4*)(s + 4);
    u32x4 w; w.x = pk2(a[0], a[1]); w.y = pk2(a[2], a[3]); w.z = pk2(b[0], b[1]); w.w = pk2(b[2], b[3]);
    return __builtin_bit_cast(bf16x8, w);
}
__device__ __forceinline__ void att_sample_unit(const Ctx& p, int bs, int h, LAS unsigned char* lds) {
    const int tid = threadIdx.x, lane = tid & 63, wave = __builtin_amdgcn_readfirstlane(tid >> 6), q = lane & 15, g = lane >> 4;
    bf16_t* QB = (bf16_t*)(p.ws() + WS_QB);
    const int row = MPR + bs * 16 + q;
    bf16_t* qrow = QB + (size_t)row * 512 + h * 128;
    bf16x8 bq[2][2];
#pragma unroll
    for (int mm = 0; mm < 2; ++mm)
#pragma unroll
        for (int ks = 0; ks < 2; ++ks) bq[mm][ks] = *(const bf16x8*)(qrow + mm * 64 + ks * 32 + 8 * g);
    AttAcc A; att_init(A);
    for (int kt = wave; kt < 65; kt += 8) {
        const bool isnew = kt == 64;
        const float* kb = isnew ? p.out() + O_KS + (size_t)bs * 16 * 512 : p.in(2) + ((size_t)bs * PAST + kt * 64) * 512;
        const float* vb = isnew ? p.out() + O_VS + (size_t)bs * 16 * 512 : p.in(3) + ((size_t)bs * PAST + kt * 64) * 512;
        const int nvalid = isnew ? 16 : 64;
        bf16x8 bP[2][2];
        att_qk(A, [&](int mm, int ks, int t) { const int key = min(16 * t + q, nvalid - 1); return cvt8(kb + (key * 512 + h * 128 + mm * 64 + ks * 32 + 8 * g)); }, bq, nvalid, g, bP);
#pragma unroll
        for (int d = 0; d < 8; ++d)
#pragma unroll
            for (int k2 = 0; k2 < 2; ++k2) {
                float v[8];
#pragma unroll
                for (int e = 0; e < 8; ++e) { const int key = min(32 * k2 + (e >> 2) * 16 + 4 * g + (e & 3), nvalid - 1); v[e] = vb[key * 512 + h * 128 + 16 * d + q]; }
                u32x4 w; w.x = pk2(v[0], v[1]); w.y = pk2(v[2], v[3]); w.z = pk2(v[4], v[5]); w.w = pk2(v[6], v[7]);
                const bf16x8 vf = __builtin_bit_cast(bf16x8, w);
                A.O[0][d] = MFMA16(vf, bP[0][k2], A.O[0][d]); A.O[1][d] = MFMA16(vf, bP[1][k2], A.O[1][d]);
                if (k2 == 1 && (d & 1)) asm volatile("" ::: "memory");
            }
    }
    float l0 = A.l[0], l1 = A.l[1];
    l0 += __shfl_xor(l0, 16); l0 += __shfl_xor(l0, 32); l1 += __shfl_xor(l1, 16); l1 += __shfl_xor(l1, 32);
    LAS float* Ob = (LAS float*)lds; LAS float* ML = Ob + 8 * 2 * 8 * 4 * 64;
#pragma unroll
    for (int mm = 0; mm < 2; ++mm)
#pragma unroll
        for (int d = 0; d < 8; ++d)
#pragma unroll
            for (int r = 0; r < 4; ++r) Ob[((((wave * 2 + mm) * 8 + d) * 4 + r) << 6) + lane] = A.O[mm][d][r];
    ML[(wave * 4 + 0) * 64 + lane] = A.m[0]; ML[(wave * 4 + 1) * 64 + lane] = A.m[1]; ML[(wave * 4 + 2) * 64 + lane] = l0; ML[(wave * 4 + 3) * 64 + lane] = l1;
    __syncthreads();
    {
        float ms0 = -1e30f, ms1 = -1e30f;
#pragma unroll
        for (int w = 0; w < 8; ++w) { ms0 = fmaxf(ms0, ML[(w * 4 + 0) * 64 + lane]); ms1 = fmaxf(ms1, ML[(w * 4 + 1) * 64 + lane]); }
        float L0 = 0.f, L1 = 0.f; f32x4 o0 = (f32x4){0.f, 0.f, 0.f, 0.f}, o1 = o0;
#pragma unroll
        for (int w = 0; w < 8; ++w) {
            const float f0 = fexp2(ML[(w * 4 + 0) * 64 + lane] - ms0), f1 = fexp2(ML[(w * 4 + 1) * 64 + lane] - ms1);
            L0 += ML[(w * 4 + 2) * 64 + lane] * f0; L1 += ML[(w * 4 + 3) * 64 + lane] * f1;
#pragma unroll
            for (int r = 0; r < 4; ++r) { o0[r] += Ob[((((w * 2 + 0) * 8 + wave) * 4 + r) << 6) + lane] * f0; o1[r] += Ob[((((w * 2 + 1) * 8 + wave) * 4 + r) << 6) + lane] * f1; }
        }
        const float lam = att_lambda(p, lane);
        const f32x4 o = o0 * (1.f / L0) - o1 * (lam / L1);
        float ss = (o[0] * o[0] + o[1] * o[1]) + (o[2] * o[2] + o[3] * o[3]);
        ss += __shfl_xor(ss, 16); ss += __shfl_xor(ss, 32);
        LAS float* SS = ML + 8 * 4 * 64;
        SS[wave * 64 + lane] = ss;
        __syncthreads();
        float tot = 0.f;
#pragma unroll
        for (int w = 0; w < 8; ++w) tot += SS[w * 64 + lane];
        const float rs = 0.8f / sqrtf(tot * (1.f / 128.f) + EPS);
        const f32x4 gg = *(const f32x4*)(p.in(16) + 16 * wave + 4 * g);
        u32x2 wv; wv.x = pk2(o[0] * rs * gg[0], o[1] * rs * gg[1]); wv.y = pk2(o[2] * rs * gg[2], o[3] * rs * gg[3]);
        *(u32x2*)(qrow + 16 * wave + 4 * g) = wv;
    }
    __syncthreads();
}

template <int CTRL> __device__ __forceinline__ float dpp_add(float x) {
    return x + __builtin_bit_cast(float, __builtin_amdgcn_update_dpp(0, __builtin_bit_cast(int, x), CTRL, 0xf, 0xf, true));
}
__device__ __forceinline__ float sum16(float x) { x = dpp_add<0xB1>(x); x = dpp_add<0x4E>(x); x = dpp_add<0x141>(x); x = dpp_add<0x140>(x); return x; }
__device__ __forceinline__ float sum8(float x) { x = dpp_add<0xB1>(x); x = dpp_add<0x4E>(x); x = dpp_add<0x141>(x); return x; }
__device__ __forceinline__ void unpack4(const u32x2 w, float (&f)[4]) { f[0] = bflo(w.x); f[1] = bfhi(w.x); f[2] = bflo(w.y); f[3] = bfhi(w.y); }
__device__ __forceinline__ void zshift4(const Ctx& p, const bf16_t* ZRW, int row, int c, const float (&mu)[4], float (&o)[4]) {
    float z[4], pv[4];
    unpack4(*(const u32x2*)(ZRW + (size_t)row * SHW + c), z);
    bool first; int bsmp = 0;
    if (row < MPR) first = (row & (TP - 1)) == 0; else { first = ((row - MPR) & 15) == 0; bsmp = (row - MPR) >> 4; }
    if (!first) unpack4(*(const u32x2*)(ZRW + (size_t)(row - 1) * SHW + c), pv);
    else if (row < MPR) { pv[0] = 0.f; pv[1] = 0.f; pv[2] = 0.f; pv[3] = 0.f; }
    else { const f32x4 s0 = *(const f32x4*)(p.in(5) + (size_t)bsmp * SHW + c); pv[0] = s0[0]; pv[1] = s0[1]; pv[2] = s0[2]; pv[3] = s0[3]; }
#pragma unroll
    for (int e = 0; e < 4; ++e) o[e] = z[e] + (pv[e] - z[e]) * mu[e];
}
constexpr int SCH = 16, SBUF_F = SCH * (320 + 16), YP_F = SCH * 16 * 16;
struct ScanOps { f32x4 w, kk, ka, kp, rr; float v; };
__device__ __forceinline__ void scan_load(ScanOps& o, const LAS float* OP, const LAS float* VP, int t) {
    o.w = *(const LAS f32x4*)(OP + t * 320); o.kk = *(const LAS f32x4*)(OP + t * 320 + 64); o.ka = *(const LAS f32x4*)(OP + t * 320 + 128);
    o.kp = *(const LAS f32x4*)(OP + t * 320 + 192); o.rr = *(const LAS f32x4*)(OP + t * 320 + 256);
}
__device__ __forceinline__ void scan_step(f32x4& S, const ScanOps& o, LAS float* yp) {
    f32x2 S0 = {S[0], S[1]}, S1 = {S[2], S[3]};
    const f32x2 k0 = {o.kk[0], o.kk[1]}, k1 = {o.kk[2], o.kk[3]};
    f32x2 t = S0 * k0; t = S1 * k1 + t;
    const float sa = -sum16(t[0] + t[1]);
    const f32x2 sav = {sa, sa}, vv = {o.v, o.v};
    const f32x2 a0 = {o.ka[0], o.ka[1]}, a1 = {o.ka[2], o.ka[3]}, p0 = {o.kp[0], o.kp[1]}, p1 = {o.kp[2], o.kp[3]}, w0 = {o.w[0], o.w[1]}, w1 = {o.w[2], o.w[3]};
    f32x2 u0 = a0 * sav; u0 = p0 * vv + u0; S0 = S0 * w0 + u0;
    f32x2 u1 = a1 * sav; u1 = p1 * vv + u1; S1 = S1 * w1 + u1;
    const f32x2 r0 = {o.rr[0], o.rr[1]}, r1 = {o.rr[2], o.rr[3]};
    f32x2 y = S0 * r0; y = S1 * r1 + y;
    *yp = y[0] + y[1];
    S = (f32x4){S0[0], S0[1], S1[0], S1[1]};
}
__device__ __forceinline__ void scan_unit(const Ctx& p, int chain, int rq, LAS unsigned char* lds) {
    const int tid = threadIdx.x, lane = tid & 63, wave = __builtin_amdgcn_readfirstlane(tid >> 6);
    const bool smp = chain >= 32;
    const int cb = smp ? (chain - 32) >> 3 : chain >> 3, h = chain & 7, T = smp ? TS : TP, row0 = smp ? MPR + cb * TS : cb * TP;
    const int nch = T / SCH;
    const bf16_t* ZRW = (const bf16_t*)(p.ws() + WS_ZRW);
    const float* DEC = (const float*)(p.ws() + WS_DEC); const bf16_t* AB = (const bf16_t*)(p.ws() + WS_ABUF);
    bf16_t* ORW = (bf16_t*)(p.ws() + WS_ORW);
    LAS float* B0 = (LAS float*)lds; LAS float* YB = B0 + 2 * SBUF_F;
    __syncthreads();
    if (wave >= 4) {
        const int ht = tid - 256, tt = ht >> 4, cg4 = ht & 15, c0 = h * 64 + 4 * cg4;
        float mur[4], muk[4], muv[4], kkc[4], kac[4];
#pragma unroll
        for (int e = 0; e < 4; ++e) { mur[e] = p.in(17)[c0 + e]; muk[e] = p.in(17)[512 + c0 + e]; kkc[e] = p.in(23)[c0 + e]; kac[e] = p.in(24)[c0 + e]; }
        const int vc0 = h * 64 + 16 * rq + 4 * (cg4 & 3);
#pragma unroll
        for (int e = 0; e < 4; ++e) muv[e] = p.in(17)[1024 + vc0 + e];
        const bool hasv = cg4 < 4;
        struct HReg { u32x2 zr, zrp, zk, zkp, ab, zv, zvp; f32x4 dec; };
        auto issue = [&](HReg& R, int c) {
            const int row = row0 + c * SCH + tt, rp = row > 0 ? row - 1 : 0;
            R.zr = *(const u32x2*)(ZRW + (size_t)row * SHW + c0); R.zrp = *(const u32x2*)(ZRW + (size_t)rp * SHW + c0);
            R.zk = *(const u32x2*)(ZRW + (size_t)row * SHW + 512 + c0); R.zkp = *(const u32x2*)(ZRW + (size_t)rp * SHW + 512 + c0);
            R.ab = *(const u32x2*)(AB + (size_t)row * 512 + c0); R.dec = *(const f32x4*)(DEC + (size_t)row * 512 + c0);
            R.zv = (u32x2){0u, 0u}; R.zvp = (u32x2){0u, 0u};
            if (hasv) { R.zv = *(const u32x2*)(ZRW + (size_t)row * SHW + 1024 + vc0); R.zvp = *(const u32x2*)(ZRW + (size_t)rp * SHW + 1024 + vc0); }
        };
        auto commit = [&](const HReg& R, int c) {
            float zr[4], pr[4], zk[4], pk[4], a[4], zv[4], pv[4];
            unpack4(R.zr, zr); unpack4(R.zrp, pr); unpack4(R.zk, zk); unpack4(R.zkp, pk); unpack4(R.ab, a); unpack4(R.zv, zv); unpack4(R.zvp, pv);
            if (c == 0 && tt == 0) {
#pragma unroll
                for (int e = 0; e < 4; ++e) { pr[e] = 0.f; pk[e] = 0.f; pv[e] = 0.f; }
                if (smp) { const float* s0 = p.in(5) + (size_t)cb * SHW;
#pragma unroll
                    for (int e = 0; e < 4; ++e) { pr[e] = s0[c0 + e]; pk[e] = s0[512 + c0 + e]; pv[e] = s0[1024 + vc0 + e]; } }
            }
            float r[4], k[4], kk[4], n2 = 0.f;
#pragma unroll
            for (int e = 0; e < 4; ++e) { r[e] = zr[e] + (pr[e] - zr[e]) * mur[e]; k[e] = zk[e] + (pk[e] - zk[e]) * muk[e]; kk[e] = k[e] * kkc[e]; n2 += kk[e] * kk[e]; }
            n2 = sum16(n2);
            const float inv = __builtin_amdgcn_rsqf(fmaxf(n2, 1e-24f));
            float ka[4], kp[4];
#pragma unroll
            for (int e = 0; e < 4; ++e) { kk[e] *= inv; ka[e] = kk[e] * a[e]; kp[e] = k[e] * (1.f + (a[e] - 1.f) * kac[e]); }
            LAS float* OP = B0 + (c & 1) * SBUF_F + tt * 320 + 4 * cg4;
            *(LAS f32x4*)(OP) = R.dec;
            *(LAS f32x4*)(OP + 64) = (f32x4){kk[0], kk[1], kk[2], kk[3]};
            *(LAS f32x4*)(OP + 128) = (f32x4){ka[0], ka[1], ka[2], ka[3]};
            *(LAS f32x4*)(OP + 192) = (f32x4){kp[0], kp[1], kp[2], kp[3]};
            *(LAS f32x4*)(OP + 256) = (f32x4){r[0], r[1], r[2], r[3]};
            if (hasv) { LAS float* VW = B0 + (c & 1) * SBUF_F + SCH * 320 + (4 * cg4) * 16 + tt;
#pragma unroll
                for (int e = 0; e < 4; ++e) VW[e * 16] = zv[e] + (pv[e] - zv[e]) * muv[e]; }
        };
        auto yout = [&](int c) {
            const LAS float* Y = YB + (c & 1) * YP_F + (tt * 16 + cg4) * 16;
            const f32x4 y0 = *(const LAS f32x4*)Y, y1 = *(const LAS f32x4*)(Y + 4), y2 = *(const LAS f32x4*)(Y + 8), y3 = *(const LAS f32x4*)(Y + 12);
            const f32x4 ys = (y0 + y1) + (y2 + y3);
            ORW[(size_t)(row0 + c * SCH + tt) * 512 + h * 64 + 16 * rq + cg4] = f2bf((ys[0] + ys[1]) + (ys[2] + ys[3]));
        };
        HReg R0, R1;
        issue(R0, 0); if (nch > 1) issue(R1, 1);
        for (int ci = 0; ci <= nch; ci += 2) {
            if (ci < nch) { commit(R0, ci); if (ci + 2 < nch) issue(R0, ci + 2); }
            __syncthreads();
            if (ci > 0) yout(ci - 1);
            if (ci + 1 <= nch) {
                if (ci + 1 < nch) { commit(R1, ci + 1); if (ci + 3 < nch) issue(R1, ci + 3); }
                __syncthreads();
                yout(ci);
            }
        }
    } else {
        const int rl = lane >> 4, cl = lane & 15, il = 4 * wave + rl;
        f32x4 S;
        float* sg = (smp ? p.out() + O_SS : p.out() + O_SP) + ((size_t)(cb * 8 + h) * 64 + 16 * rq + il) * 64 + 4 * cl;
        if (smp) S = *(const f32x4*)(p.in(4) + ((size_t)(cb * 8 + h) * 64 + 16 * rq + il) * 64 + 4 * cl); else S = (f32x4){0.f, 0.f, 0.f, 0.f};
        for (int ci = 0; ci < nch; ++ci) {
            __syncthreads();
            const LAS float* OP = B0 + (ci & 1) * SBUF_F + 4 * cl;
            const LAS float* VP = B0 + (ci & 1) * SBUF_F + SCH * 320 + il * 16;
            LAS float* Y = YB + (ci & 1) * YP_F + il * 16 + cl;
            ScanOps oa, ob;
            scan_load(oa, OP, VP, 0);
            f32x2 vv = *(const LAS f32x2*)VP;
#pragma unroll 1
            for (int t = 0; t < SCH; t += 2) {
                scan_load(ob, OP, VP, t + 1);
                oa.v = vv[0]; ob.v = vv[1];
                scan_step(S, oa, Y + t * 256);
                scan_load(oa, OP, VP, (t + 2) & (SCH - 1));
                vv = *(const LAS f32x2*)(VP + ((t + 2) & (SCH - 1)));
                scan_step(S, ob, Y + (t + 1) * 256);
            }
        }
        __syncthreads();
        *(f32x4*)sg = S;
    }
}
__device__ __forceinline__ void phase_lnpass(const Ctx& p) {
    const int tid = threadIdx.x, c8 = tid & 7, h = (tid >> 3) & 7, rr = tid >> 6, c = h * 64 + 8 * c8;
    const bf16_t* ZRW = (const bf16_t*)(p.ws() + WS_ZRW); const bf16_t* AB = (const bf16_t*)(p.ws() + WS_ABUF); const bf16_t* GG = (const bf16_t*)(p.ws() + WS_GG);
    bf16_t* ORW = (bf16_t*)(p.ws() + WS_ORW);
    float mur[8], muk[8], muv[8], kac[8], rkc[8], lg[8], lb[8];
#pragma unroll
    for (int e = 0; e < 8; ++e) { mur[e] = p.in(17)[c + e]; muk[e] = p.in(17)[512 + c + e]; muv[e] = p.in(17)[1024 + c + e]; kac[e] = p.in(24)[c + e]; rkc[e] = p.in(25)[c + e]; lg[e] = p.in(26)[c + e]; lb[e] = p.in(27)[c + e]; }
    struct LR { u32x4 zr, zrp, zk, zkp, zv, zvp, ab, gg, yy; };
    auto ldrow = [&](LR& L, int row) {
        const int rp = row > 0 ? row - 1 : 0;
        L.zr = *(const u32x4*)(ZRW + (size_t)row * SHW + c); L.zrp = *(const u32x4*)(ZRW + (size_t)rp * SHW + c);
        L.zk = *(const u32x4*)(ZRW + (size_t)row * SHW + 512 + c); L.zkp = *(const u32x4*)(ZRW + (size_t)rp * SHW + 512 + c);
        L.zv = *(const u32x4*)(ZRW + (size_t)row * SHW + 1024 + c); L.zvp = *(const u32x4*)(ZRW + (size_t)rp * SHW + 1024 + c);
        L.ab = *(const u32x4*)(AB + (size_t)row * 512 + c); L.gg = *(const u32x4*)(GG + (size_t)row * 512 + c); L.yy = *(const u32x4*)(ORW + (size_t)row * 512 + c);
    };
    LR La, Lb;
    if ((int)blockIdx.x < MR / 8) ldrow(La, blockIdx.x * 8 + rr);
    for (int it = blockIdx.x; it < MR / 8; it += gridDim.x) {
        const int row = it * 8 + rr;
        const bool more = it + (int)gridDim.x < MR / 8;
        if (more) ldrow(Lb, (it + gridDim.x) * 8 + rr);
        float zr[8], pr[8], zk[8], pk[8], zv[8], pv[8], a[8], g[8], y[8];
        unpack8(La.zr, zr); unpack8(La.zrp, pr); unpack8(La.zk, zk); unpack8(La.zkp, pk); unpack8(La.zv, zv); unpack8(La.zvp, pv); unpack8(La.ab, a); unpack8(La.gg, g); unpack8(La.yy, y);
        const bool first = row < MPR ? (row & (TP - 1)) == 0 : ((row - MPR) & 15) == 0;
        if (first) {
#pragma unroll
            for (int e = 0; e < 8; ++e) { pr[e] = 0.f; pk[e] = 0.f; pv[e] = 0.f; }
            if (row >= MPR) { const float* s0 = p.in(5) + (size_t)((row - MPR) >> 4) * SHW;
#pragma unroll
                for (int e = 0; e < 8; ++e) { pr[e] = s0[c + e]; pk[e] = s0[512 + c + e]; pv[e] = s0[1024 + c + e]; } }
        }
        float r[8], k[8], v[8];
#pragma unroll
        for (int e = 0; e < 8; ++e) { r[e] = zr[e] + (pr[e] - zr[e]) * mur[e]; k[e] = zk[e] + (pk[e] - zk[e]) * muk[e]; v[e] = zv[e] + (pv[e] - zv[e]) * muv[e]; }
        float bon = 0.f, sy = 0.f;
#pragma unroll
        for (int e = 0; e < 8; ++e) { const float kp = k[e] * (1.f + (a[e] - 1.f) * kac[e]); bon += r[e] * kp * rkc[e]; sy += y[e]; }
        bon = sum8(bon);
        const float mu = sum8(sy) * (1.f / 64.f);
        float var = 0.f;
#pragma unroll
        for (int e = 0; e < 8; ++e) { y[e] -= mu; var += y[e] * y[e]; }
        var = sum8(var) * (1.f / 64.f);
        const float rs = 1.f / sqrtf(var + LNX_EPS);
        float o[8];
#pragma unroll
        for (int e = 0; e < 8; ++e) o[e] = (y[e] * rs * lg[e] + lb[e] + bon * v[e]) * g[e];
        u32x4 w; w.x = pk2(o[0], o[1]); w.y = pk2(o[2], o[3]); w.z = pk2(o[4], o[5]); w.w = pk2(o[6], o[7]);
        *(u32x4*)(ORW + (size_t)row * 512 + c) = w;
        if (more) La = Lb;
    }
}

__device__ __forceinline__ void ffn2_weights(const Ctx& p, LAS unsigned char* lds) {
    const int tid = threadIdx.x, lane = tid & 63, wave = __builtin_amdgcn_readfirstlane(tid >> 6);
    unsigned char* ws = p.ws();
    LAS float* scr = (LAS float*)(lds + wave * 16384);
    constexpr int I7 = 16 * 176, I8 = 44 * 32;
    __syncthreads();
    for (int it = ((int)blockIdx.x - 128) * 8 + wave; it < I7 + I8; it += 128 * 8) {
        int r = it;
        if (r < I7) { const int kb = r / 176, nb = r % 176; transpose_item(p.in(33), DM, NFF, (bf16_t*)(ws + WS_W3T), 64 * kb, 32 * nb, map_w1(32 * nb), scr, lane); continue; } r -= I7;
        { const int kb = r / 32, nb = r % 32; transpose_item(p.in(34), DFF, DM, (bf16_t*)(ws + WS_W4T), 64 * kb, 32 * nb, 32 * nb, scr, lane); }
    }
}
__device__ __forceinline__ void phase_mixer(const Ctx& p, LAS unsigned char* lds) {
    if (blockIdx.x < 128) scan_unit(p, blockIdx.x >> 2, blockIdx.x & 3, lds);
    else { const int u0 = (blockIdx.x - 128) * 2; scan_unit(p, 32 + (u0 >> 2), u0 & 3, lds); scan_unit(p, 32 + ((u0 + 1) >> 2), (u0 + 1) & 3, lds); }
    if (blockIdx.x < 128) return;
    unsigned* ctr = (unsigned*)(p.ws() + WS_CTR);
    LAS unsigned* su = (LAS unsigned*)(lds + 140 * 1024);
    for (;;) {
        __syncthreads();
        if (threadIdx.x == 0) su[0] = atomicAdd(ctr, 1u);
        __syncthreads();
        const int u = __builtin_amdgcn_readfirstlane((int)su[0]);
        if (u >= 32) break;
        att_sample_unit(p, u >> 2, u & 3, lds);
    }
    for (;;) {
        __syncthreads();
        if (threadIdx.x == 0) su[0] = atomicAdd(ctr + 1, 1u);
        __syncthreads();
        const int v = __builtin_amdgcn_readfirstlane((int)su[0]);
        if (v >= 512) break;
        att_prompt_unit(p, v & 15, 31 - (v >> 4), lds);
    }
    ffn2_weights(p, lds);
}

constexpr int LDS_BYTES = 147456;
constexpr int NPHASE = 15;
#ifndef SINGLE_LAUNCH
#define SINGLE_LAUNCH 1
#endif

#define XB_TMO      128
#define XB_XCNT(j)  (256  + 64 * (j))
#define XB_XSUB(j)  (1280 + 64 * (j))
#define XB_XGEN(j)  (2304 + 64 * (j))
#define XB_TOP      3328
#define XB_TOPGEN   3392
#define XCD_BAR_WORDS 3456
#define XB_SPIN_CAP (1u << 18)

__device__ __forceinline__ unsigned xb_ld(unsigned* p)              { return __hip_atomic_load(p, __ATOMIC_RELAXED, __HIP_MEMORY_SCOPE_AGENT); }
__device__ __forceinline__ unsigned xb_add(unsigned* p, unsigned v) { return __hip_atomic_fetch_add(p, v, __ATOMIC_RELAXED, __HIP_MEMORY_SCOPE_AGENT); }
__device__ __forceinline__ unsigned xb_xcc_id() { return (unsigned)__builtin_amdgcn_s_getreg((3 << 11) | 20) & 0xFu; }
#define XB_SPIN(cond, bar) do { unsigned _sp = 0; while (cond) { __builtin_amdgcn_s_sleep(1); \
    if ((++_sp & 255u) == 0u) { if (xb_ld(&(bar)[XB_TMO])) break; if (_sp > XB_SPIN_CAP) { atomicAdd(&(bar)[XB_TMO], 1u); break; } } } } while (0)

struct XcdBarrier {
    unsigned* bar; unsigned x;
    volatile LAS unsigned* st;
};

__device__ __forceinline__ XcdBarrier xcd_barrier_post(unsigned* bar, volatile LAS unsigned* st) {
    XcdBarrier b; b.bar = bar; b.x = xb_xcc_id(); b.st = st;
    if (threadIdx.x == 0) (void)xb_add(&bar[XB_XCNT(b.x)], 1u);
    return b;
}
__device__ __forceinline__ void xcd_barrier_complete(unsigned* bar, unsigned x, unsigned& nloc, unsigned& nx) {
    const unsigned G = gridDim.x * gridDim.y * gridDim.z;
    unsigned sum, cnt, mine, sp = 0u;
    for (;;) {
        sum = 0u; cnt = 0u; mine = 0u;
#pragma unroll
        for (unsigned j = 0; j < 16; ++j) { const unsigned c = xb_ld(&bar[XB_XCNT(j)]); sum += c; cnt += (c > 0u) ? 1u : 0u; mine = (j == x) ? c : mine; }
        if (sum == G) break;
        __builtin_amdgcn_s_sleep(1);
        if ((++sp & 255u) == 0u) { if (xb_ld(&bar[XB_TMO])) break; if (sp > XB_SPIN_CAP) { atomicAdd(&bar[XB_TMO], 1u); break; } }
    }
    nloc = mine > 0u ? mine : 1u; nx = cnt > 0u ? cnt : 1u;
}

__device__ __forceinline__ void xcd_barrier(const XcdBarrier& b) {
    asm volatile("s_waitcnt vmcnt(0)" ::: "memory");
    __syncthreads();
    if (threadIdx.x == 0) {
        unsigned* bar = b.bar;
        __builtin_amdgcn_s_waitcnt(0);
        unsigned nloc = b.st[0], nx = b.st[1];
        if (nloc == 0u) { xcd_barrier_complete(bar, b.x, nloc, nx); b.st[0] = nloc; b.st[1] = nx; }
        const unsigned old = xb_add(&bar[XB_XSUB(b.x)], 1u);
        const unsigned gen = old / nloc;
        if (old + 1u == (gen + 1u) * nloc) {
            __builtin_amdgcn_fence(__ATOMIC_RELEASE, "agent");
            asm volatile("s_waitcnt vmcnt(0)" ::: "memory");
            const unsigned og = xb_add(&bar[XB_TOP], 1u);
            const unsigned tg = og / nx;
            if (og + 1u == (tg + 1u) * nx) xb_add(&bar[XB_TOPGEN], 1u);
            else XB_SPIN(xb_ld(&bar[XB_TOPGEN]) == tg, bar);
            __builtin_amdgcn_fence(__ATOMIC_ACQUIRE, "agent");
            xb_add(&bar[XB_XGEN(b.x)], 1u);
            asm volatile("s_waitcnt vmcnt(0)" ::: "memory");
        } else {
            XB_SPIN(xb_ld(&bar[XB_XGEN(b.x)]) == gen, bar);
            __builtin_amdgcn_fence(__ATOMIC_ACQUIRE, "agent");
            asm volatile("s_waitcnt vmcnt(0)" ::: "memory");
        }
    }
    __syncthreads();
}

__device__ __forceinline__ void grid_bar(const Ctx& p, unsigned k) {
    asm volatile("s_waitcnt vmcnt(0)" ::: "memory");
    __syncthreads();
    if (threadIdx.x == 0) {
        unsigned* ctr = (unsigned*)(p.ws() + WS_CTR) + 64;
        __builtin_amdgcn_fence(__ATOMIC_RELEASE, "agent");
        asm volatile("s_waitcnt vmcnt(0)" ::: "memory");
        __hip_atomic_fetch_add(ctr, 1u, __ATOMIC_RELAXED, __HIP_MEMORY_SCOPE_AGENT);
        const unsigned target = k * gridDim.x;
        while (__hip_atomic_load(ctr, __ATOMIC_RELAXED, __HIP_MEMORY_SCOPE_AGENT) < target) __builtin_amdgcn_s_sleep(1);
        __builtin_amdgcn_fence(__ATOMIC_ACQUIRE, "agent");
        asm volatile("s_waitcnt vmcnt(0)" ::: "memory");
    }
    __syncthreads();
}
__device__ __forceinline__ void sub_barrier(const Ctx& p, unsigned n) {
    asm volatile("s_waitcnt vmcnt(0)" ::: "memory");
    __syncthreads();
    if (threadIdx.x == 0) {
        unsigned* c = (unsigned*)(p.ws() + WS_CTR) + 128;
        __builtin_amdgcn_fence(__ATOMIC_RELEASE, "agent");
        asm volatile("s_waitcnt vmcnt(0)" ::: "memory");
        __hip_atomic_fetch_add(c, 1u, __ATOMIC_RELAXED, __HIP_MEMORY_SCOPE_AGENT);
        while (__hip_atomic_load(c, __ATOMIC_RELAXED, __HIP_MEMORY_SCOPE_AGENT) < n) __builtin_amdgcn_s_sleep(2);
        __builtin_amdgcn_fence(__ATOMIC_ACQUIRE, "agent");
        asm volatile("s_waitcnt vmcnt(0)" ::: "memory");
    }
    __syncthreads();
}
template <class Epi> __device__ __forceinline__ void run_gemm(LAS unsigned char* lds, const bf16_t* A, const bf16_t* Bt, int N, int K, const Epi& E, int M = MP) {
    pg8::Gemm g{A, Bt, M, N, K, K}; pg8::StaticOrder S; S.init(M, N, (int)gridDim.x, (int)blockIdx.x);
    pg8::gemm_phase<Epi, pg8::StaticOrder, true, true>(lds, g, S, E);
}
struct OneUnit { int pn; bool on;
    __device__ __forceinline__ bool next(int i, pg8::Unit& u) const { if (i > 0 || !on) return false; u.pm = 0; u.pn = pn; return true; }
    __device__ __forceinline__ void a_ready(const pg8::Unit&) const {}
    __device__ __forceinline__ void done(const pg8::Unit&) const {} };
struct EpiPart {
    static constexpr bool PERM = false, AFTER_DRAIN = false;
    float* O;
    __device__ __forceinline__ void operator()(const f32x4 (&acc)[2][2][4][2], const Unit& u, int wr, int wc, int fr, int fq) const {
        const int col0 = u.pn * 256 + wc * 32 + 4 * fq;
#pragma unroll
        for (int m = 0; m < 4; ++m) {
            const int row = wr * 64 + m * 16 + fr;
#pragma unroll
            for (int bj = 0; bj < 2; ++bj)
#pragma unroll
                for (int n = 0; n < 2; ++n) *(f32x4*)(O + (size_t)row * DM + col0 + bj * 128 + n * 16) = acc[0][bj][m][n];
            asm volatile("" ::: "memory");
        }
    }
};
constexpr size_t WS_PART = 240 * MiB;
constexpr int KSL = 256;
__device__ __forceinline__ void run_gemm_sample(LAS unsigned char* lds, const bf16_t* A, const bf16_t* Bt, int K, float* PART) {
    const int c = (int)blockIdx.x, ns = K / KSL, ks = c >> 2;
    OneUnit S{c & 3, c < 4 * ns};
    pg8::Gemm g{A + (size_t)MPR * K + (size_t)ks * KSL, Bt + (size_t)ks * KSL, 256, DM, KSL, K};
    EpiPart E{PART + (size_t)ks * 128 * DM};
    pg8::gemm_phase<EpiPart, OneUnit, false, true>(lds, g, S, E);
}

__global__ void __launch_bounds__(512) fwd_kernel(Params prm) {
    extern __shared__ __attribute__((aligned(16))) unsigned char lds_raw[];
    LAS unsigned char* lds = (LAS unsigned char*)lds_raw;
    cg::grid_group grid = cg::this_grid();
    const int lo = prm.ph_lo, hi = prm.ph_hi;
    {   LAS unsigned long long* tab = (LAS unsigned long long*)(lds + 141 * 1024);
        if (threadIdx.x < 36) tab[threadIdx.x] = (unsigned long long)prm.in[threadIdx.x];
        if (threadIdx.x == 36) tab[36] = (unsigned long long)prm.out;
        if (threadIdx.x == 37) tab[37] = (unsigned long long)prm.ws;
        __syncthreads(); }
    Ctx p{(const LAS unsigned*)(lds + 141 * 1024)};
volatile LAS unsigned* bst = (volatile LAS unsigned*)(lds + 142 * 1024);
    if (threadIdx.x < 2) bst[threadIdx.x] = 0u;
    __syncthreads();
    XcdBarrier bar = xcd_barrier_post((unsigned*)(p.ws() + WS_CTR) + 1024, bst);
#define ws (p.ws())
#define IN(k) (lo <= (k) && (k) < hi)
#define SEAM(k) do { if (IN(k) && IN((k) + 1)) xcd_barrier(bar); } while (0)
    unsigned nbar = 0;
    if (IN(0)) { phase_prologue(p, lds); } if (IN(0) && IN(1)) grid.sync();
    if (IN(1)) { EpiSwiglu E{(bf16_t*)(ws + WS_G)}; run_gemm(lds, (const bf16_t*)(ws + WS_XN), (const bf16_t*)(ws + WS_W1T), NFF, DM, E);
        { constexpr int NFULL = (MP / 256) * (NFF / 256) - 5 * 256;
          if ((int)blockIdx.x >= NFULL) prologue_part2(p, lds, (int)blockIdx.x - NFULL, 256 - NFULL); } } SEAM(1);
    if (IN(2)) { EpiF32 E{(float*)(ws + WS_F)}; run_gemm(lds, (const bf16_t*)(ws + WS_G), (const bf16_t*)(ws + WS_W2T), DM, DFF, E, MPR); run_gemm_sample(lds, (const bf16_t*)(ws + WS_G), (const bf16_t*)(ws + WS_W2T), DFF, (float*)(ws + WS_PART)); } SEAM(2);
    if (IN(3)) { phase_rowpass(p, (const float*)(ws + WS_F), 1, 0.5f, p.in(9), p.in(10), (bf16_t*)(ws + WS_XN), (const float*)(ws + WS_PART), DFF / KSL); } SEAM(3);
    if (IN(4)) { EpiZ E{p.out(), (bf16_t*)(ws + WS_QB), (bf16_t*)(ws + WS_KB), (bf16_t*)(ws + WS_VT), (bf16_t*)(ws + WS_ZRW), (bf16_t*)(ws + WS_GATE), (const f32x2*)(ws + WS_TAB)};
        run_gemm(lds, (const bf16_t*)(ws + WS_XN), (const bf16_t*)(ws + WS_WINT), INW, DM, E); } SEAM(4);
    if (IN(5)) { phase_lora(p, lds); } SEAM(5);
    if (IN(6)) { phase_mixer(p, lds);
        if (blockIdx.x >= 128) {
            sub_barrier(p, 128u);
            EpiGate1 E{(bf16_t*)(ws + WS_KB), (const bf16_t*)(ws + WS_GATE)};
            pg8::Gemm g{(const bf16_t*)(ws + WS_QB), (const bf16_t*)(ws + WS_WAT), MP, DM, 512, 512}; pg8::StaticOrder S; S.init(MP, DM, 128, (int)blockIdx.x - 128);
            pg8::gemm_phase<EpiGate1, pg8::StaticOrder, true, true>(lds, g, S, E);
        } } SEAM(6);
    if (IN(14)) { phase_lnpass(p); } if (IN(14) && IN(7)) xcd_barrier(bar);
    if (IN(8)) { EpiGate2 E{(const bf16_t*)(ws + WS_KB), (const bf16_t*)(ws + WS_GATE), (bf16_t*)(ws + WS_MG)}; run_gemm(lds, (const bf16_t*)(ws + WS_ORW), (const bf16_t*)(ws + WS_WRT), DM, 512, E); } SEAM(8);
    if (IN(9)) { EpiF32 E{(float*)(ws + WS_T)}; run_gemm(lds, (const bf16_t*)(ws + WS_MG), (const bf16_t*)(ws + WS_WOT), DM, DM, E, MPR); run_gemm_sample(lds, (const bf16_t*)(ws + WS_MG), (const bf16_t*)(ws + WS_WOT), DM, (float*)(ws + WS_PART)); } SEAM(9);
    if (IN(10)) { phase_rowpass(p, (const float*)(ws + WS_T), 0, 1.0f, p.in(31), p.in(32), (bf16_t*)(ws + WS_XN), (const float*)(ws + WS_PART), DM / KSL); } SEAM(10);
    if (IN(11)) { EpiSwiglu E{(bf16_t*)(ws + WS_G)}; run_gemm(lds, (const bf16_t*)(ws + WS_XN), (const bf16_t*)(ws + WS_W3T), NFF, DM, E); } SEAM(11);
    if (IN(12)) { EpiF32 E{(float*)(ws + WS_F)}; run_gemm(lds, (const bf16_t*)(ws + WS_G), (const bf16_t*)(ws + WS_W4T), DM, DFF, E, MPR); run_gemm_sample(lds, (const bf16_t*)(ws + WS_G), (const bf16_t*)(ws + WS_W4T), DFF, (float*)(ws + WS_PART)); } SEAM(12);
    if (IN(13)) { phase_rowpass(p, (const float*)(ws + WS_F), 0, 0.5f, p.in(35), nullptr, nullptr, (const float*)(ws + WS_PART), DFF / KSL); }
#undef IN
#undef SEAM
#undef ws
}

extern "C" void kernel_launch(void* const* d_in, const int* in_sizes, int n_in, void* d_out, int out_size, void* d_ws, size_t ws_size, hipStream_t stream) {
    static int grid = 0;
    if (grid == 0) {
        int dev = 0, cus = 0, per_cu = 0;
        (void)hipGetDevice(&dev);
        (void)hipDeviceGetAttribute(&cus, hipDeviceAttributeMultiprocessorCount, dev);
        (void)hipFuncSetAttribute((const void*)fwd_kernel, hipFuncAttributeMaxDynamicSharedMemorySize, LDS_BYTES);
        if (hipOccupancyMaxActiveBlocksPerMultiprocessor(&per_cu, (const void*)fwd_kernel, 512, LDS_BYTES) != hipSuccess || per_cu < 1) per_cu = 1;
        (void)hipGetLastError();
        grid = cus * per_cu;
        if (grid <= 0) grid = 256;
        if (n_in != 36 || (size_t)out_size != O_END || ws_size < WS_NEED) { fprintf(stderr, "kernel_launch: unexpected sizes n_in %d out %d ws %zu (need %zu)\n", n_in, out_size, ws_size, (size_t)WS_NEED); grid = -1; }
    }
    if (grid < 0) return;
    Params p{};
    for (int i = 0; i < 36; ++i) p.in[i] = (const float*)d_in[i];
    p.out = (float*)d_out; p.ws = (unsigned char*)d_ws;
    (void)hipMemsetAsync((unsigned char*)d_ws + WS_CTR, 0, 4096 + 3456 * 4, stream);
#if SINGLE_LAUNCH
    p.ph_lo = 0; p.ph_hi = NPHASE;
    void* args[] = {&p};
    hipError_t e = hipLaunchCooperativeKernel((const void*)fwd_kernel, dim3(grid), dim3(512), args, LDS_BYTES, stream);
    if (e != hipSuccess) fprintf(stderr, "cooperative launch failed: %s (grid %d)\n", hipGetErrorString(e), grid);
#else
    for (int ph = 0; ph < NPHASE; ++ph) { p.ph_lo = ph; p.ph_hi = ph + 1; hipLaunchKernelGGL(fwd_kernel, dim3(grid), dim3(512), LDS_BYTES, stream, p); }
#endif
}
```

```cpp
#include <hip/hip_runtime.h>
#include <hip/hip_cooperative_groups.h>
#include <cstdio>
#include <cstdint>
namespace cg = cooperative_groups;
namespace pg8 {
#define PG8_LAS __attribute__((address_space(3)))
typedef unsigned short bf16_t;
typedef short bf16x8 __attribute__((ext_vector_type(8)));
typedef float f32x4 __attribute__((ext_vector_type(4)));
typedef unsigned u32x4 __attribute__((ext_vector_type(4)));
constexpr int BM = 256, BK = 64, HALF = 128, HTB = HALF * BK * 2  , STAGE_BYTES = 8 * HTB, NXCD = 8, WGM = 8;

__host__ __device__ __forceinline__ int lds_byte(int r, int c) { const int st = (r >> 4) * 2 + (c >> 5), rr = r & 15, cc = c & 31, ob = rr * 64 + cc * 2; return st * 1024 + (ob ^ (((ob >> 9) & 1) << 5)); }
__host__ __device__ __forceinline__ void stage_rc(int b, int& R, int& C) { const int st = b / 1024, sb = b % 1024, swz = sb ^ (((sb >> 9) & 1) << 5); R = (st >> 1) * 16 + swz / 64; C = (st & 1) * 32 + (swz % 64) / 2; }
__host__ __device__ __forceinline__ int perm32(int rho) { const int n = rho >> 4, i = rho & 15; return 8 * (i >> 2) + 4 * n + (i & 3); }

struct Unit { int pm, pn; };
struct Gemm { const bf16_t* A; const bf16_t* Bt; int M, N, K, ld; };

struct StaticOrder {
    int nM, nN, nwg, G, c;
    __host__ __device__ void init(int M, int N, int G_, int c_) { nM = M / BM; nN = N / BM; nwg = nM * nN; G = G_; c = c_; }
    __host__ __device__ bool next(int i, Unit& u) const {
        const long L = (long)i * G + c; if (L >= nwg) return false;
        int wgid = (int)L; { const int q = nwg / NXCD, r = nwg % NXCD, xcd = wgid % NXCD, off = wgid / NXCD; wgid = (xcd < r ? xcd * (q + 1) : r * (q + 1) + (xcd - r) * q) + off; }
        const int nig = WGM * nN, gid = wgid / nig, fm = gid * WGM, gsz = (nM - fm) < WGM ? (nM - fm) : WGM;
        u.pm = fm + ((wgid % nig) % gsz); u.pn = (wgid % nig) / gsz; return true;
    }
    __device__ __forceinline__ void a_ready(const Unit&) const {}
    __device__ __forceinline__ void done(const Unit&) const {}
};

__device__ __forceinline__ unsigned cvt_pk_bf16(float lo, float hi) { unsigned r; asm volatile("v_cvt_pk_bf16_f32 %0, %1, %2" : "=v"(r) : "v"(lo), "v"(hi)); return r; }
typedef float f32x2 __attribute__((ext_vector_type(2)));
template <class Epi, class Sched, bool ALIGN_EPI = false, bool SP2 = false>
__device__ __forceinline__ void gemm_phase(PG8_LAS unsigned char* lds, const Gemm g, const Sched& S, const Epi& E) {
    const int tid = threadIdx.x, wid = __builtin_amdgcn_readfirstlane(tid >> 6), lane = tid & 63, wr = wid >> 2, wc = wid & 3, fr = lane & 15, fq = lane >> 4;
    const int K = g.K, nt = K / BK;
    unsigned voffA[2], voffB[2];
#pragma unroll
    for (int i = 0; i < 2; ++i) { int R, C; stage_rc(tid * 16 + i * 8192, R, C); const int Rb = Epi::PERM ? ((R & ~31) + perm32(R & 31)) : R;
        voffA[i] = (unsigned)(R * g.ld + C) * 2u; voffB[i] = (unsigned)(Rb * g.ld + C) * 2u; }
    const size_t kstep = (size_t)(BK * 2);
    const size_t hstep = (size_t)HALF * g.ld * 2;
    const size_t tstep = 2 * hstep;
    const unsigned ldsw = (unsigned)wid * 1024u;
    const int aoff = lds_byte(wr * 64 + fr, fq * 8), boff = lds_byte(wc * 32 + fr, fq * 8);
#define PG8_SA(b, h) (((b) * 2 + (h)) * HTB)
#define PG8_SB(b, h) ((4 + (b) * 2 + (h)) * HTB)
#define PG8_STAGE(bufoff, gbase, voff) do { _Pragma("unroll") for (int _i = 0; _i < 2; ++_i) \
        __builtin_amdgcn_global_load_lds((const unsigned*)((const char*)(gbase) + (voff)[_i]), (PG8_LAS unsigned*)(lds + (bufoff) + ldsw + _i * 8192), 16, 0, 0); } while (0)
#define PG8_LDA(dst, b, h) do { _Pragma("unroll") for (int m = 0; m < 4; ++m) _Pragma("unroll") for (int k = 0; k < 2; ++k) dst[m][k] = *(const PG8_LAS bf16x8*)(lds + PG8_SA(b, h) + aoff + m * 2048 + k * 1024); } while (0)
#define PG8_LDB(dst, b, h) do { _Pragma("unroll") for (int n = 0; n < 2; ++n) _Pragma("unroll") for (int k = 0; k < 2; ++k) dst[n][k] = *(const PG8_LAS bf16x8*)(lds + PG8_SB(b, h) + boff + n * 2048 + k * 1024); } while (0)
#define PG8_MMA(ai, bj, At, Bt) do { __builtin_amdgcn_s_setprio(1); _Pragma("unroll") for (int m = 0; m < 4; ++m) _Pragma("unroll") for (int n = 0; n < 2; ++n) _Pragma("unroll") for (int k = 0; k < 2; ++k) \
        acc[ai][bj][m][n] = __builtin_amdgcn_mfma_f32_16x16x32_bf16(Bt[n][k], At[m][k], acc[ai][bj][m][n], 0, 0, 0); __builtin_amdgcn_s_setprio(0); } while (0)
#define PG8_WAIT_V(n) asm volatile("s_waitcnt vmcnt(" #n ")" ::: "memory")
#define PG8_WAIT_L(n) asm volatile("s_waitcnt lgkmcnt(" #n ")" ::: "memory")
#define PG8_BAR __builtin_amdgcn_s_barrier()
#define PG8_SCHED __builtin_amdgcn_sched_barrier(0)
    Unit cur, nxt; int ui = 0;
    if (!S.next(0, cur)) return;
    f32x4 acc[2][2][4][2];
#pragma unroll
    for (int a = 0; a < 2; ++a)
#pragma unroll
        for (int b = 0; b < 2; ++b)
#pragma unroll
            for (int m = 0; m < 4; ++m)
#pragma unroll
                for (int n = 0; n < 2; ++n) acc[a][b][m][n] = (f32x4){0.f, 0.f, 0.f, 0.f};
    bf16x8 At[4][2], B0[2][2], B1[2][2];
    const char* cA = (const char*)g.A + (size_t)cur.pm * tstep; const char* cB = (const char*)g.Bt + (size_t)cur.pn * tstep;
    S.a_ready(cur);
    if constexpr (SP2) {
        PG8_STAGE(PG8_SB(0, 0), cB, voffB); PG8_STAGE(PG8_SB(0, 1), cB + hstep, voffB); PG8_STAGE(PG8_SA(0, 0), cA, voffA); PG8_STAGE(PG8_SA(0, 1), cA + hstep, voffA);
        if (wr == 1) PG8_BAR;
        PG8_WAIT_V(2); PG8_BAR;
        PG8_STAGE(PG8_SB(1, 0), cB + kstep, voffB); PG8_STAGE(PG8_SA(1, 0), cA + kstep, voffA); PG8_STAGE(PG8_SB(1, 1), cB + hstep + kstep, voffB);
        PG8_WAIT_V(6); PG8_BAR;
    } else {
        PG8_STAGE(PG8_SB(0, 0), cB, voffB); PG8_STAGE(PG8_SA(0, 0), cA, voffA); PG8_STAGE(PG8_SB(0, 1), cB + hstep, voffB); PG8_STAGE(PG8_SA(0, 1), cA + hstep, voffA);
        if (wr == 1) PG8_BAR;
        PG8_WAIT_V(4); PG8_BAR;
        PG8_STAGE(PG8_SB(1, 0), cB + kstep, voffB); PG8_STAGE(PG8_SA(1, 0), cA + kstep, voffA); PG8_STAGE(PG8_SB(1, 1), cB + hstep + kstep, voffB);
        PG8_WAIT_V(6); PG8_BAR;
    }
    for (;;) {
        const bool has_next = S.next(ui + 1, nxt);
        const char* nA = has_next ? (const char*)g.A + (size_t)nxt.pm * tstep : cA; const char* nB = has_next ? (const char*)g.Bt + (size_t)nxt.pn * tstep : cB;
        for (int t = 0; t < nt; t += 2) {
            const bool last = (t == nt - 2);
            const char* a1 = cA + (size_t)(t + 1) * kstep;
            const char* a2 = last ? nA : cA + (size_t)(t + 2) * kstep; const char* b2 = last ? nB : cB + (size_t)(t + 2) * kstep;
            const char* a3 = a2 + kstep; const char* b3 = b2 + kstep;
            if (last && has_next) S.a_ready(nxt);
            if constexpr (SP2) {
            PG8_LDB(B0, 0, 0); PG8_LDB(B1, 0, 1); PG8_SCHED; PG8_LDA(At, 0, 0); PG8_STAGE(PG8_SA(1, 1), a1 + hstep, voffA);
            PG8_WAIT_V(8); PG8_WAIT_L(0); PG8_BAR; PG8_MMA(0, 0, At, B0); PG8_MMA(0, 1, At, B1); PG8_BAR; PG8_SCHED;
            PG8_LDA(At, 0, 1); PG8_STAGE(PG8_SB(0, 0), b2, voffB); PG8_STAGE(PG8_SB(0, 1), b2 + hstep, voffB); PG8_STAGE(PG8_SA(0, 0), a2, voffA);
            PG8_WAIT_V(8); PG8_WAIT_L(0); PG8_BAR; PG8_MMA(1, 0, At, B0); PG8_MMA(1, 1, At, B1); PG8_BAR; PG8_SCHED;
            PG8_LDB(B0, 1, 0); PG8_LDB(B1, 1, 1); PG8_SCHED; PG8_LDA(At, 1, 0); PG8_STAGE(PG8_SA(0, 1), a2 + hstep, voffA);
            PG8_WAIT_V(8); PG8_WAIT_L(0); PG8_BAR; PG8_MMA(0, 0, At, B0); PG8_MMA(0, 1, At, B1); PG8_BAR; PG8_SCHED;
            PG8_LDA(At, 1, 1); PG8_STAGE(PG8_SB(1, 0), b3, voffB); PG8_STAGE(PG8_SB(1, 1), b3 + hstep, voffB); PG8_STAGE(PG8_SA(1, 0), a3, voffA);
            PG8_WAIT_V(8); PG8_WAIT_L(0); PG8_BAR; PG8_MMA(1, 0, At, B0); PG8_MMA(1, 1, At, B1); PG8_BAR; PG8_SCHED;
            } else {
            PG8_LDB(B0, 0, 0); PG8_SCHED; PG8_LDA(At, 0, 0); PG8_STAGE(PG8_SA(1, 1), a1 + hstep, voffA);
            PG8_WAIT_L(8); PG8_BAR; PG8_WAIT_L(0); PG8_MMA(0, 0, At, B0); PG8_BAR; PG8_SCHED;
            PG8_LDB(B1, 0, 1); PG8_STAGE(PG8_SB(0, 0), b2, voffB);
            PG8_BAR; PG8_WAIT_L(0); PG8_MMA(0, 1, At, B1); PG8_BAR;
            PG8_LDA(At, 0, 1); PG8_STAGE(PG8_SA(0, 0), a2, voffA);
            PG8_BAR; PG8_WAIT_L(0); PG8_MMA(1, 0, At, B0); PG8_BAR; PG8_SCHED;
            PG8_STAGE(PG8_SB(0, 1), b2 + hstep, voffB);
            PG8_WAIT_V(6); PG8_BAR; PG8_MMA(1, 1, At, B1); PG8_BAR;
            PG8_LDB(B0, 1, 0); PG8_SCHED; PG8_LDA(At, 1, 0); PG8_STAGE(PG8_SA(0, 1), a2 + hstep, voffA);
            PG8_WAIT_L(8); PG8_BAR; PG8_WAIT_L(0); PG8_MMA(0, 0, At, B0); PG8_BAR; PG8_SCHED;
            PG8_LDB(B1, 1, 1); PG8_STAGE(PG8_SB(1, 0), b3, voffB);
            PG8_BAR; PG8_WAIT_L(0); PG8_MMA(0, 1, At, B1); PG8_BAR;
            PG8_LDA(At, 1, 1); PG8_STAGE(PG8_SA(1, 0), a3, voffA);
            PG8_BAR; PG8_WAIT_L(0); PG8_MMA(1, 0, At, B0); PG8_BAR; PG8_SCHED;
            PG8_STAGE(PG8_SB(1, 1), b3 + hstep, voffB);
            PG8_WAIT_V(6); PG8_BAR; PG8_MMA(1, 1, At, B1); PG8_BAR;
            }
        }
        if constexpr (ALIGN_EPI) { if (wr == 0) PG8_BAR; }
        if constexpr (!Epi::AFTER_DRAIN) { E(acc, cur, wr, wc, fr, fq); S.done(cur); }
        if (!has_next) break;
#pragma unroll
        for (int a = 0; a < 2; ++a)
#pragma unroll
            for (int b = 0; b < 2; ++b)
#pragma unroll
                for (int m = 0; m < 4; ++m)
#pragma unroll
                    for (int n = 0; n < 2; ++n) acc[a][b][m][n] = (f32x4){0.f, 0.f, 0.f, 0.f};
        cur = nxt; cA = nA; cB = nB; ++ui;
        if constexpr (ALIGN_EPI) { if (wr == 1) PG8_BAR; }
    }
    PG8_WAIT_V(0);
    if constexpr (!ALIGN_EPI) { if (wr == 0) PG8_BAR; }
    PG8_BAR;
    if constexpr (Epi::AFTER_DRAIN) { E.fused(acc, cur, wr, wc, fr, fq, lds, wid, lane); S.done(cur); }
#undef PG8_SA
#undef PG8_SB
#undef PG8_STAGE
#undef PG8_LDA
#undef PG8_LDB
#undef PG8_MMA
#undef PG8_WAIT_V
#undef PG8_WAIT_L
#undef PG8_BAR
#undef PG8_SCHED
}
}

constexpr int DM = 1024, TP = 4096, BP = 4, MPR = BP * TP, BS = 8, TS = 16, MR = MPR + BS * TS, MP = 16640;
constexpr int DFF = 2816, NFF = 2 * DFF, INW = 5376, SHW = 1792, PAST = 4096, NPOS = PAST + TS;
constexpr float EPS = 1e-6f, LNX_EPS = 64e-5f;
constexpr float QSCALE = 0.125f * 1.4426950408889634f;
constexpr size_t O_Y = 0, O_KP = (size_t)MR * DM, O_VP = O_KP + (size_t)MPR * 512, O_SP = O_VP + (size_t)MPR * 512, O_SHP = O_SP + 131072,
                 O_KS = O_SHP + 7168, O_VS = O_KS + 65536, O_SS = O_VS + 65536, O_SHS = O_SS + 262144, O_END = O_SHS + 14336;
constexpr size_t KiB = 1024, MiB = 1u << 20;
constexpr size_t WS_W1T = 0, WS_W2T = 11 * MiB, WS_WINT = 16 * MiB + 512 * KiB, WS_WAT = 27 * MiB, WS_WRT = 28 * MiB, WS_WOT = 29 * MiB, WS_W3T = 31 * MiB, WS_W4T = 42 * MiB,
                 WS_TAB = 48 * MiB, WS_CTR = 49 * MiB + 512 * KiB, WS_ORW = 0,
                 WS_XN = 50 * MiB, WS_ABUF = 50 * MiB, WS_GG = 66 * MiB + 256 * KiB, WS_MG = 50 * MiB,
                 WS_G = 82 * MiB + 512 * KiB, WS_QB = WS_G, WS_KB = 98 * MiB + 768 * KiB, WS_VT = 115 * MiB, WS_ZRW = 131 * MiB + 256 * KiB,
                 WS_GATE = 188 * MiB + 128 * KiB, WS_DEC = 253 * MiB + 128 * KiB, WS_T = WS_KB, WS_F = 171 * MiB + 896 * KiB, WS_NEED = 286 * MiB;
constexpr size_t WS_LW = 49 * MiB + 64 * KiB;
static_assert(WS_ZRW + (size_t)MP * SHW * 2 <= WS_GATE && WS_GATE + (size_t)MP * 2048 * 2 <= WS_DEC && WS_DEC + (size_t)MP * 512 * 4 <= WS_NEED, "ws map");
static_assert(WS_G + (size_t)MP * DFF * 2 <= WS_F && WS_F + (size_t)MP * DM * 4 <= WS_NEED && WS_T + (size_t)MP * DM * 4 <= WS_F, "ws map 2");
static_assert(WS_XN + (size_t)MP * DM * 2 <= WS_G && WS_ORW + (size_t)MP * 512 * 2 <= WS_WINT && WS_VT + (size_t)MP * 512 * 2 <= WS_ZRW, "ws map 3");

#define LAS __attribute__((address_space(3)))
typedef unsigned short bf16_t;
typedef short bf16x8 __attribute__((ext_vector_type(8)));
typedef float f32x4 __attribute__((ext_vector_type(4)));
typedef float f32x2 __attribute__((ext_vector_type(2)));
typedef unsigned u32x4 __attribute__((ext_vector_type(4)));
typedef unsigned u32x2 __attribute__((ext_vector_type(2)));
typedef __bf16 bf16x2_t __attribute__((ext_vector_type(2)));
using pg8::Unit;

__device__ __forceinline__ unsigned pk2(float lo, float hi) { f32x2 v = {lo, hi}; bf16x2_t b = __builtin_convertvector(v, bf16x2_t); return __builtin_bit_cast(unsigned, b); }
__device__ __forceinline__ bf16_t f2bf(float f) { return (bf16_t)(pk2(f, 0.f) & 0xffffu); }
__device__ __forceinline__ float bf2f(bf16_t h) { return __uint_as_float((unsigned)h << 16); }
__device__ __forceinline__ float bflo(unsigned w) { return __uint_as_float(w << 16); }
__device__ __forceinline__ float bfhi(unsigned w) { return __uint_as_float(w & 0xffff0000u); }
__device__ __forceinline__ float fexp2(float x) { return __builtin_amdgcn_exp2f(x); }
__device__ __forceinline__ float frcp(float x) { return __builtin_amdgcn_rcpf(x); }
__device__ __forceinline__ float sigmoidf_(float x) { return frcp(1.f + fexp2(-1.4426950408889634f * x)); }
template <int CTRL> __device__ __forceinline__ float dpp_add_(float x) {
    return x + __builtin_bit_cast(float, __builtin_amdgcn_update_dpp(0, __builtin_bit_cast(int, x), CTRL, 0xf, 0xf, true));
}
__device__ __forceinline__ float wave_sum_fast(float x) {
    x = dpp_add_<0xB1>(x); x = dpp_add_<0x4E>(x); x = dpp_add_<0x141>(x); x = dpp_add_<0x140>(x);
    { auto rr = __builtin_amdgcn_permlane16_swap(__float_as_uint(x), __float_as_uint(x), false, false); x = __uint_as_float(rr[0]) + __uint_as_float(rr[1]); }
    { auto rr = __builtin_amdgcn_permlane32_swap(__float_as_uint(x), __float_as_uint(x), false, false); x = __uint_as_float(rr[0]) + __uint_as_float(rr[1]); }
    return x;
}
__device__ __forceinline__ float wave_sum(float v) { return wave_sum_fast(v); }
__device__ __forceinline__ float half_sum(float v) {
#pragma unroll
    for (int o = 1; o < 32; o <<= 1) v += __shfl_xor(v, o);
    return v;
}

struct Params {
    const float* in[36];
    float* out;
    unsigned char* ws;
    int ph_lo, ph_hi;
};
struct Ctx {
    const LAS unsigned* tab;
    __device__ __forceinline__ const void* ptr(int i) const {
        const unsigned lo = __builtin_amdgcn_readfirstlane(tab[2 * i]), hi = __builtin_amdgcn_readfirstlane(tab[2 * i + 1]);
        return (const void*)(const __attribute__((address_space(1))) void*)(((unsigned long long)hi << 32) | lo);
    }
    __device__ __forceinline__ const float* in(int i) const { return (const float*)ptr(i); }
    __device__ __forceinline__ float* out() const { return (float*)ptr(36); }
    __device__ __forceinline__ unsigned char* ws() const { return (unsigned char*)ptr(37); }
};

struct EpiSwiglu {
    static constexpr bool PERM = true, AFTER_DRAIN = false;
    bf16_t* O;
    __device__ __forceinline__ void operator()(const f32x4 (&acc)[2][2][4][2], const Unit& u, int wr, int wc, int fr, int fq) const {
        const int col0 = u.pn * 128 + wc * 32 + 8 * fq;
#pragma unroll
        for (int ai = 0; ai < 2; ++ai)
#pragma unroll
            for (int m = 0; m < 4; ++m) {
                const int row = u.pm * 256 + ai * 128 + wr * 64 + m * 16 + fr;
                float v[8];
#pragma unroll
                for (int n = 0; n < 2; ++n)
#pragma unroll
                    for (int i = 0; i < 4; ++i) { const float g = acc[ai][0][m][n][i], up = acc[ai][1][m][n][i]; v[n * 4 + i] = g * sigmoidf_(g) * up; }
                u32x4 w; w.x = pk2(v[0], v[1]); w.y = pk2(v[2], v[3]); w.z = pk2(v[4], v[5]); w.w = pk2(v[6], v[7]);
                if (row < MR) *(u32x4*)(O + (size_t)row * DFF + col0) = w;
                asm volatile("" ::: "memory");
            }
    }
};
struct EpiF32 {
    static constexpr bool PERM = false, AFTER_DRAIN = false;
    float* O;
    __device__ __forceinline__ void operator()(const f32x4 (&acc)[2][2][4][2], const Unit& u, int wr, int wc, int fr, int fq) const {
        const int col0 = u.pn * 256 + wc * 32 + 4 * fq;
#pragma unroll
        for (int ai = 0; ai < 2; ++ai)
#pragma unroll
            for (int m = 0; m < 4; ++m) {
                const int row = u.pm * 256 + ai * 128 + wr * 64 + m * 16 + fr;
                if (row < MR) {
#pragma unroll
                    for (int bj = 0; bj < 2; ++bj)
#pragma unroll
                        for (int n = 0; n < 2; ++n) *(f32x4*)(O + (size_t)row * DM + col0 + bj * 128 + n * 16) = acc[ai][bj][m][n];
                }
                asm volatile("" ::: "memory");
            }
    }
};
struct EpiGate1 {
    static constexpr bool PERM = true, AFTER_DRAIN = false;
    bf16_t* T; const bf16_t* GATE;
    __device__ __forceinline__ void operator()(const f32x4 (&acc)[2][2][4][2], const Unit& u, int wr, int wc, int fr, int fq) const {
        const int col0 = u.pn * 256 + wc * 32 + 8 * fq;
#pragma unroll
        for (int ai = 0; ai < 2; ++ai)
#pragma unroll
            for (int m = 0; m < 4; ++m) {
                const int row = u.pm * 256 + ai * 128 + wr * 64 + m * 16 + fr;
                if (row < MR) {
#pragma unroll
                    for (int bj = 0; bj < 2; ++bj) {
                        const u32x4 gv = *(const u32x4*)(GATE + (size_t)row * 2048 + col0 + bj * 128);
                        f32x4 a = acc[ai][bj][m][0], b = acc[ai][bj][m][1];
                        a[0] *= bflo(gv.x); a[1] *= bfhi(gv.x); a[2] *= bflo(gv.y); a[3] *= bfhi(gv.y);
                        b[0] *= bflo(gv.z); b[1] *= bfhi(gv.z); b[2] *= bflo(gv.w); b[3] *= bfhi(gv.w);
                        u32x4 w; w.x = pk2(a[0], a[1]); w.y = pk2(a[2], a[3]); w.z = pk2(b[0], b[1]); w.w = pk2(b[2], b[3]);
                        *(u32x4*)(T + (size_t)row * DM + col0 + bj * 128) = w;
                    }
                }
                asm volatile("" ::: "memory");
            }
    }
};
struct EpiGate2 {
    static constexpr bool PERM = true, AFTER_DRAIN = false;
    const bf16_t* T; const bf16_t* GATE; bf16_t* MG;
    __device__ __forceinline__ void operator()(const f32x4 (&acc)[2][2][4][2], const Unit& u, int wr, int wc, int fr, int fq) const {
        const int col0 = u.pn * 256 + wc * 32 + 8 * fq;
#pragma unroll
        for (int ai = 0; ai < 2; ++ai)
#pragma unroll
            for (int m = 0; m < 4; ++m) {
                const int row = u.pm * 256 + ai * 128 + wr * 64 + m * 16 + fr;
                if (row < MR) {
#pragma unroll
                    for (int bj = 0; bj < 2; ++bj) {
                        const u32x4 gv = *(const u32x4*)(GATE + (size_t)row * 2048 + 1024 + col0 + bj * 128);
                        const u32x4 tv = *(const u32x4*)(T + (size_t)row * DM + col0 + bj * 128);
                        f32x4 a = (f32x4){bflo(tv.x), bfhi(tv.x), bflo(tv.y), bfhi(tv.y)}, b = (f32x4){bflo(tv.z), bfhi(tv.z), bflo(tv.w), bfhi(tv.w)};
                        const f32x4 x = acc[ai][bj][m][0], y = acc[ai][bj][m][1];
                        a[0] += x[0] * bflo(gv.x); a[1] += x[1] * bfhi(gv.x); a[2] += x[2] * bflo(gv.y); a[3] += x[3] * bfhi(gv.y);
                        b[0] += y[0] * bflo(gv.z); b[1] += y[1] * bfhi(gv.z); b[2] += y[2] * bflo(gv.w); b[3] += y[3] * bfhi(gv.w);
                        u32x4 w; w.x = pk2(a[0], a[1]); w.y = pk2(a[2], a[3]); w.z = pk2(b[0], b[1]); w.w = pk2(b[2], b[3]);
                        *(u32x4*)(MG + (size_t)row * DM + col0 + bj * 128) = w;
                    }
                }
                asm volatile("" ::: "memory");
            }
    }
};
struct EpiZ {
    static constexpr bool PERM = true, AFTER_DRAIN = false;
    float* out; bf16_t *QB, *KB, *VT, *ZRW, *GATE; const f32x2* TAB;
    __device__ __forceinline__ void operator()(const f32x4 (&acc)[2][2][4][2], const Unit& u, int wr, int wc, int fr, int fq) const {
        const int pn = u.pn;
#pragma unroll
        for (int ai = 0; ai < 2; ++ai)
#pragma unroll
            for (int m = 0; m < 4; ++m) {
                const int row = u.pm * 256 + ai * 128 + wr * 64 + m * 16 + fr;
                asm volatile("" ::: "memory");
                if (row >= MR) continue;
                const bool smp = row >= MPR;
                if (pn < 4) {
                    const int pos = smp ? PAST + ((row - MPR) & 15) : (row & (TP - 1));
                    const int d0 = 8 * fq;
                    float o1[8], o2[8];
#pragma unroll
                    for (int n = 0; n < 2; ++n)
#pragma unroll
                        for (int i = 0; i < 4; ++i) {
                            const f32x2 cs = TAB[pos * 32 + d0 + n * 4 + i];
                            const float x1 = acc[ai][0][m][n][i], x2 = acc[ai][1][m][n][i];
                            o1[n * 4 + i] = x1 * cs.x - x2 * cs.y; o2[n * 4 + i] = x1 * cs.y + x2 * cs.x;
                        }
                    const int cb = (pn & 1) * 256 + 64 * wc + d0;
                    if (pn < 2) {
                        u32x4 w1, w2;
                        w1.x = pk2(o1[0] * QSCALE, o1[1] * QSCALE); w1.y = pk2(o1[2] * QSCALE, o1[3] * QSCALE); w1.z = pk2(o1[4] * QSCALE, o1[5] * QSCALE); w1.w = pk2(o1[6] * QSCALE, o1[7] * QSCALE);
                        w2.x = pk2(o2[0] * QSCALE, o2[1] * QSCALE); w2.y = pk2(o2[2] * QSCALE, o2[3] * QSCALE); w2.z = pk2(o2[4] * QSCALE, o2[5] * QSCALE); w2.w = pk2(o2[6] * QSCALE, o2[7] * QSCALE);
                        *(u32x4*)(QB + (size_t)row * 512 + cb) = w1; *(u32x4*)(QB + (size_t)row * 512 + cb + 32) = w2;
                    } else {
                        float* ko = smp ? out + O_KS + (size_t)(row - MPR) * 512 + cb : out + O_KP + (size_t)row * 512 + cb;
                        *(f32x4*)ko = (f32x4){o1[0], o1[1], o1[2], o1[3]}; *(f32x4*)(ko + 4) = (f32x4){o1[4], o1[5], o1[6], o1[7]};
                        *(f32x4*)(ko + 32) = (f32x4){o2[0], o2[1], o2[2], o2[3]}; *(f32x4*)(ko + 36) = (f32x4){o2[4], o2[5], o2[6], o2[7]};
                        u32x4 w1, w2;
                        w1.x = pk2(o1[0], o1[1]); w1.y = pk2(o1[2], o1[3]); w1.z = pk2(o1[4], o1[5]); w1.w = pk2(o1[6], o1[7]);
                        w2.x = pk2(o2[0], o2[1]); w2.y = pk2(o2[2], o2[3]); w2.z = pk2(o2[4], o2[5]); w2.w = pk2(o2[6], o2[7]);
                        *(u32x4*)(KB + (size_t)row * 512 + cb) = w1; *(u32x4*)(KB + (size_t)row * 512 + cb + 32) = w2;
                    }
                } else {
#pragma unroll
                    for (int bj = 0; bj < 2; ++bj) {
                        const int c = pn * 256 + bj * 128 + wc * 32 + 8 * fq;
                        const f32x4 a = acc[ai][bj][m][0], b = acc[ai][bj][m][1];
                        if (pn < 6) {
                            const int vc = c - 1024;
                            float* vo = smp ? out + O_VS + (size_t)(row - MPR) * 512 + vc : out + O_VP + (size_t)row * 512 + vc;
                            *(f32x4*)vo = a; *(f32x4*)(vo + 4) = b;
                            if (!smp) {
                                const int bb = row >> 12, t = row & (TP - 1), hh = vc >> 7, dd = vc & 127;
                                bf16_t* vt = VT + ((size_t)(bb * 4 + hh) * 128 + dd) * TP + t;
                                vt[0] = f2bf(a[0]); vt[TP] = f2bf(a[1]); vt[2 * TP] = f2bf(a[2]); vt[3 * TP] = f2bf(a[3]);
                                vt[4 * TP] = f2bf(b[0]); vt[5 * TP] = f2bf(b[1]); vt[6 * TP] = f2bf(b[2]); vt[7 * TP] = f2bf(b[3]);
                            }
                        } else if (pn < 13) {
                            const int zc = c - 1536;
                            u32x4 w; w.x = pk2(a[0], a[1]); w.y = pk2(a[2], a[3]); w.z = pk2(b[0], b[1]); w.w = pk2(b[2], b[3]);
                            *(u32x4*)(ZRW + (size_t)row * SHW + zc) = w;
                            const bool last = smp ? (((row - MPR) & 15) == 15) : ((row & (TP - 1)) == TP - 1);
                            if (last) { float* so = smp ? out + O_SHS + (size_t)((row - MPR) >> 4) * SHW + zc : out + O_SHP + (size_t)(row >> 12) * SHW + zc;
                                *(f32x4*)so = a; *(f32x4*)(so + 4) = b; }
                        } else {
                            const int gc = c - 3328;
                            u32x4 w; w.x = pk2(sigmoidf_(a[0]), sigmoidf_(a[1])); w.y = pk2(sigmoidf_(a[2]), sigmoidf_(a[3])); w.z = pk2(sigmoidf_(b[0]), sigmoidf_(b[1])); w.w = pk2(sigmoidf_(b[2]), sigmoidf_(b[3]));
                            *(u32x4*)(GATE + (size_t)row * 2048 + gc) = w;
                        }
                    }
                }
            }
    }
};

__device__ __forceinline__ void transpose_item(const float* W, int K, int N, bf16_t* WT, int k0, int n0, int drow0, LAS float* scr, int lane) {
#pragma unroll 8
    for (int i = 0; i < 32; ++i) { const int kk = 2 * i + (lane >> 5); scr[kk * 33 + (lane & 31)] = W[(size_t)(k0 + kk) * N + n0 + (lane & 31)]; }
    asm volatile("s_waitcnt lgkmcnt(0)" ::: "memory");
    const int c = lane & 7;
#pragma unroll
    for (int j = 0; j < 4; ++j) { const int n = (lane >> 3) + 8 * j; const LAS float* s = scr + (8 * c) * 33 + n;
        u32x4 o; o.x = pk2(s[0 * 33], s[1 * 33]); o.y = pk2(s[2 * 33], s[3 * 33]); o.z = pk2(s[4 * 33], s[5 * 33]); o.w = pk2(s[6 * 33], s[7 * 33]);
        *(u32x4*)(WT + (size_t)(drow0 + n) * K + k0 + 8 * c) = o; }
    asm volatile("s_waitcnt lgkmcnt(0)" ::: "memory");
}
__device__ __forceinline__ int map_w1(int n) { return n < DFF ? 256 * (n >> 7) + (n & 127) : 256 * ((n - DFF) >> 7) + 128 + ((n - DFF) & 127); }
__device__ __forceinline__ int map_win(int n) { return n < 1024 ? (n & ~255) + 128 * ((n >> 5) & 1) + 32 * ((n >> 6) & 3) + (n & 31) : n; }

__device__ __forceinline__ void sincos_d(double ang, float& c, float& s) {
    const double TWO_PI = 6.283185307179586476925286766559, HALF_PI = 1.5707963267948966192313216916398;
    double r = ang - TWO_PI * __builtin_rint(ang / TWO_PI);
    const double qd = __builtin_rint(r / HALF_PI); const int q = (int)qd; r -= qd * HALF_PI;
    const double r2 = r * r;
    double sp = r * (1.0 + r2 * (-1.0 / 6 + r2 * (1.0 / 120 + r2 * (-1.0 / 5040 + r2 * (1.0 / 362880 + r2 * (-1.0 / 39916800 + r2 * (1.0 / 6227020800.0)))))));
    double cp = 1.0 + r2 * (-0.5 + r2 * (1.0 / 24 + r2 * (-1.0 / 720 + r2 * (1.0 / 40320 + r2 * (-1.0 / 3628800 + r2 * (1.0 / 479001600.0 + r2 * (-1.0 / 87178291200.0)))))));
    double cc, ss;
    switch (q & 3) { case 0: cc = cp; ss = sp; break; case 1: cc = -sp; ss = cp; break; case 2: cc = -cp; ss = -sp; break; default: cc = sp; ss = -cp; break; }
    c = (float)cc; s = (float)ss;
}
__device__ __forceinline__ void rms_row_to_bf16(const float* xrow, const float* g, bf16_t* orow, int lane) {
    const f32x4* xr = (const f32x4*)xrow + lane; const f32x4* gr = (const f32x4*)g + lane;
    f32x4 v[4]; float s = 0.f;
#pragma unroll
    for (int j = 0; j < 4; ++j) { v[j] = xr[64 * j]; s += (v[j].x * v[j].x + v[j].y * v[j].y) + (v[j].z * v[j].z + v[j].w * v[j].w); }
    const float rs = 1.f / sqrtf(wave_sum(s) * (1.f / DM) + EPS);
    u32x2* o8 = (u32x2*)orow + lane;
#pragma unroll
    for (int j = 0; j < 4; ++j) { const f32x4 gg = gr[64 * j]; u32x2 w; w.x = pk2(v[j].x * rs * gg.x, v[j].y * rs * gg.y); w.y = pk2(v[j].z * rs * gg.z, v[j].w * rs * gg.w); o8[64 * j] = w; }
}
__device__ __forceinline__ const float* xrow_ptr(const Ctx& p, int row) { return row < MPR ? p.in(0) + (size_t)row * DM : p.in(1) + (size_t)(row - MPR) * DM; }

__device__ __forceinline__ void prologue_part2(const Ctx& p, LAS unsigned char* lds, int bidx, int nblk) {
    const int tid = threadIdx.x, lane = tid & 63, wave = __builtin_amdgcn_readfirstlane(tid >> 6);
    const int gw = bidx * 8 + wave, NGW = nblk * 8;
    unsigned char* ws = p.ws();
    LAS float* scr = (LAS float*)(lds + wave * 16384);
    constexpr int I2 = 44 * 32, I3 = 16 * 168, I4 = 8 * 32, I5 = 8 * 32, I6 = 16 * 32;
    __syncthreads();
    for (int it = gw; it < I2 + I3 + I4 + I5 + I6; it += NGW) {
        int r = it;
        if (r < I2) { const int kb = r / 32, nb = r % 32; transpose_item(p.in(8), DFF, DM, (bf16_t*)(ws + WS_W2T), 64 * kb, 32 * nb, 32 * nb, scr, lane); continue; } r -= I2;
        if (r < I3) { const int kb = r / 168, nb = r % 168; transpose_item(p.in(11), DM, INW, (bf16_t*)(ws + WS_WINT), 64 * kb, 32 * nb, map_win(32 * nb), scr, lane); continue; } r -= I3;
        if (r < I4) { const int kb = r / 32, nb = r % 32; transpose_item(p.in(28), 512, DM, (bf16_t*)(ws + WS_WAT), 64 * kb, 32 * nb, 32 * nb, scr, lane); continue; } r -= I4;
        if (r < I5) { const int kb = r / 32, nb = r % 32; transpose_item(p.in(29), 512, DM, (bf16_t*)(ws + WS_WRT), 64 * kb, 32 * nb, 32 * nb, scr, lane); continue; } r -= I5;
        { const int kb = r / 32, nb = r % 32; transpose_item(p.in(30), DM, DM, (bf16_t*)(ws + WS_WOT), 64 * kb, 32 * nb, 32 * nb, scr, lane); }
    }
    {   bf16_t* LW = (bf16_t*)(ws + WS_LW);
        for (int e = bidx * 512 + tid; e < 512 * 256; e += nblk * 512) {
            const int n = e & 511, k = e >> 9;
            if (k < 64) LW[n * 64 + k] = f2bf(p.in(19)[k * 512 + n]);
            else if (k < 128) LW[512 * 64 + n * 64 + (k - 64)] = f2bf(p.in(21)[(k - 64) * 512 + n]);
            else LW[2 * 512 * 64 + n * 128 + (k - 128)] = f2bf(p.in(22)[(k - 128) * 512 + n]);
        } }
    for (int e = bidx * 512 + tid; e < NPOS * 32; e += nblk * 512) {
        const int pos = e >> 5, d = e & 31;
        const double inv = exp(-(double)d * (9.210340371976182736071965818737 / 32.0));
        float c, s; sincos_d((double)pos * inv, c, s);
        ((f32x2*)(ws + WS_TAB))[e] = (f32x2){c, s};
    }
}
__device__ __forceinline__ void phase_prologue(const Ctx& p, LAS unsigned char* lds) {
    const int tid = threadIdx.x, lane = tid & 63, wave = __builtin_amdgcn_readfirstlane(tid >> 6);
    const int gw = blockIdx.x * 8 + wave, NGW = gridDim.x * 8;
    unsigned char* ws = p.ws();
    LAS float* scr = (LAS float*)(lds + wave * 16384);
    constexpr int I1 = 16 * 176;
    for (int it = gw; it < I1; it += NGW) { const int kb = it / 176, nb = it % 176; transpose_item(p.in(7), DM, NFF, (bf16_t*)(ws + WS_W1T), 64 * kb, 32 * nb, map_w1(32 * nb), scr, lane); }
    bf16_t* XN = (bf16_t*)(ws + WS_XN);
    {   f32x4 g4[4], v[4], v2[4];
#pragma unroll
        for (int j = 0; j < 4; ++j) g4[j] = ((const f32x4*)p.in(6))[lane + 64 * j];
        if (gw < MR) {
#pragma unroll
            for (int j = 0; j < 4; ++j) v[j] = ((const f32x4*)xrow_ptr(p, gw))[lane + 64 * j]; }
        for (int m = gw; m < MP; m += NGW) {
            const int mn = m + NGW;
            if (mn < MR) {
#pragma unroll
                for (int j = 0; j < 4; ++j) v2[j] = ((const f32x4*)xrow_ptr(p, mn))[lane + 64 * j]; }
            u32x2* o8 = (u32x2*)(XN + (size_t)m * DM) + lane;
            if (m < MR) {
                float sq = 0.f;
#pragma unroll
                for (int j = 0; j < 4; ++j) sq += (v[j].x * v[j].x + v[j].y * v[j].y) + (v[j].z * v[j].z + v[j].w * v[j].w);
                const float rs = 1.f / sqrtf(wave_sum(sq) * (1.f / DM) + EPS);
#pragma unroll
                for (int j = 0; j < 4; ++j) { u32x2 w; w.x = pk2(v[j].x * rs * g4[j].x, v[j].y * rs * g4[j].y); w.y = pk2(v[j].z * rs * g4[j].z, v[j].w * rs * g4[j].w); o8[64 * j] = w; }
            } else {
#pragma unroll
                for (int j = 0; j < 4; ++j) o8[64 * j] = (u32x2){0u, 0u}; }
#pragma unroll
            for (int j = 0; j < 4; ++j) v[j] = v2[j];
        }
    }
}

__device__ __forceinline__ void phase_rowpass(const Ctx& p, const float* F, int base_is_x, float alpha, const float* gpost, const float* gnext, bf16_t* XN, const float* PART, int nsplit) {
    const int tid = threadIdx.x, lane = tid & 63, wave = __builtin_amdgcn_readfirstlane(tid >> 6);
    const int gw = blockIdx.x * 8 + wave, NGW = gridDim.x * 8;
    float* H = p.out() + O_Y;
    auto loadrow = [&](int m, f32x4 (&f)[4], f32x4 (&b)[4]) {
        const f32x4* fr = (const f32x4*)(F + (size_t)m * DM) + lane;
        const f32x4* br = (const f32x4*)(base_is_x ? xrow_ptr(p, m) : H + (size_t)m * DM) + lane;
#pragma unroll
        for (int j = 0; j < 4; ++j) { b[j] = br[64 * j];
            if (m < MPR) f[j] = fr[64 * j];
            else { f[j] = (f32x4){0.f, 0.f, 0.f, 0.f};
                for (int ks = 0; ks < nsplit; ++ks) f[j] = f[j] + ((const f32x4*)(PART + ((size_t)ks * 128 + (m - MPR)) * DM))[lane + 64 * j]; } }
    };
    f32x4 gp[4], gn[4];
#pragma unroll
    for (int j = 0; j < 4; ++j) { gp[j] = ((const f32x4*)gpost)[lane + 64 * j]; gn[j] = gnext ? ((const f32x4*)gnext)[lane + 64 * j] : (f32x4){0.f, 0.f, 0.f, 0.f}; }
    f32x4 f[4], b[4], f2[4], b2[4];
    if (gw < MR) loadrow(gw, f, b);
    for (int m = gw; m < MR; m += NGW) {
        const bool more = m + NGW < MR;
        if (more) loadrow(m + NGW, f2, b2);
        float s = 0.f;
#pragma unroll
        for (int j = 0; j < 4; ++j) s += (f[j].x * f[j].x + f[j].y * f[j].y) + (f[j].z * f[j].z + f[j].w * f[j].w);
        const float rs = alpha / sqrtf(wave_sum_fast(s) * (1.f / DM) + EPS);
        float s2 = 0.f;
#pragma unroll
        for (int j = 0; j < 4; ++j) { b[j] = b[j] + f[j] * rs * gp[j]; s2 += (b[j].x * b[j].x + b[j].y * b[j].y) + (b[j].z * b[j].z + b[j].w * b[j].w);
            ((f32x4*)(H + (size_t)m * DM))[lane + 64 * j] = b[j]; }
        if (gnext) {
            const float r2 = 1.f / sqrtf(wave_sum_fast(s2) * (1.f / DM) + EPS);
            u32x2* o8 = (u32x2*)(XN + (size_t)m * DM) + lane;
#pragma unroll
            for (int j = 0; j < 4; ++j) { u32x2 w; w.x = pk2(b[j].x * r2 * gn[j].x, b[j].y * r2 * gn[j].y); w.y = pk2(b[j].z * r2 * gn[j].z, b[j].w * r2 * gn[j].w); o8[64 * j] = w; }
        }
        if (more) {
#pragma unroll
            for (int j = 0; j < 4; ++j) { f[j] = f2[j]; b[j] = b2[j]; } }
    }
}

__device__ __forceinline__ float zshift(const Ctx& p, const bf16_t* ZRW, int row, int c) {
    const float z = bf2f(ZRW[(size_t)row * SHW + c]);
    float prev;
    if (row < MPR) prev = (row & (TP - 1)) ? bf2f(ZRW[(size_t)(row - 1) * SHW + c]) : 0.f;
    else { const int r = row - MPR; prev = (r & 15) ? bf2f(ZRW[(size_t)(row - 1) * SHW + c]) : p.in(5)[(size_t)(r >> 4) * SHW + c]; }
    return z + (prev - z) * p.in(17)[c];
}
__device__ __forceinline__ void unpack8(const u32x4 w, float (&f)[8]) { f[0] = bflo(w.x); f[1] = bfhi(w.x); f[2] = bflo(w.y); f[3] = bfhi(w.y); f[4] = bflo(w.z); f[5] = bfhi(w.z); f[6] = bflo(w.w); f[7] = bfhi(w.w); }
__device__ __forceinline__ void zshift8(const Ctx& p, const bf16_t* ZRW, int row, int c, const float (&mu)[8], float (&o)[8]) {
    float z[8], pv[8];
    unpack8(*(const u32x4*)(ZRW + (size_t)row * SHW + c), z);
    bool first; int bsmp = 0;
    if (row < MPR) first = (row & (TP - 1)) == 0; else { first = ((row - MPR) & 15) == 0; bsmp = (row - MPR) >> 4; }
    if (!first) unpack8(*(const u32x4*)(ZRW + (size_t)(row - 1) * SHW + c), pv);
    else if (row < MPR) {
#pragma unroll
        for (int e = 0; e < 8; ++e) pv[e] = 0.f;
    } else { const float* s0 = p.in(5) + (size_t)bsmp * SHW + c;
#pragma unroll
        for (int e = 0; e < 8; ++e) pv[e] = s0[e]; }
#pragma unroll
    for (int e = 0; e < 8; ++e) o[e] = z[e] + (pv[e] - z[e]) * mu[e];
}
__device__ __forceinline__ void phase_lora(const Ctx& p, LAS unsigned char* lds) {
    const int tid = threadIdx.x, lane = tid & 63, wave = __builtin_amdgcn_readfirstlane(tid >> 6), q = lane & 15, g = lane >> 4;
    const bf16_t* ZRW = (const bf16_t*)(p.ws() + WS_ZRW);
    float* DEC = (float*)(p.ws() + WS_DEC); bf16_t* AB = (bf16_t*)(p.ws() + WS_ABUF); bf16_t* GG = (bf16_t*)(p.ws() + WS_GG);
    const bf16_t* w2T = (const bf16_t*)(p.ws() + WS_LW); const bf16_t* a2T = w2T + 512 * 64; const bf16_t* g2T = a2T + 512 * 64;
    LAS bf16_t* X = (LAS bf16_t*)(lds + wave * 16 * 264 * 2);
    const float* mu = p.in(17) + 1536;
    for (int it = blockIdx.x + gridDim.x * wave; it < MR / 16; it += gridDim.x * 8) {
        const int r0 = it * 16;
        {
            const int tt = lane >> 2, cq = lane & 3, row = r0 + tt;
#pragma unroll
            for (int j = 0; j < 8; ++j) {
                const int c = cq * 64 + j * 8;
                float m8[8], z[8];
#pragma unroll
                for (int e = 0; e < 8; ++e) m8[e] = mu[c + e];
                zshift8(p, ZRW, row, 1536 + c, m8, z);
#pragma unroll
                for (int e = 0; e < 8; ++e) z[e] = cq == 0 ? tanhf(z[e]) : (cq == 1 ? z[e] : sigmoidf_(z[e]));
                u32x4 w; w.x = pk2(z[0], z[1]); w.y = pk2(z[2], z[3]); w.z = pk2(z[4], z[5]); w.w = pk2(z[6], z[7]);
                *(LAS u32x4*)(X + tt * 264 + c) = w;
            }
        }
        asm volatile("s_waitcnt lgkmcnt(0)" ::: "memory");
        bf16x8 bx[8];
#pragma unroll
        for (int ks = 0; ks < 8; ++ks) bx[ks] = *(const LAS bf16x8*)(X + q * 264 + ks * 32 + 8 * g);
        const int row = r0 + q;
        struct WF { bf16x8 w[2], a[2], gq[4]; f32x4 w0, a0; };
        auto ldw = [&](WF& f, int nt) {
            const int n = nt * 16 + q, c = nt * 16 + 4 * g;
#pragma unroll
            for (int ks = 0; ks < 2; ++ks) { f.w[ks] = *(const bf16x8*)(w2T + n * 64 + ks * 32 + 8 * g); f.a[ks] = *(const bf16x8*)(a2T + n * 64 + ks * 32 + 8 * g); }
#pragma unroll
            for (int ks = 0; ks < 4; ++ks) f.gq[ks] = *(const bf16x8*)(g2T + n * 128 + ks * 32 + 8 * g);
            f.w0 = *(const f32x4*)(p.in(18) + c); f.a0 = *(const f32x4*)(p.in(20) + c);
        };
        auto tile = [&](const WF& f, int nt) {
            f32x4 aw = (f32x4){0.f, 0.f, 0.f, 0.f}, aa = aw, ag = aw;
#pragma unroll
            for (int ks = 0; ks < 2; ++ks) { aw = __builtin_amdgcn_mfma_f32_16x16x32_bf16(f.w[ks], bx[ks], aw, 0, 0, 0); aa = __builtin_amdgcn_mfma_f32_16x16x32_bf16(f.a[ks], bx[2 + ks], aa, 0, 0, 0); }
#pragma unroll
            for (int ks = 0; ks < 4; ++ks) ag = __builtin_amdgcn_mfma_f32_16x16x32_bf16(f.gq[ks], bx[4 + ks], ag, 0, 0, 0);
            const int c = nt * 16 + 4 * g;
            f32x4 dec; float av[4];
#pragma unroll
            for (int e = 0; e < 4; ++e) {
                const float x = f.w0[e] + aw[e];
                const float sp = fmaxf(-x, 0.f) + log1pf(expf(-fabsf(x)));
                dec[e] = expf(-expf(-sp - 0.5f));
                av[e] = sigmoidf_(f.a0[e] + aa[e]);
            }
            *(f32x4*)(DEC + (size_t)row * 512 + c) = dec;
            *(u32x2*)(AB + (size_t)row * 512 + c) = (u32x2){pk2(av[0], av[1]), pk2(av[2], av[3])};
            *(u32x2*)(GG + (size_t)row * 512 + c) = (u32x2){pk2(ag[0], ag[1]), pk2(ag[2], ag[3])};
        };
        WF fa, fb;
        ldw(fa, 0);
#pragma unroll 1
        for (int nt = 0; nt < 32; nt += 2) {
            ldw(fb, nt + 1);
            tile(fa, nt);
            ldw(fa, (nt + 2) & 31);
            tile(fb, nt + 1);
        }
        asm volatile("s_waitcnt lgkmcnt(0)" ::: "memory");
    }
}

#define MFMA16(a, b, c) __builtin_amdgcn_mfma_f32_16x16x32_bf16((a), (b), (c), 0, 0, 0)
struct AttAcc { f32x4 O[2][8]; float m[2], l[2]; };
__device__ __forceinline__ void att_init(AttAcc& A) {
#pragma unroll
    for (int mm = 0; mm < 2; ++mm) { A.m[mm] = -1e30f; A.l[mm] = 0.f;
#pragma unroll
        for (int d = 0; d < 8; ++d) A.O[mm][d] = (f32x4){0.f, 0.f, 0.f, 0.f}; }
}
template <class LK> __device__ __forceinline__ void att_qk(AttAcc& A, const LK& lk, const bf16x8 (&bq)[2][2], int nvalid, int g, bf16x8 (&bP)[2][2]) {
#pragma unroll
    for (int mm = 0; mm < 2; ++mm) {
        f32x4 s[4];
#pragma unroll
        for (int t = 0; t < 4; ++t) { s[t] = (f32x4){0.f, 0.f, 0.f, 0.f};
#pragma unroll
            for (int ks = 0; ks < 2; ++ks) s[t] = MFMA16(lk(mm, ks, t), bq[mm][ks], s[t]); }
        if (nvalid < 64) {
#pragma unroll
            for (int t = 0; t < 4; ++t)
#pragma unroll
                for (int r = 0; r < 4; ++r) if (16 * t + 4 * g + r >= nvalid) s[t][r] = -1e30f;
        }
        float mx = s[0][0];
#pragma unroll
        for (int t = 0; t < 4; ++t)
#pragma unroll
            for (int r = 0; r < 4; ++r) mx = fmaxf(mx, s[t][r]);
        { auto rr = __builtin_amdgcn_permlane16_swap(__float_as_uint(mx), __float_as_uint(mx), false, false); mx = fmaxf(__uint_as_float(rr[0]), __uint_as_float(rr[1])); }
        { auto rr = __builtin_amdgcn_permlane32_swap(__float_as_uint(mx), __float_as_uint(mx), false, false); mx = fmaxf(__uint_as_float(rr[0]), __uint_as_float(rr[1])); }
        const float mnew = fmaxf(A.m[mm], mx), alpha = fexp2(A.m[mm] - mnew);
        const bool grew = __builtin_amdgcn_ballot_w64(mnew > A.m[mm]) != 0ull;
        A.m[mm] = mnew;
        float ls = 0.f;
#pragma unroll
        for (int t = 0; t < 4; ++t)
#pragma unroll
            for (int r = 0; r < 4; ++r) { s[t][r] = fexp2(s[t][r] - mnew); ls += s[t][r]; }
        A.l[mm] = A.l[mm] * alpha + ls;
        if (grew) {
#pragma unroll
            for (int d = 0; d < 8; ++d) A.O[mm][d] = A.O[mm][d] * alpha;
        }
#pragma unroll
        for (int k2 = 0; k2 < 2; ++k2) {
            u32x4 w; w.x = pk2(s[2 * k2][0], s[2 * k2][1]); w.y = pk2(s[2 * k2][2], s[2 * k2][3]); w.z = pk2(s[2 * k2 + 1][0], s[2 * k2 + 1][1]); w.w = pk2(s[2 * k2 + 1][2], s[2 * k2 + 1][3]);
            bP[mm][k2] = __builtin_bit_cast(bf16x8, w);
        }
        asm volatile("" ::: "memory");
    }
}
__device__ __forceinline__ void att_final(const AttAcc& A, float l0, float l1, float lam, const float* subg, bf16_t* orow, int g) {
    const float i0 = 1.f / l0, i1 = lam / l1;
    f32x4 o[8]; float ss = 0.f;
#pragma unroll
    for (int d = 0; d < 8; ++d) { o[d] = A.O[0][d] * i0 - A.O[1][d] * i1; ss += (o[d][0] * o[d][0] + o[d][1] * o[d][1]) + (o[d][2] * o[d][2] + o[d][3] * o[d][3]); }
    ss += __shfl_xor(ss, 16); ss += __shfl_xor(ss, 32);
    const float rs = 0.8f / sqrtf(ss * (1.f / 128.f) + EPS);
#pragma unroll
    for (int d = 0; d < 8; ++d) { const f32x4 gg = *(const f32x4*)(subg + 16 * d + 4 * g);
        u32x2 w; w.x = pk2(o[d][0] * rs * gg[0], o[d][1] * rs * gg[1]); w.y = pk2(o[d][2] * rs * gg[2], o[d][3] * rs * gg[3]);
        *(u32x2*)(orow + 16 * d + 4 * g) = w; }
}
__device__ __forceinline__ float att_lambda(const Ctx& p, int lane) {
    const float a = wave_sum(p.in(12)[lane] * p.in(13)[lane]), b = wave_sum(p.in(14)[lane] * p.in(15)[lane]);
    return expf(a) - expf(b) + 0.2f;
}
constexpr int KS_STRIDE = 136, VS_STRIDE = 72, ATT_BUF = 64 * KS_STRIDE + 128 * VS_STRIDE;
__device__ __forceinline__ void att_prompt_unit(const Ctx& p, int bh, int qb, LAS unsigned char* lds) {
    const int tid = threadIdx.x, lane = tid & 63, wave = __builtin_amdgcn_readfirstlane(tid >> 6), q = lane & 15, g = lane >> 4;
    const int b = bh >> 2, h = bh & 3;
    bf16_t* QB = (bf16_t*)(p.ws() + WS_QB); const bf16_t* KB = (const bf16_t*)(p.ws() + WS_KB); const bf16_t* VT = (const bf16_t*)(p.ws() + WS_VT);
    const int row = b * TP + qb * 128 + wave * 16 + q;
    bf16_t* qrow = QB + (size_t)row * 512 + h * 128;
    bf16x8 bq[2][2];
#pragma unroll
    for (int mm = 0; mm < 2; ++mm)
#pragma unroll
        for (int ks = 0; ks < 2; ++ks) bq[mm][ks] = *(const bf16x8*)(qrow + mm * 64 + ks * 32 + 8 * g);
    AttAcc A; att_init(A);
    const int nkb = 2 * qb + 2, nkt = 2 * qb + 1 + (wave >> 2);
    const bf16_t* kg = KB + (size_t)(b * TP + (tid >> 4)) * 512 + h * 128 + (tid & 15) * 8;
    const bf16_t* vg = VT + ((size_t)bh * 128 + (tid >> 3)) * TP + (tid & 7) * 8;
    LAS bf16_t* L = (LAS bf16_t*)lds;
    const int kso = (tid >> 4) * KS_STRIDE + (tid & 15) * 8, vsb = 64 * KS_STRIDE + (tid >> 3) * VS_STRIDE + ((tid & 7) >> 2) * 32;
    const int kb_ = (tid & 3) * 8, vso = vsb + 8 * ((kb_ & 15) >> 2) + 4 * (kb_ >> 4), vso2 = vsb + 8 * (((kb_ + 4) & 15) >> 2) + 4 * ((kb_ + 4) >> 4);
    u32x4 k0 = *(const u32x4*)kg, k1 = *(const u32x4*)(kg + 32 * 512), v0 = *(const u32x4*)vg, v1 = *(const u32x4*)(vg + (size_t)64 * TP);
    __syncthreads();
    *(LAS u32x4*)(L + kso) = k0; *(LAS u32x4*)(L + kso + 32 * KS_STRIDE) = k1; *(LAS u32x2*)(L + vso) = (u32x2){v0.x, v0.y}; *(LAS u32x2*)(L + vso2) = (u32x2){v0.z, v0.w}; *(LAS u32x2*)(L + vso + 64 * VS_STRIDE) = (u32x2){v1.x, v1.y}; *(LAS u32x2*)(L + vso2 + 64 * VS_STRIDE) = (u32x2){v1.z, v1.w};
    __syncthreads();
    for (int kt = 0; kt < nkb; ++kt) {
        const LAS bf16_t* Lc = L + (kt & 1) * ATT_BUF;
        LAS bf16_t* Ln = L + ((kt + 1) & 1) * ATT_BUF;
        const bool more = kt + 1 < nkb;
        if (more) { const bf16_t* kn = kg + (size_t)(kt + 1) * 64 * 512; const bf16_t* vn = vg + (kt + 1) * 64;
            k0 = *(const u32x4*)kn; k1 = *(const u32x4*)(kn + 32 * 512); v0 = *(const u32x4*)vn; v1 = *(const u32x4*)(vn + (size_t)64 * TP); }
        if (kt < nkt) {
            bf16x8 bP[2][2];
            const LAS bf16_t* kl = Lc + q * KS_STRIDE + 8 * g;
            att_qk(A, [&](int mm, int ks, int t) { return *(const LAS bf16x8*)(kl + t * 16 * KS_STRIDE + mm * 64 + ks * 32); }, bq, 64, g, bP);
            const LAS bf16_t* vl = Lc + 64 * KS_STRIDE + q * VS_STRIDE + 8 * g;
#pragma unroll
            for (int d = 0; d < 8; ++d)
#pragma unroll
                for (int k2 = 0; k2 < 2; ++k2) {
                    const bf16x8 vf = *(const LAS bf16x8*)(vl + d * 16 * VS_STRIDE + 32 * k2);
                    A.O[0][d] = MFMA16(vf, bP[0][k2], A.O[0][d]); A.O[1][d] = MFMA16(vf, bP[1][k2], A.O[1][d]);
                }
        }
        if (more) { *(LAS u32x4*)(Ln + kso) = k0; *(LAS u32x4*)(Ln + kso + 32 * KS_STRIDE) = k1; *(LAS u32x2*)(Ln + vso) = (u32x2){v0.x, v0.y}; *(LAS u32x2*)(Ln + vso2) = (u32x2){v0.z, v0.w}; *(LAS u32x2*)(Ln + vso + 64 * VS_STRIDE) = (u32x2){v1.x, v1.y}; *(LAS u32x2*)(Ln + vso2 + 64 * VS_STRIDE) = (u32x2){v1.z, v1.w}; }
        __syncthreads();
    }
    float l0 = A.l[0], l1 = A.l[1];
    l0 += __shfl_xor(l0, 16); l0 += __shfl_xor(l0, 32); l1 += __shfl_xor(l1, 16); l1 += __shfl_xor(l1, 32);
    const float lam = att_lambda(p, lane);
    att_final(A, l0, l1, lam, p.in(16), qrow, g);
}
__device__ __forceinline__ bf16x8 cvt8(const float* s) {
    const f32x4 a = *(const f32x4*)s, b = *(const f32x4*)(s + 4);
    u32x4 w; w.x = pk2(a[0], a[1]); w.y = pk2(a[2], a[3]); w.z = pk2(b[0], b[1]); w.w = pk2(b[2], b[3]);
    return __builtin_bit_cast(bf16x8, w);
}
__device__ __forceinline__ void att_sample_unit(const Ctx& p, int bs, int h, LAS unsigned char* lds) {
    const int tid = threadIdx.x, lane = tid & 63, wave = __builtin_amdgcn_readfirstlane(tid >> 6), q = lane & 15, g = lane >> 4;
    bf16_t* QB = (bf16_t*)(p.ws() + WS_QB);
    const int row = MPR + bs * 16 + q;
    bf16_t* qrow = QB + (size_t)row * 512 + h * 128;
    bf16x8 bq[2][2];
#pragma unroll
    for (int mm = 0; mm < 2; ++mm)
#pragma unroll
        for (int ks = 0; ks < 2; ++ks) bq[mm][ks] = *(const bf16x8*)(qrow + mm * 64 + ks * 32 + 8 * g);
    AttAcc A; att_init(A);
    for (int kt = wave; kt < 65; kt += 8) {
        const bool isnew = kt == 64;
        const float* kb = isnew ? p.out() + O_KS + (size_t)bs * 16 * 512 : p.in(2) + ((size_t)bs * PAST + kt * 64) * 512;
        const float* vb = isnew ? p.out() + O_VS + (size_t)bs * 16 * 512 : p.in(3) + ((size_t)bs * PAST + kt * 64) * 512;
        const int nvalid = isnew ? 16 : 64;
        bf16x8 bP[2][2];
        att_qk(A, [&](int mm, int ks, int t) { const int key = min(16 * t + q, nvalid - 1); return cvt8(kb + (key * 512 + h * 128 + mm * 64 + ks * 32 + 8 * g)); }, bq, nvalid, g, bP);
#pragma unroll
        for (int d = 0; d < 8; ++d)
#pragma unroll
            for (int k2 = 0; k2 < 2; ++k2) {
                float v[8];
#pragma unroll
                for (int e = 0; e < 8; ++e) { const int key = min(32 * k2 + (e >> 2) * 16 + 4 * g + (e & 3), nvalid - 1); v[e] = vb[key * 512 + h * 128 + 16 * d + q]; }
                u32x4 w; w.x = pk2(v[0], v[1]); w.y = pk2(v[2], v[3]); w.z = pk2(v[4], v[5]); w.w = pk2(v[6], v[7]);
                const bf16x8 vf = __builtin_bit_cast(bf16x8, w);
                A.O[0][d] = MFMA16(vf, bP[0][k2], A.O[0][d]); A.O[1][d] = MFMA16(vf, bP[1][k2], A.O[1][d]);
                if (k2 == 1 && (d & 1)) asm volatile("" ::: "memory");
            }
    }
    float l0 = A.l[0], l1 = A.l[1];
    l0 += __shfl_xor(l0, 16); l0 += __shfl_xor(l0, 32); l1 += __shfl_xor(l1, 16); l1 += __shfl_xor(l1, 32);
    LAS float* Ob = (LAS float*)lds; LAS float* ML = Ob + 8 * 2 * 8 * 4 * 64;
#pragma unroll
    for (int mm = 0; mm < 2; ++mm)
#pragma unroll
        for (int d = 0; d < 8; ++d)
#pragma unroll
            for (int r = 0; r < 4; ++r) Ob[((((wave * 2 + mm) * 8 + d) * 4 + r) << 6) + lane] = A.O[mm][d][r];
    ML[(wave * 4 + 0) * 64 + lane] = A.m[0]; ML[(wave * 4 + 1) * 64 + lane] = A.m[1]; ML[(wave * 4 + 2) * 64 + lane] = l0; ML[(wave * 4 + 3) * 64 + lane] = l1;
    __syncthreads();
    {
        float ms0 = -1e30f, ms1 = -1e30f;
#pragma unroll
        for (int w = 0; w < 8; ++w) { ms0 = fmaxf(ms0, ML[(w * 4 + 0) * 64 + lane]); ms1 = fmaxf(ms1, ML[(w * 4 + 1) * 64 + lane]); }
        float L0 = 0.f, L1 = 0.f; f32x4 o0 = (f32x4){0.f, 0.f, 0.f, 0.f}, o1 = o0;
#pragma unroll
        for (int w = 0; w < 8; ++w) {
            const float f0 = fexp2(ML[(w * 4 + 0) * 64 + lane] - ms0), f1 = fexp2(ML[(w * 4 + 1) * 64 + lane] - ms1);
            L0 += ML[(w * 4 + 2) * 64 + lane] * f0; L1 += ML[(w * 4 + 3) * 64 + lane] * f1;
#pragma unroll
            for (int r = 0; r < 4; ++r) { o0[r] += Ob[((((w * 2 + 0) * 8 + wave) * 4 + r) << 6) + lane] * f0; o1[r] += Ob[((((w * 2 + 1) * 8 + wave) * 4 + r) << 6) + lane] * f1; }
        }
        const float lam = att_lambda(p, lane);
        const f32x4 o = o0 * (1.f / L0) - o1 * (lam / L1);
        float ss = (o[0] * o[0] + o[1] * o[1]) + (o[2] * o[2] + o[3] * o[3]);
        ss += __shfl_xor(ss, 16); ss += __shfl_xor(ss, 32);
        LAS float* SS = ML + 8 * 4 * 64;
        SS[wave * 64 + lane] = ss;
        __syncthreads();
        float tot = 0.f;
#pragma unroll
        for (int w = 0; w < 8; ++w) tot += SS[w * 64 + lane];
        const float rs = 0.8f / sqrtf(tot * (1.f / 128.f) + EPS);
        const f32x4 gg = *(const f32x4*)(p.in(16) + 16 * wave + 4 * g);
        u32x2 wv; wv.x = pk2(o[0] * rs * gg[0], o[1] * rs * gg[1]); wv.y = pk2(o[2] * rs * gg[2], o[3] * rs * gg[3]);
        *(u32x2*)(qrow + 16 * wave + 4 * g) = wv;
    }
    __syncthreads();
}

template <int CTRL> __device__ __forceinline__ float dpp_add(float x) {
    return x + __builtin_bit_cast(float, __builtin_amdgcn_update_dpp(0, __builtin_bit_cast(int, x), CTRL, 0xf, 0xf, true));
}
__device__ __forceinline__ float sum16(float x) { x = dpp_add<0xB1>(x); x = dpp_add<0x4E>(x); x = dpp_add<0x141>(x); x = dpp_add<0x140>(x); return x; }
__device__ __forceinline__ float sum8(float x) { x = dpp_add<0xB1>(x); x = dpp_add<0x4E>(x); x = dpp_add<0x141>(x); return x; }
__device__ __forceinline__ void unpack4(const u32x2 w, float (&f)[4]) { f[0] = bflo(w.x); f[1] = bfhi(w.x); f[2] = bflo(w.y); f[3] = bfhi(w.y); }
__device__ __forceinline__ void zshift4(const Ctx& p, const bf16_t* ZRW, int row, int c, const float (&mu)[4], float (&o)[4]) {
    float z[4], pv[4];
    unpack4(*(const u32x2*)(ZRW + (size_t)row * SHW + c), z);
    bool first; int bsmp = 0;
    if (row < MPR) first = (row & (TP - 1)) == 0; else { first = ((row - MPR) & 15) == 0; bsmp = (row - MPR) >> 4; }
    if (!first) unpack4(*(const u32x2*)(ZRW + (size_t)(row - 1) * SHW + c), pv);
    else if (row < MPR) { pv[0] = 0.f; pv[1] = 0.f; pv[2] = 0.f; pv[3] = 0.f; }
    else { const f32x4 s0 = *(const f32x4*)(p.in(5) + (size_t)bsmp * SHW + c); pv[0] = s0[0]; pv[1] = s0[1]; pv[2] = s0[2]; pv[3] = s0[3]; }
#pragma unroll
    for (int e = 0; e < 4; ++e) o[e] = z[e] + (pv[e] - z[e]) * mu[e];
}
constexpr int SCH = 16, SBUF_F = SCH * (320 + 16), YP_F = SCH * 16 * 16;
struct ScanOps { f32x4 w, kk, ka, kp, rr; float v; };
__device__ __forceinline__ void scan_load(ScanOps& o, const LAS float* OP, const LAS float* VP, int t) {
    o.w = *(const LAS f32x4*)(OP + t * 320); o.kk = *(const LAS f32x4*)(OP + t * 320 + 64); o.ka = *(const LAS f32x4*)(OP + t * 320 + 128);
    o.kp = *(const LAS f32x4*)(OP + t * 320 + 192); o.rr = *(const LAS f32x4*)(OP + t * 320 + 256);
}
__device__ __forceinline__ void scan_step(f32x4& S, const ScanOps& o, LAS float* yp) {
    f32x2 S0 = {S[0], S[1]}, S1 = {S[2], S[3]};
    const f32x2 k0 = {o.kk[0], o.kk[1]}, k1 = {o.kk[2], o.kk[3]};
    f32x2 t = S0 * k0; t = S1 * k1 + t;
    const float sa = -sum16(t[0] + t[1]);
    const f32x2 sav = {sa, sa}, vv = {o.v, o.v};
    const f32x2 a0 = {o.ka[0], o.ka[1]}, a1 = {o.ka[2], o.ka[3]}, p0 = {o.kp[0], o.kp[1]}, p1 = {o.kp[2], o.kp[3]}, w0 = {o.w[0], o.w[1]}, w1 = {o.w[2], o.w[3]};
    f32x2 u0 = a0 * sav; u0 = p0 * vv + u0; S0 = S0 * w0 + u0;
    f32x2 u1 = a1 * sav; u1 = p1 * vv + u1; S1 = S1 * w1 + u1;
    const f32x2 r0 = {o.rr[0], o.rr[1]}, r1 = {o.rr[2], o.rr[3]};
    f32x2 y = S0 * r0; y = S1 * r1 + y;
    *yp = y[0] + y[1];
    S = (f32x4){S0[0], S0[1], S1[0], S1[1]};
}
__device__ __forceinline__ void scan_unit(const Ctx& p, int chain, int rq, LAS unsigned char* lds) {
    const int tid = threadIdx.x, lane = tid & 63, wave = __builtin_amdgcn_readfirstlane(tid >> 6);
    const bool smp = chain >= 32;
    const int cb = smp ? (chain - 32) >> 3 : chain >> 3, h = chain & 7, T = smp ? TS : TP, row0 = smp ? MPR + cb * TS : cb * TP;
    const int nch = T / SCH;
    const bf16_t* ZRW = (const bf16_t*)(p.ws() + WS_ZRW);
    const float* DEC = (const float*)(p.ws() + WS_DEC); const bf16_t* AB = (const bf16_t*)(p.ws() + WS_ABUF);
    bf16_t* ORW = (bf16_t*)(p.ws() + WS_ORW);
    LAS float* B0 = (LAS float*)lds; LAS float* YB = B0 + 2 * SBUF_F;
    __syncthreads();
    if (wave >= 4) {
        const int ht = tid - 256, tt = ht >> 4, cg4 = ht & 15, c0 = h * 64 + 4 * cg4;
        float mur[4], muk[4], muv[4], kkc[4], kac[4];
#pragma unroll
        for (int e = 0; e < 4; ++e) { mur[e] = p.in(17)[c0 + e]; muk[e] = p.in(17)[512 + c0 + e]; kkc[e] = p.in(23)[c0 + e]; kac[e] = p.in(24)[c0 + e]; }
        const int vc0 = h * 64 + 16 * rq + 4 * (cg4 & 3);
#pragma unroll
        for (int e = 0; e < 4; ++e) muv[e] = p.in(17)[1024 + vc0 + e];
        const bool hasv = cg4 < 4;
        struct HReg { u32x2 zr, zrp, zk, zkp, ab, zv, zvp; f32x4 dec; };
        auto issue = [&](HReg& R, int c) {
            const int row = row0 + c * SCH + tt, rp = row > 0 ? row - 1 : 0;
            R.zr = *(const u32x2*)(ZRW + (size_t)row * SHW + c0); R.zrp = *(const u32x2*)(ZRW + (size_t)rp * SHW + c0);
            R.zk = *(const u32x2*)(ZRW + (size_t)row * SHW + 512 + c0); R.zkp = *(const u32x2*)(ZRW + (size_t)rp * SHW + 512 + c0);
            R.ab = *(const u32x2*)(AB + (size_t)row * 512 + c0); R.dec = *(const f32x4*)(DEC + (size_t)row * 512 + c0);
            R.zv = (u32x2){0u, 0u}; R.zvp = (u32x2){0u, 0u};
            if (hasv) { R.zv = *(const u32x2*)(ZRW + (size_t)row * SHW + 1024 + vc0); R.zvp = *(const u32x2*)(ZRW + (size_t)rp * SHW + 1024 + vc0); }
        };
        auto commit = [&](const HReg& R, int c) {
            float zr[4], pr[4], zk[4], pk[4], a[4], zv[4], pv[4];
            unpack4(R.zr, zr); unpack4(R.zrp, pr); unpack4(R.zk, zk); unpack4(R.zkp, pk); unpack4(R.ab, a); unpack4(R.zv, zv); unpack4(R.zvp, pv);
            if (c == 0 && tt == 0) {
#pragma unroll
                for (int e = 0; e < 4; ++e) { pr[e] = 0.f; pk[e] = 0.f; pv[e] = 0.f; }
                if (smp) { const float* s0 = p.in(5) + (size_t)cb * SHW;
#pragma unroll
                    for (int e = 0; e < 4; ++e) { pr[e] = s0[c0 + e]; pk[e] = s0[512 + c0 + e]; pv[e] = s0[1024 + vc0 + e]; } }
            }
            float r[4], k[4], kk[4], n2 = 0.f;
#pragma unroll
            for (int e = 0; e < 4; ++e) { r[e] = zr[e] + (pr[e] - zr[e]) * mur[e]; k[e] = zk[e] + (pk[e] - zk[e]) * muk[e]; kk[e] = k[e] * kkc[e]; n2 += kk[e] * kk[e]; }
            n2 = sum16(n2);
            const float inv = __builtin_amdgcn_rsqf(fmaxf(n2, 1e-24f));
            float ka[4], kp[4];
#pragma unroll
            for (int e = 0; e < 4; ++e) { kk[e] *= inv; ka[e] = kk[e] * a[e]; kp[e] = k[e] * (1.f + (a[e] - 1.f) * kac[e]); }
            LAS float* OP = B0 + (c & 1) * SBUF_F + tt * 320 + 4 * cg4;
            *(LAS f32x4*)(OP) = R.dec;
            *(LAS f32x4*)(OP + 64) = (f32x4){kk[0], kk[1], kk[2], kk[3]};
            *(LAS f32x4*)(OP + 128) = (f32x4){ka[0], ka[1], ka[2], ka[3]};
            *(LAS f32x4*)(OP + 192) = (f32x4){kp[0], kp[1], kp[2], kp[3]};
            *(LAS f32x4*)(OP + 256) = (f32x4){r[0], r[1], r[2], r[3]};
            if (hasv) { LAS float* VW = B0 + (c & 1) * SBUF_F + SCH * 320 + (4 * cg4) * 16 + tt;
#pragma unroll
                for (int e = 0; e < 4; ++e) VW[e * 16] = zv[e] + (pv[e] - zv[e]) * muv[e]; }
        };
        auto yout = [&](int c) {
            const LAS float* Y = YB + (c & 1) * YP_F + (tt * 16 + cg4) * 16;
            const f32x4 y0 = *(const LAS f32x4*)Y, y1 = *(const LAS f32x4*)(Y + 4), y2 = *(const LAS f32x4*)(Y + 8), y3 = *(const LAS f32x4*)(Y + 12);
            const f32x4 ys = (y0 + y1) + (y2 + y3);
            ORW[(size_t)(row0 + c * SCH + tt) * 512 + h * 64 + 16 * rq + cg4] = f2bf((ys[0] + ys[1]) + (ys[2] + ys[3]));
        };
        HReg R0, R1;
        issue(R0, 0); if (nch > 1) issue(R1, 1);
        for (int ci = 0; ci <= nch; ci += 2) {
            if (ci < nch) { commit(R0, ci); if (ci + 2 < nch) issue(R0, ci + 2); }
            __syncthreads();
            if (ci > 0) yout(ci - 1);
            if (ci + 1 <= nch) {
                if (ci + 1 < nch) { commit(R1, ci + 1); if (ci + 3 < nch) issue(R1, ci + 3); }
                __syncthreads();
                yout(ci);
            }
        }
    } else {
        const int rl = lane >> 4, cl = lane & 15, il = 4 * wave + rl;
        f32x4 S;
        float* sg = (smp ? p.out() + O_SS : p.out() + O_SP) + ((size_t)(cb * 8 + h) * 64 + 16 * rq + il) * 64 + 4 * cl;
        if (smp) S = *(const f32x4*)(p.in(4) + ((size_t)(cb * 8 + h) * 64 + 16 * rq + il) * 64 + 4 * cl); else S = (f32x4){0.f, 0.f, 0.f, 0.f};
        for (int ci = 0; ci < nch; ++ci) {
            __syncthreads();
            const LAS float* OP = B0 + (ci & 1) * SBUF_F + 4 * cl;
            const LAS float* VP = B0 + (ci & 1) * SBUF_F + SCH * 320 + il * 16;
            LAS float* Y = YB + (ci & 1) * YP_F + il * 16 + cl;
            ScanOps oa, ob;
            scan_load(oa, OP, VP, 0);
            f32x2 vv = *(const LAS f32x2*)VP;
#pragma unroll 1
            for (int t = 0; t < SCH; t += 2) {
                scan_load(ob, OP, VP, t + 1);
                oa.v = vv[0]; ob.v = vv[1];
                scan_step(S, oa, Y + t * 256);
                scan_load(oa, OP, VP, (t + 2) & (SCH - 1));
                vv = *(const LAS f32x2*)(VP + ((t + 2) & (SCH - 1)));
                scan_step(S, ob, Y + (t + 1) * 256);
            }
        }
        __syncthreads();
        *(f32x4*)sg = S;
    }
}
__device__ __forceinline__ void phase_lnpass(const Ctx& p) {
    const int tid = threadIdx.x, c8 = tid & 7, h = (tid >> 3) & 7, rr = tid >> 6, c = h * 64 + 8 * c8;
    const bf16_t* ZRW = (const bf16_t*)(p.ws() + WS_ZRW); const bf16_t* AB = (const bf16_t*)(p.ws() + WS_ABUF); const bf16_t* GG = (const bf16_t*)(p.ws() + WS_GG);
    bf16_t* ORW = (bf16_t*)(p.ws() + WS_ORW);
    float mur[8], muk[8], muv[8], kac[8], rkc[8], lg[8], lb[8];
#pragma unroll
    for (int e = 0; e < 8; ++e) { mur[e] = p.in(17)[c + e]; muk[e] = p.in(17)[512 + c + e]; muv[e] = p.in(17)[1024 + c + e]; kac[e] = p.in(24)[c + e]; rkc[e] = p.in(25)[c + e]; lg[e] = p.in(26)[c + e]; lb[e] = p.in(27)[c + e]; }
    struct LR { u32x4 zr, zrp, zk, zkp, zv, zvp, ab, gg, yy; };
    auto ldrow = [&](LR& L, int row) {
        const int rp = row > 0 ? row - 1 : 0;
        L.zr = *(const u32x4*)(ZRW + (size_t)row * SHW + c); L.zrp = *(const u32x4*)(ZRW + (size_t)rp * SHW + c);
        L.zk = *(const u32x4*)(ZRW + (size_t)row * SHW + 512 + c); L.zkp = *(const u32x4*)(ZRW + (size_t)rp * SHW + 512 + c);
        L.zv = *(const u32x4*)(ZRW + (size_t)row * SHW + 1024 + c); L.zvp = *(const u32x4*)(ZRW + (size_t)rp * SHW + 1024 + c);
        L.ab = *(const u32x4*)(AB + (size_t)row * 512 + c); L.gg = *(const u32x4*)(GG + (size_t)row * 512 + c); L.yy = *(const u32x4*)(ORW + (size_t)row * 512 + c);
    };
    LR La, Lb;
    if ((int)blockIdx.x < MR / 8) ldrow(La, blockIdx.x * 8 + rr);
    for (int it = blockIdx.x; it < MR / 8; it += gridDim.x) {
        const int row = it * 8 + rr;
        const bool more = it + (int)gridDim.x < MR / 8;
        if (more) ldrow(Lb, (it + gridDim.x) * 8 + rr);
        float zr[8], pr[8], zk[8], pk[8], zv[8], pv[8], a[8], g[8], y[8];
        unpack8(La.zr, zr); unpack8(La.zrp, pr); unpack8(La.zk, zk); unpack8(La.zkp, pk); unpack8(La.zv, zv); unpack8(La.zvp, pv); unpack8(La.ab, a); unpack8(La.gg, g); unpack8(La.yy, y);
        const bool first = row < MPR ? (row & (TP - 1)) == 0 : ((row - MPR) & 15) == 0;
        if (first) {
#pragma unroll
            for (int e = 0; e < 8; ++e) { pr[e] = 0.f; pk[e] = 0.f; pv[e] = 0.f; }
            if (row >= MPR) { const float* s0 = p.in(5) + (size_t)((row - MPR) >> 4) * SHW;
#pragma unroll
                for (int e = 0; e < 8; ++e) { pr[e] = s0[c + e]; pk[e] = s0[512 + c + e]; pv[e] = s0[1024 + c + e]; } }
        }
        float r[8], k[8], v[8];
#pragma unroll
        for (int e = 0; e < 8; ++e) { r[e] = zr[e] + (pr[e] - zr[e]) * mur[e]; k[e] = zk[e] + (pk[e] - zk[e]) * muk[e]; v[e] = zv[e] + (pv[e] - zv[e]) * muv[e]; }
        float bon = 0.f, sy = 0.f;
#pragma unroll
        for (int e = 0; e < 8; ++e) { const float kp = k[e] * (1.f + (a[e] - 1.f) * kac[e]); bon += r[e] * kp * rkc[e]; sy += y[e]; }
        bon = sum8(bon);
        const float mu = sum8(sy) * (1.f / 64.f);
        float var = 0.f;
#pragma unroll
        for (int e = 0; e < 8; ++e) { y[e] -= mu; var += y[e] * y[e]; }
        var = sum8(var) * (1.f / 64.f);
        const float rs = 1.f / sqrtf(var + LNX_EPS);
        float o[8];
#pragma unroll
        for (int e = 0; e < 8; ++e) o[e] = (y[e] * rs * lg[e] + lb[e] + bon * v[e]) * g[e];
        u32x4 w; w.x = pk2(o[0], o[1]); w.y = pk2(o[2], o[3]); w.z = pk2(o[4], o[5]); w.w = pk2(o[6], o[7]);
        *(u32x4*)(ORW + (size_t)row * 512 + c) = w;
        if (more) La = Lb;
    }
}

__device__ __forceinline__ void ffn2_weights(const Ctx& p, LAS unsigned char* lds) {
    const int tid = threadIdx.x, lane = tid & 63, wave = __builtin_amdgcn_readfirstlane(tid >> 6);
    unsigned char* ws = p.ws();
    LAS float* scr = (LAS float*)(lds + wave * 16384);
    constexpr int I7 = 16 * 176, I8 = 44 * 32;
    __syncthreads();
    for (int it = ((int)blockIdx.x - 128) * 8 + wave; it < I7 + I8; it += 128 * 8) {
        int r = it;
        if (r < I7) { const int kb = r / 176, nb = r % 176; transpose_item(p.in(33), DM, NFF, (bf16_t*)(ws + WS_W3T), 64 * kb, 32 * nb, map_w1(32 * nb), scr, lane); continue; } r -= I7;
        { const int kb = r / 32, nb = r % 32; transpose_item(p.in(34), DFF, DM, (bf16_t*)(ws + WS_W4T), 64 * kb, 32 * nb, 32 * nb, scr, lane); }
    }
}
__device__ __forceinline__ void phase_mixer(const Ctx& p, LAS unsigned char* lds) {
    if (blockIdx.x < 128) scan_unit(p, blockIdx.x >> 2, blockIdx.x & 3, lds);
    else { const int u0 = (blockIdx.x - 128) * 2; scan_unit(p, 32 + (u0 >> 2), u0 & 3, lds); scan_unit(p, 32 + ((u0 + 1) >> 2), (u0 + 1) & 3, lds); }
    if (blockIdx.x < 128) return;
    unsigned* ctr = (unsigned*)(p.ws() + WS_CTR);
    LAS unsigned* su = (LAS unsigned*)(lds + 140 * 1024);
    for (;;) {
        __syncthreads();
        if (threadIdx.x == 0) su[0] = atomicAdd(ctr, 1u);
        __syncthreads();
        const int u = __builtin_amdgcn_readfirstlane((int)su[0]);
        if (u >= 32) break;
        att_sample_unit(p, u >> 2, u & 3, lds);
    }
    for (;;) {
        __syncthreads();
        if (threadIdx.x == 0) su[0] = atomicAdd(ctr + 1, 1u);
        __syncthreads();
        const int v = __builtin_amdgcn_readfirstlane((int)su[0]);
        if (v >= 512) break;
        att_prompt_unit(p, v & 15, 31 - (v >> 4), lds);
    }
    ffn2_weights(p, lds);
}

constexpr int LDS_BYTES = 147456;
constexpr int NPHASE = 15;
#ifndef SINGLE_LAUNCH
#define SINGLE_LAUNCH 1
#endif

#define XB_TMO      128
#define XB_XCNT(j)  (256  + 64 * (j))
#define XB_XSUB(j)  (1280 + 64 * (j))
#define XB_XGEN(j)  (2304 + 64 * (j))
#define XB_TOP      3328
#define XB_TOPGEN   3392
#define XCD_BAR_WORDS 3456
#define XB_SPIN_CAP (1u << 18)

__device__ __forceinline__ unsigned xb_ld(unsigned* p)              { return __hip_atomic_load(p, __ATOMIC_RELAXED, __HIP_MEMORY_SCOPE_AGENT); }
__device__ __forceinline__ unsigned xb_add(unsigned* p, unsigned v) { return __hip_atomic_fetch_add(p, v, __ATOMIC_RELAXED, __HIP_MEMORY_SCOPE_AGENT); }
__device__ __forceinline__ unsigned xb_xcc_id() { return (unsigned)__builtin_amdgcn_s_getreg((3 << 11) | 20) & 0xFu; }
#define XB_SPIN(cond, bar) do { unsigned _sp = 0; while (cond) { __builtin_amdgcn_s_sleep(1); \
    if ((++_sp & 255u) == 0u) { if (xb_ld(&(bar)[XB_TMO])) break; if (_sp > XB_SPIN_CAP) { atomicAdd(&(bar)[XB_TMO], 1u); break; } } } } while (0)

struct XcdBarrier {
    unsigned* bar; unsigned x;
    volatile LAS unsigned* st;
};

__device__ __forceinline__ XcdBarrier xcd_barrier_post(unsigned* bar, volatile LAS unsigned* st) {
    XcdBarrier b; b.bar = bar; b.x = xb_xcc_id(); b.st = st;
    if (threadIdx.x == 0) (void)xb_add(&bar[XB_XCNT(b.x)], 1u);
    return b;
}
__device__ __forceinline__ void xcd_barrier_complete(unsigned* bar, unsigned x, unsigned& nloc, unsigned& nx) {
    const unsigned G = gridDim.x * gridDim.y * gridDim.z;
    unsigned sum, cnt, mine, sp = 0u;
    for (;;) {
        sum = 0u; cnt = 0u; mine = 0u;
#pragma unroll
        for (unsigned j = 0; j < 16; ++j) { const unsigned c = xb_ld(&bar[XB_XCNT(j)]); sum += c; cnt += (c > 0u) ? 1u : 0u; mine = (j == x) ? c : mine; }
        if (sum == G) break;
        __builtin_amdgcn_s_sleep(1);
        if ((++sp & 255u) == 0u) { if (xb_ld(&bar[XB_TMO])) break; if (sp > XB_SPIN_CAP) { atomicAdd(&bar[XB_TMO], 1u); break; } }
    }
    nloc = mine > 0u ? mine : 1u; nx = cnt > 0u ? cnt : 1u;
}

__device__ __forceinline__ void xcd_barrier(const XcdBarrier& b) {
    asm volatile("s_waitcnt vmcnt(0)" ::: "memory");
    __syncthreads();
    if (threadIdx.x == 0) {
        unsigned* bar = b.bar;
        __builtin_amdgcn_s_waitcnt(0);
        unsigned nloc = b.st[0], nx = b.st[1];
        if (nloc == 0u) { xcd_barrier_complete(bar, b.x, nloc, nx); b.st[0] = nloc; b.st[1] = nx; }
        const unsigned old = xb_add(&bar[XB_XSUB(b.x)], 1u);
        const unsigned gen = old / nloc;
        if (old + 1u == (gen + 1u) * nloc) {
            __builtin_amdgcn_fence(__ATOMIC_RELEASE, "agent");
            asm volatile("s_waitcnt vmcnt(0)" ::: "memory");
            const unsigned og = xb_add(&bar[XB_TOP], 1u);
            const unsigned tg = og / nx;
            if (og + 1u == (tg + 1u) * nx) xb_add(&bar[XB_TOPGEN], 1u);
            else XB_SPIN(xb_ld(&bar[XB_TOPGEN]) == tg, bar);
            __builtin_amdgcn_fence(__ATOMIC_ACQUIRE, "agent");
            xb_add(&bar[XB_XGEN(b.x)], 1u);
            asm volatile("s_waitcnt vmcnt(0)" ::: "memory");
        } else {
            XB_SPIN(xb_ld(&bar[XB_XGEN(b.x)]) == gen, bar);
            __builtin_amdgcn_fence(__ATOMIC_ACQUIRE, "agent");
            asm volatile("s_waitcnt vmcnt(0)" ::: "memory");
        }
    }
    __syncthreads();
}

__device__ __forceinline__ void grid_bar(const Ctx& p, unsigned k) {
    asm volatile("s_waitcnt vmcnt(0)" ::: "memory");
    __syncthreads();
    if (threadIdx.x == 0) {
        unsigned* ctr = (unsigned*)(p.ws() + WS_CTR) + 64;
        __builtin_amdgcn_fence(__ATOMIC_RELEASE, "agent");
        asm volatile("s_waitcnt vmcnt(0)" ::: "memory");
        __hip_atomic_fetch_add(ctr, 1u, __ATOMIC_RELAXED, __HIP_MEMORY_SCOPE_AGENT);
        const unsigned target = k * gridDim.x;
        while (__hip_atomic_load(ctr, __ATOMIC_RELAXED, __HIP_MEMORY_SCOPE_AGENT) < target) __builtin_amdgcn_s_sleep(1);
        __builtin_amdgcn_fence(__ATOMIC_ACQUIRE, "agent");
        asm volatile("s_waitcnt vmcnt(0)" ::: "memory");
    }
    __syncthreads();
}
__device__ __forceinline__ void sub_barrier(const Ctx& p, unsigned n) {
    asm volatile("s_waitcnt vmcnt(0)" ::: "memory");
    __syncthreads();
    if (threadIdx.x == 0) {
        unsigned* c = (unsigned*)(p.ws() + WS_CTR) + 128;
        __builtin_amdgcn_fence(__ATOMIC_RELEASE, "agent");
        asm volatile("s_waitcnt vmcnt(0)" ::: "memory");
        __hip_atomic_fetch_add(c, 1u, __ATOMIC_RELAXED, __HIP_MEMORY_SCOPE_AGENT);
        while (__hip_atomic_load(c, __ATOMIC_RELAXED, __HIP_MEMORY_SCOPE_AGENT) < n) __builtin_amdgcn_s_sleep(2);
        __builtin_amdgcn_fence(__ATOMIC_ACQUIRE, "agent");
        asm volatile("s_waitcnt vmcnt(0)" ::: "memory");
    }
    __syncthreads();
}
template <class Epi> __device__ __forceinline__ void run_gemm(LAS unsigned char* lds, const bf16_t* A, const bf16_t* Bt, int N, int K, const Epi& E, int M = MP) {
    pg8::Gemm g{A, Bt, M, N, K, K}; pg8::StaticOrder S; S.init(M, N, (int)gridDim.x, (int)blockIdx.x);
    pg8::gemm_phase<Epi, pg8::StaticOrder, true, true>(lds, g, S, E);
}
struct OneUnit { int pn; bool on;
    __device__ __forceinline__ bool next(int i, pg8::Unit& u) const { if (i > 0 || !on) return false; u.pm = 0; u.pn = pn; return true; }
    __device__ __forceinline__ void a_ready(const pg8::Unit&) const {}
    __device__ __forceinline__ void done(const pg8::Unit&) const {} };
struct EpiPart {
    static constexpr bool PERM = false, AFTER_DRAIN = false;
    float* O;
    __device__ __forceinline__ void operator()(const f32x4 (&acc)[2][2][4][2], const Unit& u, int wr, int wc, int fr, int fq) const {
        const int col0 = u.pn * 256 + wc * 32 + 4 * fq;
#pragma unroll
        for (int m = 0; m < 4; ++m) {
            const int row = wr * 64 + m * 16 + fr;
#pragma unroll
            for (int bj = 0; bj < 2; ++bj)
#pragma unroll
                for (int n = 0; n < 2; ++n) *(f32x4*)(O + (size_t)row * DM + col0 + bj * 128 + n * 16) = acc[0][bj][m][n];
            asm volatile("" ::: "memory");
        }
    }
};
constexpr size_t WS_PART = 240 * MiB;
constexpr int KSL = 256;
__device__ __forceinline__ void run_gemm_sample(LAS unsigned char* lds, const bf16_t* A, const bf16_t* Bt, int K, float* PART) {
    const int c = (int)blockIdx.x, ns = K / KSL, ks = c >> 2;
    OneUnit S{c & 3, c < 4 * ns};
    pg8::Gemm g{A + (size_t)MPR * K + (size_t)ks * KSL, Bt + (size_t)ks * KSL, 256, DM, KSL, K};
    EpiPart E{PART + (size_t)ks * 128 * DM};
    pg8::gemm_phase<EpiPart, OneUnit, false, true>(lds, g, S, E);
}

__global__ void __launch_bounds__(512) fwd_kernel(Params prm) {
    extern __shared__ __attribute__((aligned(16))) unsigned char lds_raw[];
    LAS unsigned char* lds = (LAS unsigned char*)lds_raw;
    cg::grid_group grid = cg::this_grid();
    const int lo = prm.ph_lo, hi = prm.ph_hi;
    {   LAS unsigned long long* tab = (LAS unsigned long long*)(lds + 141 * 1024);
        if (threadIdx.x < 36) tab[threadIdx.x] = (unsigned long long)prm.in[threadIdx.x];
        if (threadIdx.x == 36) tab[36] = (unsigned long long)prm.out;
        if (threadIdx.x == 37) tab[37] = (unsigned long long)prm.ws;
        __syncthreads(); }
    Ctx p{(const LAS unsigned*)(lds + 141 * 1024)};
volatile LAS unsigned* bst = (volatile LAS unsigned*)(lds + 142 * 1024);
    if (threadIdx.x < 2) bst[threadIdx.x] = 0u;
    __syncthreads();
    XcdBarrier bar = xcd_barrier_post((unsigned*)(p.ws() + WS_CTR) + 1024, bst);
#define ws (p.ws())
#define IN(k) (lo <= (k) && (k) < hi)
#define SEAM(k) do { if (IN(k) && IN((k) + 1)) xcd_barrier(bar); } while (0)
    unsigned nbar = 0;
    if (IN(0)) { phase_prologue(p, lds); } if (IN(0) && IN(1)) { if (lo < 0) grid.sync();   xcd_barrier(bar); }
    if (IN(1)) { EpiSwiglu E{(bf16_t*)(ws + WS_G)}; run_gemm(lds, (const bf16_t*)(ws + WS_XN), (const bf16_t*)(ws + WS_W1T), NFF, DM, E);
        { constexpr int NFULL = (MP / 256) * (NFF / 256) - 5 * 256;
          if ((int)blockIdx.x >= NFULL) prologue_part2(p, lds, (int)blockIdx.x - NFULL, 256 - NFULL); } } SEAM(1);
    if (IN(2)) { EpiF32 E{(float*)(ws + WS_F)}; run_gemm(lds, (const bf16_t*)(ws + WS_G), (const bf16_t*)(ws + WS_W2T), DM, DFF, E, MPR); run_gemm_sample(lds, (const bf16_t*)(ws + WS_G), (const bf16_t*)(ws + WS_W2T), DFF, (float*)(ws + WS_PART)); } SEAM(2);
    if (IN(3)) { phase_rowpass(p, (const float*)(ws + WS_F), 1, 0.5f, p.in(9), p.in(10), (bf16_t*)(ws + WS_XN), (const float*)(ws + WS_PART), DFF / KSL); } SEAM(3);
    if (IN(4)) { EpiZ E{p.out(), (bf16_t*)(ws + WS_QB), (bf16_t*)(ws + WS_KB), (bf16_t*)(ws + WS_VT), (bf16_t*)(ws + WS_ZRW), (bf16_t*)(ws + WS_GATE), (const f32x2*)(ws + WS_TAB)};
        run_gemm(lds, (const bf16_t*)(ws + WS_XN), (const bf16_t*)(ws + WS_WINT), INW, DM, E); } SEAM(4);
    if (IN(5)) { phase_lora(p, lds); } SEAM(5);
    if (IN(6)) { phase_mixer(p, lds);
        if (blockIdx.x >= 128) {
            sub_barrier(p, 128u);
            EpiGate1 E{(bf16_t*)(ws + WS_KB), (const bf16_t*)(ws + WS_GATE)};
            pg8::Gemm g{(const bf16_t*)(ws + WS_QB), (const bf16_t*)(ws + WS_WAT), MP, DM, 512, 512}; pg8::StaticOrder S; S.init(MP, DM, 128, (int)blockIdx.x - 128);
            pg8::gemm_phase<EpiGate1, pg8::StaticOrder, true, true>(lds, g, S, E);
        } } SEAM(6);
    if (IN(14)) { phase_lnpass(p); } if (IN(14) && IN(7)) xcd_barrier(bar);
    if (IN(8)) { EpiGate2 E{(const bf16_t*)(ws + WS_KB), (const bf16_t*)(ws + WS_GATE), (bf16_t*)(ws + WS_MG)}; run_gemm(lds, (const bf16_t*)(ws + WS_ORW), (const bf16_t*)(ws + WS_WRT), DM, 512, E); } SEAM(8);
    if (IN(9)) { EpiF32 E{(float*)(ws + WS_T)}; run_gemm(lds, (const bf16_t*)(ws + WS_MG), (const bf16_t*)(ws + WS_WOT), DM, DM, E, MPR); run_gemm_sample(lds, (const bf16_t*)(ws + WS_MG), (const bf16_t*)(ws + WS_WOT), DM, (float*)(ws + WS_PART)); } SEAM(9);
    if (IN(10)) { phase_rowpass(p, (const float*)(ws + WS_T), 0, 1.0f, p.in(31), p.in(32), (bf16_t*)(ws + WS_XN), (const float*)(ws + WS_PART), DM / KSL); } SEAM(10);
    if (IN(11)) { EpiSwiglu E{(bf16_t*)(ws + WS_G)}; run_gemm(lds, (const bf16_t*)(ws + WS_XN), (const bf16_t*)(ws + WS_W3T), NFF, DM, E); } SEAM(11);
    if (IN(12)) { EpiF32 E{(float*)(ws + WS_F)}; run_gemm(lds, (const bf16_t*)(ws + WS_G), (const bf16_t*)(ws + WS_W4T), DM, DFF, E, MPR); run_gemm_sample(lds, (const bf16_t*)(ws + WS_G), (const bf16_t*)(ws + WS_W4T), DFF, (float*)(ws + WS_PART)); } SEAM(12);
    if (IN(13)) { phase_rowpass(p, (const float*)(ws + WS_F), 0, 0.5f, p.in(35), nullptr, nullptr, (const float*)(ws + WS_PART), DFF / KSL); }
#undef IN
#undef SEAM
#undef ws
}

extern "C" void kernel_launch(void* const* d_in, const int* in_sizes, int n_in, void* d_out, int out_size, void* d_ws, size_t ws_size, hipStream_t stream) {
    static int grid = 0;
    if (grid == 0) {
        int dev = 0, cus = 0, per_cu = 0;
        (void)hipGetDevice(&dev);
        (void)hipDeviceGetAttribute(&cus, hipDeviceAttributeMultiprocessorCount, dev);
        (void)hipFuncSetAttribute((const void*)fwd_kernel, hipFuncAttributeMaxDynamicSharedMemorySize, LDS_BYTES);
        if (hipOccupancyMaxActiveBlocksPerMultiprocessor(&per_cu, (const void*)fwd_kernel, 512, LDS_BYTES) != hipSuccess || per_cu < 1) per_cu = 1;
        (void)hipGetLastError();
        grid = cus * per_cu;
        if (grid <= 0) grid = 256;
        if (n_in != 36 || (size_t)out_size != O_END || ws_size < WS_NEED) { fprintf(stderr, "kernel_launch: unexpected sizes n_in %d out %d ws %zu (need %zu)\n", n_in, out_size, ws_size, (size_t)WS_NEED); grid = -1; }
    }
    if (grid < 0) return;
    Params p{};
    for (int i = 0; i < 36; ++i) p.in[i] = (const float*)d_in[i];
    p.out = (float*)d_out; p.ws = (unsigned char*)d_ws;
    (void)hipMemsetAsync((unsigned char*)d_ws + WS_CTR, 0, 4096 + 3456 * 4, stream);
#if SINGLE_LAUNCH
    p.ph_lo = 0; p.ph_hi = NPHASE;
    void* args[] = {&p};
    hipError_t e = hipLaunchCooperativeKernel((const void*)fwd_kernel, dim3(grid), dim3(512), args, LDS_BYTES, stream);
    if (e != hipSuccess) fprintf(stderr, "cooperative launch failed: %s (grid %d)\n", hipGetErrorString(e), grid);
#else
    for (int ph = 0; ph < NPHASE; ++ph) { p.ph_lo = ph; p.ph_hi = ph + 1; hipLaunchKernelGGL(fwd_kernel, dim3(grid), dim3(512), LDS_BYTES, stream, p); }
#endif
}
```
